# Optimizing an MI355X kernel written in HIP

```python
import math
import jax, jax.numpy as jnp
from jax import lax
import numpy as np

D_MODEL = 1024
BATCH = 8
SEQ = 2048
DEPTH = 1

MEM_LEN = 256
MLA_HEADS = 8
QK_NOPE_DIM = 64
QK_ROPE_DIM = 32
V_HEAD_DIM = 64
Q_LORA_RANK = 384
KV_LORA_RANK = 256
MLA_OUT = MLA_HEADS * V_HEAD_DIM
CONV_GROUPS = 8
CONV_DIM = 512
CONV_WIDTH = 3
GROUP_DIM = 64
MIX_WIDTH = MLA_OUT + CONV_DIM
IN_PROJ_COLS = Q_LORA_RANK + KV_LORA_RANK + QK_ROPE_DIM + 3 * CONV_DIM
ROPE_THETA = 10000.0
Q_BLOCK = 128
X_HEADS = 4
X_HEAD_DIM = D_MODEL // X_HEADS
PEER_HEADS = 8
PEER_KEYS = 128
PEER_EXPERTS = PEER_KEYS * PEER_KEYS
PEER_QDIM = 128
PEER_TOPK = 16
PEER_BLOCK = 128
EPS = 1e-6

kernel_name = 'hybrid_mla_shortconv_memxattn_peer'


def rmsnorm(t, g):
    tf = t.astype(jnp.float32)
    tf = tf * lax.rsqrt(jnp.mean(tf * tf, axis=-1, keepdims=True) + EPS)
    return (tf * g.astype(jnp.float32)).astype(t.dtype)


def rope_tables(positions, dim, dtype):
    inv = ROPE_THETA ** (-jnp.arange(0, dim, 2, dtype=jnp.float32) / dim)
    ang = positions.astype(jnp.float32)[..., None] * inv
    return jnp.cos(ang).astype(dtype), jnp.sin(ang).astype(dtype)


def apply_rope(t, cos, sin):
    half = t.shape[-1] // 2
    t1, t2 = t[..., :half], t[..., half:]
    return jnp.concatenate([t1 * cos - t2 * sin, t2 * cos + t1 * sin], axis=-1)


def mla_branch(c_q, c_kv, k_rope_raw, cos, sin, g_q, w_uq, g_kv, w_ukv):
    B, S, _ = c_q.shape
    q = (rmsnorm(c_q, g_q) @ w_uq).reshape(B, S, MLA_HEADS, QK_NOPE_DIM + QK_ROPE_DIM)
    q_nope = q[..., :QK_NOPE_DIM]
    q_rope = apply_rope(q[..., QK_NOPE_DIM:], cos[:, :, None, :], sin[:, :, None, :])
    kv = (rmsnorm(c_kv, g_kv) @ w_ukv).reshape(B, S, MLA_HEADS, QK_NOPE_DIM + V_HEAD_DIM)
    k_nope = kv[..., :QK_NOPE_DIM]
    v = kv[..., QK_NOPE_DIM:]
    k_rope = apply_rope(k_rope_raw, cos, sin)
    scale = 1.0 / math.sqrt(QK_NOPE_DIM + QK_ROPE_DIM)
    kpos = jnp.arange(S)

    def block(i):
        start = i * Q_BLOCK
        qn = lax.dynamic_slice_in_dim(q_nope, start, Q_BLOCK, axis=1)
        qr = lax.dynamic_slice_in_dim(q_rope, start, Q_BLOCK, axis=1)
        s = (jnp.einsum('bqhd,bkhd->bhqk', qn, k_nope)
             + jnp.einsum('bqhd,bkd->bhqk', qr, k_rope)).astype(jnp.float32) * scale
        qpos = start + jnp.arange(Q_BLOCK)
        mask = kpos[None, :] <= qpos[:, None]
        s = jnp.where(mask[None, None], s, -jnp.inf)
        p = jax.nn.softmax(s, axis=-1).astype(v.dtype)
        return jnp.einsum('bhqk,bkhd->bqhd', p, v)

    o = lax.map(block, jnp.arange(S // Q_BLOCK))
    return jnp.transpose(o, (1, 0, 2, 3, 4)).reshape(B, S, MLA_OUT)


def short_conv_branch(gate_b, gate_c, hx, conv_w):
    z = gate_c * hx
    zc = lax.conv_general_dilated(
        z, conv_w[:, None, :].astype(z.dtype), window_strides=(1,),
        padding=[(CONV_WIDTH - 1, 0)], dimension_numbers=('NWC', 'WIO', 'NWC'),
        feature_group_count=CONV_DIM)
    return gate_b * zc


def mixer_block(xn, cos, sin, w_in, g_q, w_uq, g_kv, w_ukv, conv_w, g_out, w_o):
    B, S, _ = xn.shape
    proj = xn @ w_in
    o1 = Q_LORA_RANK
    o2 = o1 + KV_LORA_RANK
    o3 = o2 + QK_ROPE_DIM
    o4 = o3 + CONV_DIM
    o5 = o4 + CONV_DIM
    y_mla = mla_branch(proj[..., :o1], proj[..., o1:o2], proj[..., o2:o3],
                       cos, sin, g_q, w_uq, g_kv, w_ukv)
    y_conv = short_conv_branch(proj[..., o3:o4], proj[..., o4:o5], proj[..., o5:], conv_w)
    y = jnp.concatenate([y_mla, y_conv], axis=-1).reshape(B, S, MIX_WIDTH // GROUP_DIM, GROUP_DIM)
    y = rmsnorm(y, g_out.reshape(MIX_WIDTH // GROUP_DIM, GROUP_DIM)).reshape(B, S, MIX_WIDTH)
    return y @ w_o


def memory_xattn(hn, memn, w_xq, w_xkv, w_xo):
    B, S, D = hn.shape
    M = memn.shape[1]
    q = (hn @ w_xq).reshape(B, S, X_HEADS, X_HEAD_DIM)
    kv = (memn @ w_xkv).reshape(B, M, 2, X_HEADS, X_HEAD_DIM)
    k, v = kv[:, :, 0], kv[:, :, 1]
    s = jnp.einsum('bshd,bmhd->bhsm', q, k).astype(jnp.float32) / math.sqrt(X_HEAD_DIM)
    p = jax.nn.softmax(s, axis=-1).astype(v.dtype)
    o = jnp.einsum('bhsm,bmhd->bshd', p, v).reshape(B, S, D)
    return o @ w_xo


def peer_ffn(hn, w_pq, sub_keys, u_experts, v_experts):
    B, S, D = hn.shape
    T = B * S
    xt = hn.reshape(T, D)
    q = (xt @ w_pq).reshape(T, PEER_HEADS, 2, PEER_QDIM // 2)
    s = jnp.einsum('thcd,hcnd->thcn', q, sub_keys).astype(jnp.float32)
    s_top, i_top = lax.top_k(s, PEER_TOPK)
    cand_s = (s_top[:, :, 0, :, None] + s_top[:, :, 1, None, :]).reshape(T, PEER_HEADS, PEER_TOPK * PEER_TOPK)
    cand_i = (i_top[:, :, 0, :, None] * PEER_KEYS + i_top[:, :, 1, None, :]).reshape(T, PEER_HEADS, PEER_TOPK * PEER_TOPK)
    best_s, best_pos = lax.top_k(cand_s, PEER_TOPK)
    experts = jnp.take_along_axis(cand_i, best_pos, axis=-1)
    gates = jax.nn.softmax(best_s, axis=-1).astype(hn.dtype)
    nb = T // PEER_BLOCK

    def block(args):
        xb, eb, gb = args
        u_sel = jnp.take(u_experts, eb, axis=0)
        a = jax.nn.gelu(jnp.einsum('td,thkd->thk', xb, u_sel)) * gb
        v_sel = jnp.take(v_experts, eb, axis=0)
        return jnp.einsum('thk,thkd->td', a, v_sel)

    out = lax.map(block, (xt.reshape(nb, PEER_BLOCK, D),
                          experts.reshape(nb, PEER_BLOCK, PEER_HEADS, PEER_TOPK),
                          gates.reshape(nb, PEER_BLOCK, PEER_HEADS, PEER_TOPK)))
    return out.reshape(B, S, D)


def setup_inputs(seed: int = 0) -> dict:
    key = jax.random.key(seed)
    ks = iter(jax.random.split(key, 32))
    f32 = jnp.float32

    def nrm(shape, scale):
        return jax.random.normal(next(ks), shape, f32) * scale

    def gain(shape):
        return 1.0 + 0.02 * jax.random.normal(next(ks), shape, f32)

    L = DEPTH
    x = jax.random.normal(next(ks), (BATCH, SEQ, D_MODEL), f32)
    mem = jax.random.normal(next(ks), (BATCH, MEM_LEN, D_MODEL), f32)
    offs = jax.random.randint(next(ks), (BATCH, 1), 0, 1024, dtype=jnp.int32)
    positions = offs + jnp.arange(SEQ, dtype=jnp.int32)[None, :]
    return {
        'x': x,
        'mem': mem,
        'positions': positions,
        'g_mix': gain((L, D_MODEL)),
        'w_in': nrm((L, D_MODEL, IN_PROJ_COLS), D_MODEL ** -0.5),
        'g_q': gain((L, Q_LORA_RANK)),
        'w_uq': nrm((L, Q_LORA_RANK, MLA_HEADS * (QK_NOPE_DIM + QK_ROPE_DIM)), Q_LORA_RANK ** -0.5),
        'g_kv': gain((L, KV_LORA_RANK)),
        'w_ukv': nrm((L, KV_LORA_RANK, MLA_HEADS * (QK_NOPE_DIM + V_HEAD_DIM)), KV_LORA_RANK ** -0.5),
        'conv_w': nrm((L, CONV_WIDTH, CONV_DIM), CONV_WIDTH ** -0.5),
        'g_out': gain((L, MIX_WIDTH)),
        'w_o': nrm((L, MIX_WIDTH, D_MODEL), MIX_WIDTH ** -0.5),
        'g_x': gain((L, D_MODEL)),
        'g_mem': gain((L, D_MODEL)),
        'w_xq': nrm((L, D_MODEL, D_MODEL), D_MODEL ** -0.5),
        'w_xkv': nrm((L, D_MODEL, 2 * D_MODEL), D_MODEL ** -0.5),
        'w_xo': nrm((L, D_MODEL, D_MODEL), D_MODEL ** -0.5),
        'g_ffn': gain((L, D_MODEL)),
        'w_pq': nrm((L, D_MODEL, PEER_HEADS * PEER_QDIM), D_MODEL ** -0.5),
        'sub_keys': nrm((L, PEER_HEADS, 2, PEER_KEYS, PEER_QDIM // 2), (PEER_QDIM // 2) ** -0.5),
        'u_experts': nrm((L, PEER_EXPERTS, D_MODEL), D_MODEL ** -0.5),
        'v_experts': nrm((L, PEER_EXPERTS, D_MODEL), PEER_HEADS ** -0.5),
        'g_final': gain((D_MODEL,)),
    }


def reference(x, mem, positions, g_mix, w_in, g_q, w_uq, g_kv, w_ukv, conv_w, g_out, w_o,
              g_x, g_mem, w_xq, w_xkv, w_xo, g_ffn, w_pq, sub_keys, u_experts, v_experts, g_final):
    cos, sin = rope_tables(positions, QK_ROPE_DIM, x.dtype)
    h = x
    for l in range(DEPTH):
        h = h + mixer_block(rmsnorm(h, g_mix[l]), cos, sin, w_in[l], g_q[l], w_uq[l],
                            g_kv[l], w_ukv[l], conv_w[l], g_out[l], w_o[l])
        h = h + memory_xattn(rmsnorm(h, g_x[l]), rmsnorm(mem, g_mem[l]),
                             w_xq[l], w_xkv[l], w_xo[l])
        h = h + peer_ffn(rmsnorm(h, g_ffn[l]), w_pq[l], sub_keys[l], u_experts[l], v_experts[l])
    return rmsnorm(h, g_final)
```

```cpp
#include <hip/hip_runtime.h>
#include <stdint.h>
#include <math.h>
#include <string.h>

typedef unsigned short bf16_t;
constexpr int T_ = 16384, D_ = 1024, B_ = 8, S_ = 2048, ML_ = 256, TM_ = 2048;
constexpr int PJ = 2560;
constexpr float EPS_ = 1e-6f;
constexpr float LOG2E = 1.4426950408889634f;

constexpr size_t MiB = 1u << 20;
constexpr size_t WS_CTL = 0;
constexpr size_t WS_COS = 2 * MiB, WS_SIN = 3 * MiB;
constexpr size_t WS_W = 4 * MiB;
constexpr size_t WS_UT = 24 * MiB, WS_VT = 56 * MiB;
constexpr size_t WS_MEMN = 88 * MiB, WS_KX = 92 * MiB, WS_VXT = 96 * MiB;
constexpr size_t WS_RS = 100 * MiB;
constexpr size_t WS_RIDX = 106 * MiB, WS_RGATE = 114 * MiB;
constexpr size_t WS_RA = 122 * MiB;
constexpr size_t WS_RB = 154 * MiB;
constexpr size_t WS_RC = 186 * MiB;
constexpr size_t WS_RD = 218 * MiB;
constexpr size_t WS_END = 256 * MiB;

__device__ __forceinline__ float bf2f(bf16_t b) { return __uint_as_float(((unsigned)b) << 16); }
__device__ __forceinline__ bf16_t f2bf(float f) { unsigned u = __float_as_uint(f); return (bf16_t)((u + 0x7fffu + ((u >> 16) & 1u)) >> 16); }
__device__ __forceinline__ float wave_sum(float v) {
#pragma unroll
    for (int o = 1; o < 64; o <<= 1) v += __shfl_xor(v, o);
    return v;
}
__device__ __forceinline__ float wave_max(float v) {
#pragma unroll
    for (int o = 1; o < 64; o <<= 1) v = fmaxf(v, __shfl_xor(v, o));
    return v;
}

__global__ void nk_rmsnorm(const float* in, const float* g, bf16_t* out, int rows) {
    const int w = (blockIdx.x * blockDim.x + threadIdx.x) >> 6, lane = threadIdx.x & 63;
    if (w >= rows) return;
    const float* r = in + (size_t)w * 1024;
    float v[16]; float s = 0.f;
#pragma unroll
    for (int j = 0; j < 16; ++j) { v[j] = r[j * 64 + lane]; s += v[j] * v[j]; }
    s = wave_sum(s);
    const float rs = rsqrtf(s * (1.f / 1024.f) + EPS_);
#pragma unroll
    for (int j = 0; j < 16; ++j) out[(size_t)w * 1024 + j * 64 + lane] = f2bf(v[j] * rs * g[j * 64 + lane]);
}

struct NGemm {
    const bf16_t* A; const float* B; bf16_t* C; const float* kscale; const float* rowscale; const void* R;
    int lda, ldb, ldc, M, N, K, ldr, r_is_f32, trans_out; float outscale;
};
__global__ void __launch_bounds__(256) nk_gemm(NGemm g) {
    __shared__ float As[16][65];
    __shared__ float Bs[16][65];
    const int tx = threadIdx.x & 15, ty = threadIdx.x >> 4;
    const int m0 = blockIdx.y * 64, n0 = blockIdx.x * 64;
    float acc[4][4];
#pragma unroll
    for (int i = 0; i < 4; ++i)
#pragma unroll
        for (int j = 0; j < 4; ++j) acc[i][j] = 0.f;
    for (int k0 = 0; k0 < g.K; k0 += 16) {
#pragma unroll
        for (int q = 0; q < 4; ++q) {
            const int i = threadIdx.x + q * 256; const int r = i >> 4, c = i & 15;
            float a = bf2f(g.A[(size_t)(m0 + r) * g.lda + k0 + c]); if (g.kscale) a *= g.kscale[k0 + c]; As[c][r] = a;
        }
#pragma unroll
        for (int q = 0; q < 4; ++q) {
            const int i = threadIdx.x + q * 256; const int r = i >> 6, c = i & 63; const int n = n0 + c;
            Bs[r][c] = (n < g.N) ? g.B[(size_t)(k0 + r) * g.ldb + n] : 0.f;
        }
        __syncthreads();
#pragma unroll
        for (int kk = 0; kk < 16; ++kk) {
            float a[4], b[4];
#pragma unroll
            for (int i = 0; i < 4; ++i) { a[i] = As[kk][ty * 4 + i]; b[i] = Bs[kk][tx * 4 + i]; }
#pragma unroll
            for (int i = 0; i < 4; ++i)
#pragma unroll
                for (int j = 0; j < 4; ++j) acc[i][j] += a[i] * b[j];
        }
        __syncthreads();
    }
#pragma unroll
    for (int i = 0; i < 4; ++i)
#pragma unroll
        for (int j = 0; j < 4; ++j) {
            const int m = m0 + ty * 4 + i, n = n0 + tx * 4 + j;
            if (n < g.N) {
                float v = acc[i][j]; if (g.rowscale) v *= g.rowscale[m]; v *= g.outscale;
                if (g.R) v += g.r_is_f32 ? ((const float*)g.R)[(size_t)m * g.ldr + n] : bf2f(((const bf16_t*)g.R)[(size_t)m * g.ldr + n]);
                if (g.trans_out) g.C[(size_t)n * g.ldc + m] = f2bf(v); else g.C[(size_t)m * g.ldc + n] = f2bf(v);
            }
        }
}

__global__ void nk_rowstat(const bf16_t* in, int ld, int c0, int n, float* RS, int rows) {
    const int w = (blockIdx.x * blockDim.x + threadIdx.x) >> 6, lane = threadIdx.x & 63;
    if (w >= rows) return;
    float s = 0.f;
    for (int c = lane; c < n; c += 64) { const float v = bf2f(in[(size_t)w * ld + c0 + c]); s += v * v; }
    s = wave_sum(s);
    if (lane == 0) RS[w] = rsqrtf(s / (float)n + EPS_);
}

__global__ void nk_rope_tab(const int* pos, float* COS, float* SIN) {
    const int i = blockIdx.x * blockDim.x + threadIdx.x; if (i >= T_ * 16) return;
    const int t = i >> 4, f = i & 15;
    const float inv = powf(10000.f, -(float)(2 * f) / 32.f);
    const float ang = (float)pos[t] * inv;
    COS[i] = cosf(ang); SIN[i] = sinf(ang);
}

__global__ void nk_mla_prep(bf16_t* Q, const bf16_t* KVRAW, const bf16_t* PROJ, const float* COS, const float* SIN, bf16_t* K, bf16_t* V) {
    const int i = blockIdx.x * blockDim.x + threadIdx.x; if (i >= T_ * 8) return;
    const int t = i >> 3, h = i & 7;
    bf16_t* q = Q + (size_t)t * 768 + h * 96 + 64;
    float r1[16], r2[16];
#pragma unroll
    for (int j = 0; j < 16; ++j) { r1[j] = bf2f(q[j]); r2[j] = bf2f(q[16 + j]); }
#pragma unroll
    for (int j = 0; j < 16; ++j) { const float c = COS[t * 16 + j], s = SIN[t * 16 + j]; q[2 * j] = f2bf(r1[j] * c - r2[j] * s); q[2 * j + 1] = f2bf(r2[j] * c + r1[j] * s); }
    bf16_t* k = K + (size_t)t * 768 + h * 96;
    const bf16_t* kv = KVRAW + (size_t)t * 1024 + h * 128;
    for (int d = 0; d < 64; ++d) { k[d] = kv[d]; V[(size_t)t * 512 + h * 64 + d] = kv[64 + d]; }
    const bf16_t* kr = PROJ + (size_t)t * PJ + 768;
#pragma unroll
    for (int j = 0; j < 16; ++j) { const float c = COS[t * 16 + j], s = SIN[t * 16 + j]; const float t1 = bf2f(kr[j]), t2 = bf2f(kr[16 + j]); k[64 + 2 * j] = f2bf(t1 * c - t2 * s); k[64 + 2 * j + 1] = f2bf(t2 * c + t1 * s); }
}

struct NAttn { const bf16_t* Q; const bf16_t* K; const bf16_t* V; bf16_t* O; long vs_key, vs_d; int ldq, ldk, ldo, H, Sq, Sk, dqk, dv, causal, headnorm; };
__global__ void __launch_bounds__(256) nk_attn(NAttn a) {
    __shared__ float qs[4][256];
    __shared__ float ps[4][64];
    const int wl = threadIdx.x >> 6, lane = threadIdx.x & 63;
    const long w = (long)blockIdx.x * 4 + wl;
    const int q = (int)(w % a.Sq); const int h = (int)((w / a.Sq) % a.H); const int b = (int)(w / ((long)a.Sq * a.H));
    const bf16_t* qrow = a.Q + (size_t)(b * a.Sq + q) * a.ldq + h * a.dqk;
    for (int d = lane; d < a.dqk; d += 64) qs[wl][d] = bf2f(qrow[d]);
    __syncthreads();
    float m = -INFINITY, l = 0.f; float acc[4] = {0.f, 0.f, 0.f, 0.f};
    const int nk = a.causal ? (q + 1) : a.Sk;
    for (int k0 = 0; k0 < nk; k0 += 64) {
        const int key = k0 + lane; const bool valid = key < nk;
        float s = -INFINITY;
        if (valid) { const bf16_t* kr = a.K + (size_t)(b * a.Sk + key) * a.ldk + h * a.dqk; float t = 0.f; for (int d = 0; d < a.dqk; ++d) t += qs[wl][d] * bf2f(kr[d]); s = t; }
        const float mn = fmaxf(m, wave_max(s));
        const float p = valid ? exp2f(s - mn) : 0.f; const float alpha = exp2f(m - mn);
        l = l * alpha + wave_sum(p); m = mn;
        ps[wl][lane] = p;
        asm volatile("s_waitcnt lgkmcnt(0)" ::: "memory");
#pragma unroll
        for (int c = 0; c < 4; ++c) acc[c] *= alpha;
        const int jmax = (nk - k0) < 64 ? (nk - k0) : 64;
        for (int j = 0; j < jmax; ++j) {
            const float pj = ps[wl][j]; const size_t kb = (size_t)(b * a.Sk + k0 + j);
#pragma unroll
            for (int c = 0; c < 4; ++c) { const int d = lane + 64 * c; if (d < a.dv) acc[c] += pj * bf2f(a.V[kb * a.vs_key + (size_t)(h * a.dv + d) * a.vs_d]); }
        }
        asm volatile("s_waitcnt lgkmcnt(0)" ::: "memory");
    }
    const float il = 1.f / l;
    float o[4];
#pragma unroll
    for (int c = 0; c < 4; ++c) o[c] = acc[c] * il;
    if (a.headnorm) { float ss = (lane < a.dv) ? o[0] * o[0] : 0.f; ss = wave_sum(ss); const float rs = rsqrtf(ss / (float)a.dv + EPS_); o[0] *= rs; }
#pragma unroll
    for (int c = 0; c < 4; ++c) { const int d = lane + 64 * c; if (d < a.dv) a.O[(size_t)(b * a.Sq + q) * a.ldo + h * a.dv + d] = f2bf(o[c]); }
}

__global__ void nk_conv(const bf16_t* PROJ, const float* cw, bf16_t* Y) {
    const int w = (blockIdx.x * blockDim.x + threadIdx.x) >> 6, lane = threadIdx.x & 63;
    if (w >= T_ * 8) return;
    const int t = w >> 3, g = w & 7, ch = g * 64 + lane, s = t & (S_ - 1);
    float zc = 0.f;
#pragma unroll
    for (int k = 0; k < 3; ++k) { const int dt = 2 - k; if (s - dt >= 0) { const bf16_t* p = PROJ + (size_t)(t - dt) * PJ; zc += cw[k * 512 + ch] * bf2f(p[1536 + ch]) * bf2f(p[2048 + ch]); } }
    const float y = bf2f(PROJ[(size_t)t * PJ + 1024 + ch]) * zc;
    const float ms = wave_sum(y * y) * (1.f / 64.f);
    Y[(size_t)t * 1024 + 512 + ch] = f2bf(y * rsqrtf(ms + EPS_));
}

__device__ __forceinline__ void wave_argmax(float& v, int& i) {
#pragma unroll
    for (int o = 1; o < 64; o <<= 1) { const float ov = __shfl_xor(v, o); const int oi = __shfl_xor(i, o); if (ov > v || (ov == v && oi < i)) { v = ov; i = oi; } }
}
__global__ void __launch_bounds__(256) nk_route(const bf16_t* QP, const float* SK, int* RIDX, float* RGATE) {
    __shared__ float st[4][2][16];
    __shared__ int it[4][2][16];
    const int wl = threadIdx.x >> 6, lane = threadIdx.x & 63;
    const int w = blockIdx.x * 4 + wl; const int t = w >> 3, h = w & 7;
    for (int c = 0; c < 2; ++c) {
        const bf16_t* q = QP + (size_t)t * 1024 + h * 128 + c * 64;
        const float* k0 = SK + ((size_t)(h * 2 + c) * 128 + lane) * 64;
        const float* k1 = k0 + 64 * 64;
        float s0 = 0.f, s1 = 0.f;
        for (int d = 0; d < 64; ++d) { const float qd = bf2f(q[d]); s0 += qd * k0[d]; s1 += qd * k1[d]; }
        for (int r = 0; r < 16; ++r) {
            float v; int i;
            if (s0 >= s1) { v = s0; i = lane; } else { v = s1; i = lane + 64; }
            wave_argmax(v, i);
            if (i == lane) s0 = -INFINITY; if (i == lane + 64) s1 = -INFINITY;
            if (lane == 0) { st[wl][c][r] = v; it[wl][c][r] = i; }
        }
    }
    asm volatile("s_waitcnt lgkmcnt(0)" ::: "memory");
    float cs[4]; int ci[4];
#pragma unroll
    for (int j = 0; j < 4; ++j) { const int c = lane * 4 + j; cs[j] = st[wl][0][c >> 4] + st[wl][1][c & 15]; ci[j] = c; }
    float bv_keep = 0.f; int bi_keep = 0;
    float mx = 0.f;
    for (int r = 0; r < 16; ++r) {
        float v = cs[0]; int i = ci[0];
#pragma unroll
        for (int j = 1; j < 4; ++j) if (cs[j] > v) { v = cs[j]; i = ci[j]; }
        wave_argmax(v, i);
#pragma unroll
        for (int j = 0; j < 4; ++j) if (ci[j] == i) cs[j] = -INFINITY;
        if (r == 0) mx = v;
        if (lane == r) { bv_keep = v; bi_keep = i; }
    }
    float e = (lane < 16) ? expf(bv_keep - mx) : 0.f;
    const float sum = wave_sum(e);
    if (lane < 16) {
        RIDX[(size_t)t * 128 + h * 16 + lane] = it[wl][0][bi_keep >> 4] * 128 + it[wl][1][bi_keep & 15];
        RGATE[(size_t)t * 128 + h * 16 + lane] = e / sum;
    }
}

__device__ __forceinline__ float gelu_tanh(float x) { const float u = 0.7978845608028654f * (x + 0.044715f * x * x * x); return 0.5f * x * (1.f + tanhf(u)); }

__global__ void __launch_bounds__(256) nk_peer(const bf16_t* H2, const float* RS2, const float* g_ffn, const float* U, const float* Vt, const int* RIDX, const float* RGATE, const float* g_final, float* out) {
    const int t = (blockIdx.x * blockDim.x + threadIdx.x) >> 6, lane = threadIdx.x & 63;
    if (t >= T_) return;
    float h[16], hn[16], acc[16];
    const float rs = RS2[t];
#pragma unroll
    for (int j = 0; j < 16; ++j) { const int d = j * 64 + lane; h[j] = bf2f(H2[(size_t)t * 1024 + d]); hn[j] = h[j] * rs * g_ffn[d]; acc[j] = 0.f; }
    for (int e = 0; e < 128; ++e) {
        const int idx = RIDX[(size_t)t * 128 + e]; const float gate = RGATE[(size_t)t * 128 + e];
        const float* u = U + (size_t)idx * 1024; const float* v = Vt + (size_t)idx * 1024;
        float s = 0.f;
#pragma unroll
        for (int j = 0; j < 16; ++j) s += hn[j] * u[j * 64 + lane];
        s = wave_sum(s);
        const float a = gelu_tanh(s) * gate;
#pragma unroll
        for (int j = 0; j < 16; ++j) acc[j] += a * v[j * 64 + lane];
    }
    float ss = 0.f;
#pragma unroll
    for (int j = 0; j < 16; ++j) { h[j] += acc[j]; ss += h[j] * h[j]; }
    ss = wave_sum(ss);
    const float r = rsqrtf(ss * (1.f / 1024.f) + EPS_);
#pragma unroll
    for (int j = 0; j < 16; ++j) { const int d = j * 64 + lane; out[(size_t)t * 1024 + d] = h[j] * r * g_final[d]; }
}

static void ngemm(hipStream_t st, const bf16_t* A, int lda, const float* B, int ldb, bf16_t* C, int ldc, int M, int N, int K,
                  const float* kscale, const float* rowscale, float outscale, const void* R, int ldr, int r_is_f32, int trans_out) {
    NGemm g; memset(&g, 0, sizeof g);
    g.A = A; g.B = B; g.C = C; g.kscale = kscale; g.rowscale = rowscale; g.R = R; g.lda = lda; g.ldb = ldb; g.ldc = ldc; g.M = M; g.N = N; g.K = K; g.ldr = ldr; g.r_is_f32 = r_is_f32; g.trans_out = trans_out; g.outscale = outscale;
    hipLaunchKernelGGL(nk_gemm, dim3((N + 63) / 64, M / 64), dim3(256), 0, st, g);
}

extern "C" void kernel_launch(void* const* d_in, const int* in_sizes, int n_in, void* d_out, int out_size, void* d_ws, size_t ws_size, hipStream_t stream) {
    const float* x = (const float*)d_in[0]; const float* mem = (const float*)d_in[1]; const int* pos = (const int*)d_in[2];
    const float* g_mix = (const float*)d_in[3]; const float* w_in = (const float*)d_in[4]; const float* g_q = (const float*)d_in[5];
    const float* w_uq = (const float*)d_in[6]; const float* g_kv = (const float*)d_in[7]; const float* w_ukv = (const float*)d_in[8];
    const float* conv_w = (const float*)d_in[9]; const float* g_out = (const float*)d_in[10]; const float* w_o = (const float*)d_in[11];
    const float* g_x = (const float*)d_in[12]; const float* g_mem = (const float*)d_in[13]; const float* w_xq = (const float*)d_in[14];
    const float* w_xkv = (const float*)d_in[15]; const float* w_xo = (const float*)d_in[16]; const float* g_ffn = (const float*)d_in[17];
    const float* w_pq = (const float*)d_in[18]; const float* sub_keys = (const float*)d_in[19]; const float* u_exp = (const float*)d_in[20];
    const float* v_exp = (const float*)d_in[21]; const float* g_final = (const float*)d_in[22];
    float* out = (float*)d_out; unsigned char* ws = (unsigned char*)d_ws;
    if (ws_size < WS_END) return;
    float* COS = (float*)(ws + WS_COS); float* SIN = (float*)(ws + WS_SIN);
    bf16_t* MEMN = (bf16_t*)(ws + WS_MEMN); bf16_t* KX = (bf16_t*)(ws + WS_KX); bf16_t* VXT = (bf16_t*)(ws + WS_VXT);
    float* RSQ = (float*)(ws + WS_RS); float* RSKV = RSQ + T_; float* RS1 = RSKV + T_; float* RS2 = RS1 + T_;
    int* RIDX = (int*)(ws + WS_RIDX); float* RGATE = (float*)(ws + WS_RGATE);
    bf16_t* XN = (bf16_t*)(ws + WS_RA); bf16_t* KVRAW = XN; bf16_t* Y = XN; bf16_t* QX = XN; bf16_t* H2 = XN;
    bf16_t* PROJ = (bf16_t*)(ws + WS_RB); bf16_t* H1 = PROJ;
    bf16_t* OX = (bf16_t*)(ws + WS_RC); bf16_t* QP = OX;
    bf16_t* Q = (bf16_t*)d_out; bf16_t* K = Q + (size_t)T_ * 768; bf16_t* V = K + (size_t)T_ * 768;

    hipLaunchKernelGGL(nk_rmsnorm, dim3(T_ / 4), dim3(256), 0, stream, x, g_mix, XN, T_);
    hipLaunchKernelGGL(nk_rmsnorm, dim3(TM_ / 4), dim3(256), 0, stream, mem, g_mem, MEMN, TM_);
    hipLaunchKernelGGL(nk_rope_tab, dim3(T_ * 16 / 256), dim3(256), 0, stream, pos, COS, SIN);
    ngemm(stream, XN, 1024, w_in + 0, 2208, PROJ + 0, PJ, T_, 384, 1024, nullptr, nullptr, 1.f, nullptr, 0, 0, 0);
    ngemm(stream, XN, 1024, w_in + 384, 2208, PROJ + 512, PJ, T_, 256, 1024, nullptr, nullptr, 1.f, nullptr, 0, 0, 0);
    ngemm(stream, XN, 1024, w_in + 640, 2208, PROJ + 768, PJ, T_, 32, 1024, nullptr, nullptr, 1.f, nullptr, 0, 0, 0);
    ngemm(stream, XN, 1024, w_in + 672, 2208, PROJ + 1024, PJ, T_, 512, 1024, nullptr, nullptr, 1.f, nullptr, 0, 0, 0);
    ngemm(stream, XN, 1024, w_in + 1184, 2208, PROJ + 1536, PJ, T_, 512, 1024, nullptr, nullptr, 1.f, nullptr, 0, 0, 0);
    ngemm(stream, XN, 1024, w_in + 1696, 2208, PROJ + 2048, PJ, T_, 512, 1024, nullptr, nullptr, 1.f, nullptr, 0, 0, 0);
    hipLaunchKernelGGL(nk_rowstat, dim3(T_ / 4), dim3(256), 0, stream, PROJ, PJ, 0, 384, RSQ, T_);
    hipLaunchKernelGGL(nk_rowstat, dim3(T_ / 4), dim3(256), 0, stream, PROJ, PJ, 512, 256, RSKV, T_);
    ngemm(stream, PROJ, PJ, w_uq, 768, Q, 768, T_, 768, 384, g_q, RSQ, LOG2E / sqrtf(96.f), nullptr, 0, 0, 0);
    ngemm(stream, PROJ + 512, PJ, w_ukv, 1024, KVRAW, 1024, T_, 1024, 256, g_kv, RSKV, 1.f, nullptr, 0, 0, 0);
    hipLaunchKernelGGL(nk_mla_prep, dim3(T_ * 8 / 256), dim3(256), 0, stream, Q, KVRAW, PROJ, COS, SIN, K, V);
    hipLaunchKernelGGL(nk_conv, dim3(T_ * 8 / 4), dim3(256), 0, stream, PROJ, conv_w, Y);
    { NAttn a; memset(&a, 0, sizeof a); a.Q = Q; a.K = K; a.V = V; a.O = Y; a.vs_key = 512; a.vs_d = 1; a.ldq = 768; a.ldk = 768; a.ldo = 1024; a.H = 8; a.Sq = S_; a.Sk = S_; a.dqk = 96; a.dv = 64; a.causal = 1; a.headnorm = 1;
      hipLaunchKernelGGL(nk_attn, dim3(B_ * 8 * S_ / 4), dim3(256), 0, stream, a); }
    ngemm(stream, Y, 1024, w_o, 1024, H1, 1024, T_, 1024, 1024, g_out, nullptr, 1.f, x, 1024, 1, 0);
    hipLaunchKernelGGL(nk_rowstat, dim3(T_ / 4), dim3(256), 0, stream, H1, 1024, 0, 1024, RS1, T_);
    ngemm(stream, H1, 1024, w_xq, 1024, QX, 1024, T_, 1024, 1024, g_x, RS1, LOG2E / 16.f, nullptr, 0, 0, 0);
    ngemm(stream, MEMN, 1024, w_xkv, 2048, KX, 1024, TM_, 1024, 1024, nullptr, nullptr, 1.f, nullptr, 0, 0, 0);
    ngemm(stream, MEMN, 1024, w_xkv + 1024, 2048, VXT, 2048, TM_, 1024, 1024, nullptr, nullptr, 1.f, nullptr, 0, 0, 1);
    { NAttn a; memset(&a, 0, sizeof a); a.Q = QX; a.K = KX; a.V = VXT; a.O = OX; a.vs_key = 1; a.vs_d = 2048; a.ldq = 1024; a.ldk = 1024; a.ldo = 1024; a.H = 4; a.Sq = S_; a.Sk = ML_; a.dqk = 256; a.dv = 256; a.causal = 0; a.headnorm = 0;
      hipLaunchKernelGGL(nk_attn, dim3(B_ * 4 * S_ / 4), dim3(256), 0, stream, a); }
    ngemm(stream, OX, 1024, w_xo, 1024, H2, 1024, T_, 1024, 1024, nullptr, nullptr, 1.f, H1, 1024, 0, 0);
    hipLaunchKernelGGL(nk_rowstat, dim3(T_ / 4), dim3(256), 0, stream, H2, 1024, 0, 1024, RS2, T_);
    ngemm(stream, H2, 1024, w_pq, 1024, QP, 1024, T_, 1024, 1024, g_ffn, RS2, 1.f, nullptr, 0, 0, 0);
    hipLaunchKernelGGL(nk_route, dim3(T_ * 8 / 4), dim3(256), 0, stream, QP, sub_keys, RIDX, RGATE);
    hipLaunchKernelGGL(nk_peer, dim3(T_ / 4), dim3(256), 0, stream, H2, RS2, g_ffn, u_exp, v_exp, RIDX, RGATE, g_final, out);
}
```

```cpp
#include <hip/hip_runtime.h>
#include <stdint.h>
#include <math.h>
#include <string.h>

typedef unsigned short bf16_t;
constexpr int T_ = 16384, D_ = 1024, B_ = 8, S_ = 2048, ML_ = 256, TM_ = 2048;
constexpr int PJ = 2560;
constexpr float EPS_ = 1e-6f;
constexpr float LOG2E = 1.4426950408889634f;

constexpr size_t MiB = 1u << 20;
constexpr size_t WS_CTL = 0;
constexpr size_t WS_COS = 2 * MiB, WS_SIN = 3 * MiB;
constexpr size_t WS_W = 4 * MiB;
constexpr size_t WS_UT = 24 * MiB, WS_VT = 56 * MiB;
constexpr size_t WS_MEMN = 88 * MiB, WS_KX = 92 * MiB, WS_VXT = 96 * MiB;
constexpr size_t WS_RS = 100 * MiB;
constexpr size_t WS_SCL = 105 * MiB;
constexpr size_t WS_RIDX = 106 * MiB, WS_RGATE = 114 * MiB;
constexpr size_t WS_RA = 122 * MiB;
constexpr size_t WS_RB = 154 * MiB;
constexpr size_t WS_RC = 186 * MiB;
constexpr size_t WS_RD = 218 * MiB;
constexpr size_t WS_END = 256 * MiB;

__device__ __forceinline__ float bf2f(bf16_t b) { return __uint_as_float(((unsigned)b) << 16); }
__device__ __forceinline__ bf16_t f2bf(float f) { unsigned u = __float_as_uint(f); return (bf16_t)((u + 0x7fffu + ((u >> 16) & 1u)) >> 16); }
__device__ __forceinline__ unsigned q8pack(float f0, float f1, float f2, float f3, float qs) {
    const unsigned a0 = __float_as_uint(fmaf(f0, qs, 12582912.f)), a1 = __float_as_uint(fmaf(f1, qs, 12582912.f)), a2 = __float_as_uint(fmaf(f2, qs, 12582912.f)), a3 = __float_as_uint(fmaf(f3, qs, 12582912.f));
    return __builtin_amdgcn_perm(a1, a0, 0x0c0c0400u) | __builtin_amdgcn_perm(a3, a2, 0x04000c0cu);
}
__device__ __forceinline__ float wave_sum(float v) {
#pragma unroll
    for (int o = 1; o < 64; o <<= 1) v += __shfl_xor(v, o);
    return v;
}
__device__ __forceinline__ float wave_max(float v) {
#pragma unroll
    for (int o = 1; o < 64; o <<= 1) v = fmaxf(v, __shfl_xor(v, o));
    return v;
}

namespace pg8 {
#define PG8_LAS __attribute__((address_space(3)))
typedef short bf16x8 __attribute__((ext_vector_type(8)));
typedef float f32x4 __attribute__((ext_vector_type(4)));
typedef unsigned u32x4 __attribute__((ext_vector_type(4)));
constexpr int BM = 256, BK = 64, HALF = 128, HTB = HALF * BK * 2  , STAGE_BYTES = 8 * HTB, NXCD = 8, WGM = 8;

__host__ __device__ __forceinline__ int lds_byte(int r, int c) { const int st = (r >> 4) * 2 + (c >> 5), rr = r & 15, cc = c & 31, ob = rr * 64 + cc * 2; return st * 1024 + (ob ^ (((ob >> 9) & 1) << 5)); }
__host__ __device__ __forceinline__ void stage_rc(int b, int& R, int& C) { const int st = b / 1024, sb = b % 1024, swz = sb ^ (((sb >> 9) & 1) << 5); R = (st >> 1) * 16 + swz / 64; C = (st & 1) * 32 + (swz % 64) / 2; }
__host__ __device__ __forceinline__ int perm32(int rho) { const int n = rho >> 4, i = rho & 15; return 8 * (i >> 2) + 4 * n + (i & 3); }

struct Unit { int pm, pn; };
struct Gemm { const bf16_t* A; const bf16_t* Bt; int lda, ldb, M, N, K; };

struct StaticOrder {
    int nM, nN, nwg, G, c;
    __host__ __device__ __forceinline__ void init(int M, int N, int G_, int c_) { nM = M / BM; nN = N / BM; nwg = nM * nN; G = G_; c = c_; }
    __host__ __device__ __forceinline__ bool next(int i, Unit& u) const {
        const long L = (long)i * G + c; if (L >= nwg) return false;
        int wgid = (int)L; { const int q = nwg / NXCD, r = nwg % NXCD, xcd = wgid % NXCD, off = wgid / NXCD; wgid = (xcd < r ? xcd * (q + 1) : r * (q + 1) + (xcd - r) * q) + off; }
        const int nig = WGM * nN, gid = wgid / nig, fm = gid * WGM, gsz = (nM - fm) < WGM ? (nM - fm) : WGM;
        u.pm = fm + ((wgid % nig) % gsz); u.pn = (wgid % nig) / gsz; return true;
    }
    __device__ __forceinline__ void a_ready(const Unit&) const {}
    __device__ __forceinline__ void done(const Unit&) const {}
};

__device__ __forceinline__ unsigned cvt_pk_bf16(float lo, float hi) { unsigned r; asm volatile("v_cvt_pk_bf16_f32 %0, %1, %2" : "=v"(r) : "v"(lo), "v"(hi)); return r; }
__device__ __forceinline__ float bflo(unsigned w) { return __uint_as_float(w << 16); }
__device__ __forceinline__ float bfhi(unsigned w) { return __uint_as_float(w & 0xffff0000u); }

template <int MODE, bool RSCALE, int RES  , bool PSS>
struct EpiGen {
    static constexpr bool PERM = true, AFTER_DRAIN = false;
    bf16_t* O; int ldc; bf16_t* O2;
    const float* parts; int nparts; float inv_dim; float cscale;
    const void* R; int ldr;
    float* pss; int pss_tiles; int rows_total;
    const float* COS; const float* SIN;
    __device__ __forceinline__ void operator()(const f32x4 (&acc)[2][2][4][2], const Unit& u, int wr, int wc, int fr, int fq) const {
        { int ln = __builtin_amdgcn_mbcnt_hi(~0u, __builtin_amdgcn_mbcnt_lo(~0u, 0u)); asm volatile("" : "+v"(ln)); fr = ln & 15; fq = ln >> 4; }
        const int row0 = u.pm * BM + wr * 64 + fr;
        const int colb = u.pn * BM + wc * 32 + 8 * fq;
#pragma unroll
        for (int ai = 0; ai < 2; ++ai)
#pragma unroll
            for (int m = 0; m < 4; ++m) {
                const int row = row0 + ai * HALF + m * 16;
                float rs = cscale;
                if (RSCALE) { float s = 0.f; for (int p = fq; p < nparts; p += 4) s += parts[(size_t)p * rows_total + row]; s += __shfl_xor(s, 16); s += __shfl_xor(s, 32); rs *= rsqrtf(s * inv_dim + 1e-6f); }
                float ss = 0.f;
#pragma unroll
                for (int bj = 0; bj < 2; ++bj) {
                    const int col = colb + bj * HALF;
                    f32x4 v0 = acc[ai][bj][m][0] * rs, v1 = acc[ai][bj][m][1] * rs;
                    if (RES == 1) { const float* r = (const float*)R + (size_t)row * ldr + col; v0 += *(const f32x4*)r; v1 += *(const f32x4*)(r + 4); }
                    if (RES == 2) { const u32x4 w = *(const u32x4*)((const bf16_t*)R + (size_t)row * ldr + col);
                        v0 += (f32x4){bflo(w.x), bfhi(w.x), bflo(w.y), bfhi(w.y)}; v1 += (f32x4){bflo(w.z), bfhi(w.z), bflo(w.w), bfhi(w.w)}; }
                    if (PSS) ss += (v0[0] * v0[0] + v0[1] * v0[1]) + (v0[2] * v0[2] + v0[3] * v0[3]) + (v1[0] * v1[0] + v1[1] * v1[1]) + (v1[2] * v1[2] + v1[3] * v1[3]);
                    bf16_t* dst;
                    if (MODE == 1) {
                        const int pr = col % 96;
                        if (pr >= 64) { const int i0 = (pr - 64) >> 1; const f32x4 c = *(const f32x4*)(COS + (size_t)row * 16 + i0), s = *(const f32x4*)(SIN + (size_t)row * 16 + i0);
                            const f32x4 a0 = v0, a1 = v1;
                            v0[0] = a0[0] * c[0] - a0[1] * s[0]; v0[1] = a0[1] * c[0] + a0[0] * s[0]; v0[2] = a0[2] * c[1] - a0[3] * s[1]; v0[3] = a0[3] * c[1] + a0[2] * s[1];
                            v1[0] = a1[0] * c[2] - a1[1] * s[2]; v1[1] = a1[1] * c[2] + a1[0] * s[2]; v1[2] = a1[2] * c[3] - a1[3] * s[3]; v1[3] = a1[3] * c[3] + a1[2] * s[3]; }
                        dst = O + (size_t)row * 768 + col;
                    } else if (MODE == 2) {
                        if (col < 512) dst = O + (size_t)row * 768 + (col >> 6) * 96 + (col & 63); else dst = O2 + (size_t)row * 512 + (col - 512);
                    } else dst = O + (size_t)row * ldc + col;
                    u32x4 w; w.x = cvt_pk_bf16(v0[0], v0[1]); w.y = cvt_pk_bf16(v0[2], v0[3]); w.z = cvt_pk_bf16(v1[0], v1[1]); w.w = cvt_pk_bf16(v1[2], v1[3]);
                    *(u32x4*)dst = w;
                }
                if (PSS) { if (u.pn < pss_tiles) { ss += __shfl_xor(ss, 16); ss += __shfl_xor(ss, 32); if (fq == 0) pss[(size_t)(u.pn * 4 + wc) * rows_total + row] = ss; } }
                asm volatile("" ::: "memory");
            }
    }
};

struct SingleUnit {
    __device__ __forceinline__ bool next(int i, Unit& u) const { if (i > 0) return false; u.pm = 0; u.pn = 0; return true; }
    __device__ __forceinline__ void a_ready(const Unit&) const {}
    __device__ __forceinline__ void done(const Unit&) const {}
};
struct FixedUnit {
    int pm, pn;
    __device__ __forceinline__ bool next(int i, Unit& u) const { if (i > 0) return false; u.pm = pm; u.pn = pn; return true; }
    __device__ __forceinline__ void a_ready(const Unit&) const {}
    __device__ __forceinline__ void done(const Unit&) const {}
};

struct EpiSoftmax {
    static constexpr bool PERM = true, AFTER_DRAIN = true;
    bf16_t* O; int ldc;
    __device__ __forceinline__ void fused(f32x4 (&acc)[2][2][4][2], const Unit& u, int wr, int wc, int fr, int fq, PG8_LAS unsigned char* lds, int wid, int lane) const {
        PG8_LAS float* PM = (PG8_LAS float*)lds;
        PG8_LAS float* PS = (PG8_LAS float*)(lds + 4096);
#pragma unroll
        for (int ai = 0; ai < 2; ++ai)
#pragma unroll
            for (int m = 0; m < 4; ++m) {
                const int row = ai * HALF + wr * 64 + m * 16 + fr;
                float mx = -INFINITY;
#pragma unroll
                for (int bj = 0; bj < 2; ++bj)
#pragma unroll
                    for (int n = 0; n < 2; ++n) { const f32x4 v = acc[ai][bj][m][n]; mx = fmaxf(mx, fmaxf(fmaxf(v[0], v[1]), fmaxf(v[2], v[3]))); }
                mx = fmaxf(mx, __shfl_xor(mx, 16)); mx = fmaxf(mx, __shfl_xor(mx, 32));
                if (fq == 0) PM[row * 4 + wc] = mx;
            }
        asm volatile("s_waitcnt lgkmcnt(0)" ::: "memory"); __builtin_amdgcn_s_barrier(); asm volatile("" ::: "memory");
#pragma unroll
        for (int ai = 0; ai < 2; ++ai)
#pragma unroll
            for (int m = 0; m < 4; ++m) {
                const int row = ai * HALF + wr * 64 + m * 16 + fr;
                const f32x4 pm = *(const PG8_LAS f32x4*)(PM + row * 4);
                const float mrow = fmaxf(fmaxf(pm[0], pm[1]), fmaxf(pm[2], pm[3]));
                float sm = 0.f;
#pragma unroll
                for (int bj = 0; bj < 2; ++bj)
#pragma unroll
                    for (int n = 0; n < 2; ++n) { f32x4 v = acc[ai][bj][m][n];
                        v[0] = __builtin_amdgcn_exp2f(v[0] - mrow); v[1] = __builtin_amdgcn_exp2f(v[1] - mrow); v[2] = __builtin_amdgcn_exp2f(v[2] - mrow); v[3] = __builtin_amdgcn_exp2f(v[3] - mrow);
                        sm += (v[0] + v[1]) + (v[2] + v[3]); acc[ai][bj][m][n] = v; }
                sm += __shfl_xor(sm, 16); sm += __shfl_xor(sm, 32);
                if (fq == 0) PS[row * 4 + wc] = sm;
            }
        asm volatile("s_waitcnt lgkmcnt(0)" ::: "memory"); __builtin_amdgcn_s_barrier(); asm volatile("" ::: "memory");
#pragma unroll
        for (int ai = 0; ai < 2; ++ai)
#pragma unroll
            for (int m = 0; m < 4; ++m) {
                const int row = ai * HALF + wr * 64 + m * 16 + fr;
                const f32x4 ps = *(const PG8_LAS f32x4*)(PS + row * 4);
                const float inv = 1.f / ((ps[0] + ps[1]) + (ps[2] + ps[3]));
#pragma unroll
                for (int bj = 0; bj < 2; ++bj) {
                    const f32x4 v0 = acc[ai][bj][m][0] * inv, v1 = acc[ai][bj][m][1] * inv;
                    u32x4 w; w.x = cvt_pk_bf16(v0[0], v0[1]); w.y = cvt_pk_bf16(v0[2], v0[3]); w.z = cvt_pk_bf16(v1[0], v1[1]); w.w = cvt_pk_bf16(v1[2], v1[3]);
                    *(u32x4*)(O + (size_t)row * ldc + bj * HALF + wc * 32 + 8 * fq) = w;
                }
            }
        asm volatile("s_waitcnt vmcnt(0) lgkmcnt(0)" ::: "memory"); __builtin_amdgcn_s_barrier(); asm volatile("" ::: "memory");
    }
};

template <class Epi, class Sched, bool ALIGN_EPI = false, bool SP2 = false>
__device__ __forceinline__ void gemm_phase(PG8_LAS unsigned char* lds, const Gemm g, const Sched& S, const Epi& E, const int wid_in  ) {
    int lane_ = __builtin_amdgcn_mbcnt_hi(~0u, __builtin_amdgcn_mbcnt_lo(~0u, 0u)); asm volatile("" : "+v"(lane_));
    const int wid = wid_in, lane = lane_, tid = wid * 64 + lane, wr = wid >> 2, wc = wid & 3, fr = lane & 15, fq = lane >> 4;
    const int K = g.K, nt = K / BK;
    unsigned voffA[2], voffB[2];
#pragma unroll
    for (int i = 0; i < 2; ++i) { int R, C; stage_rc(tid * 16 + i * 8192, R, C); const int Rb = Epi::PERM ? ((R & ~31) + perm32(R & 31)) : R;
        voffA[i] = (unsigned)(R * g.lda + C) * 2u; voffB[i] = (unsigned)(Rb * g.ldb + C) * 2u; }
    const size_t kstep = (size_t)(BK * 2);
    const size_t hstepA = (size_t)HALF * g.lda * 2, hstepB = (size_t)HALF * g.ldb * 2;
    const size_t tstepA = 2 * hstepA, tstepB = 2 * hstepB;
    const unsigned ldsw = (unsigned)wid * 1024u;
    const int aoff = lds_byte(wr * 64 + fr, fq * 8), boff = lds_byte(wc * 32 + fr, fq * 8);
#define PG8_SA(b, h) (((b) * 2 + (h)) * HTB)
#define PG8_SB(b, h) ((4 + (b) * 2 + (h)) * HTB)
#define PG8_STAGE(bufoff, gbase, voff) do { _Pragma("unroll") for (int _i = 0; _i < 2; ++_i) \
        __builtin_amdgcn_global_load_lds((const unsigned*)((const char*)(gbase) + (voff)[_i]), (PG8_LAS unsigned*)(lds + (bufoff) + ldsw + _i * 8192), 16, 0, 0); } while (0)
#define PG8_LDA(dst, b, h) do { _Pragma("unroll") for (int m = 0; m < 4; ++m) _Pragma("unroll") for (int k = 0; k < 2; ++k) dst[m][k] = *(const PG8_LAS bf16x8*)(lds + PG8_SA(b, h) + aoff + m * 2048 + k * 1024); } while (0)
#define PG8_LDB(dst, b, h) do { _Pragma("unroll") for (int n = 0; n < 2; ++n) _Pragma("unroll") for (int k = 0; k < 2; ++k) dst[n][k] = *(const PG8_LAS bf16x8*)(lds + PG8_SB(b, h) + boff + n * 2048 + k * 1024); } while (0)
#define PG8_MMA(ai, bj, At, Bt) do { __builtin_amdgcn_s_setprio(1); _Pragma("unroll") for (int m = 0; m < 4; ++m) _Pragma("unroll") for (int n = 0; n < 2; ++n) _Pragma("unroll") for (int k = 0; k < 2; ++k) \
        acc[ai][bj][m][n] = __builtin_amdgcn_mfma_f32_16x16x32_bf16(Bt[n][k], At[m][k], acc[ai][bj][m][n], 0, 0, 0); __builtin_amdgcn_s_setprio(0); } while (0)
#define PG8_WAIT_V(n) asm volatile("s_waitcnt vmcnt(" #n ")" ::: "memory")
#define PG8_WAIT_L(n) asm volatile("s_waitcnt lgkmcnt(" #n ")" ::: "memory")
#define PG8_BAR __builtin_amdgcn_s_barrier()
#define PG8_SCHED __builtin_amdgcn_sched_barrier(0)
    Unit cur, nxt; int ui = 0;
    if (!S.next(0, cur)) return;
    f32x4 acc[2][2][4][2];
#pragma unroll
    for (int a = 0; a < 2; ++a)
#pragma unroll
        for (int b = 0; b < 2; ++b)
#pragma unroll
            for (int m = 0; m < 4; ++m)
#pragma unroll
                for (int n = 0; n < 2; ++n) acc[a][b][m][n] = (f32x4){0.f, 0.f, 0.f, 0.f};
    bf16x8 At[4][2], B0[2][2], B1[2][2];
    const char* cA = (const char*)g.A + (size_t)cur.pm * tstepA; const char* cB = (const char*)g.Bt + (size_t)cur.pn * tstepB;
    S.a_ready(cur);
    if constexpr (SP2) {
        PG8_STAGE(PG8_SB(0, 0), cB, voffB); PG8_STAGE(PG8_SB(0, 1), cB + hstepB, voffB); PG8_STAGE(PG8_SA(0, 0), cA, voffA); PG8_STAGE(PG8_SA(0, 1), cA + hstepA, voffA);
        if (wr == 1) PG8_BAR;
        PG8_WAIT_V(2); PG8_BAR;
        PG8_STAGE(PG8_SB(1, 0), cB + kstep, voffB); PG8_STAGE(PG8_SA(1, 0), cA + kstep, voffA); PG8_STAGE(PG8_SB(1, 1), cB + hstepB + kstep, voffB);
        PG8_WAIT_V(6); PG8_BAR;
    } else {
        PG8_STAGE(PG8_SB(0, 0), cB, voffB); PG8_STAGE(PG8_SA(0, 0), cA, voffA); PG8_STAGE(PG8_SB(0, 1), cB + hstepB, voffB); PG8_STAGE(PG8_SA(0, 1), cA + hstepA, voffA);
        if (wr == 1) PG8_BAR;
        PG8_WAIT_V(4); PG8_BAR;
        PG8_STAGE(PG8_SB(1, 0), cB + kstep, voffB); PG8_STAGE(PG8_SA(1, 0), cA + kstep, voffA); PG8_STAGE(PG8_SB(1, 1), cB + hstepB + kstep, voffB);
        PG8_WAIT_V(6); PG8_BAR;
    }
    for (;;) {
        const bool has_next = S.next(ui + 1, nxt);
        const char* nA = has_next ? (const char*)g.A + (size_t)nxt.pm * tstepA : cA; const char* nB = has_next ? (const char*)g.Bt + (size_t)nxt.pn * tstepB : cB;
#pragma unroll 1
        for (int t = 0; t < nt; t += 2) {
            const bool last = (t == nt - 2);
            const char* a1 = cA + (size_t)(t + 1) * kstep;
            const char* a2 = last ? nA : cA + (size_t)(t + 2) * kstep; const char* b2 = last ? nB : cB + (size_t)(t + 2) * kstep;
            const char* a3 = a2 + kstep; const char* b3 = b2 + kstep;
            if (last && has_next) S.a_ready(nxt);
            if constexpr (SP2) {
            PG8_LDB(B0, 0, 0); PG8_LDB(B1, 0, 1); PG8_SCHED; PG8_LDA(At, 0, 0); PG8_STAGE(PG8_SA(1, 1), a1 + hstepA, voffA);
            PG8_WAIT_V(8); PG8_WAIT_L(0); PG8_BAR; PG8_MMA(0, 0, At, B0); PG8_MMA(0, 1, At, B1); PG8_BAR; PG8_SCHED;
            PG8_LDA(At, 0, 1); PG8_STAGE(PG8_SB(0, 0), b2, voffB); PG8_STAGE(PG8_SB(0, 1), b2 + hstepB, voffB); PG8_STAGE(PG8_SA(0, 0), a2, voffA);
            PG8_WAIT_V(8); PG8_WAIT_L(0); PG8_BAR; PG8_MMA(1, 0, At, B0); PG8_MMA(1, 1, At, B1); PG8_BAR; PG8_SCHED;
            PG8_LDB(B0, 1, 0); PG8_LDB(B1, 1, 1); PG8_SCHED; PG8_LDA(At, 1, 0); PG8_STAGE(PG8_SA(0, 1), a2 + hstepA, voffA);
            PG8_WAIT_V(8); PG8_WAIT_L(0); PG8_BAR; PG8_MMA(0, 0, At, B0); PG8_MMA(0, 1, At, B1); PG8_BAR; PG8_SCHED;
            PG8_LDA(At, 1, 1); PG8_STAGE(PG8_SB(1, 0), b3, voffB); PG8_STAGE(PG8_SB(1, 1), b3 + hstepB, voffB); PG8_STAGE(PG8_SA(1, 0), a3, voffA);
            PG8_WAIT_V(8); PG8_WAIT_L(0); PG8_BAR; PG8_MMA(1, 0, At, B0); PG8_MMA(1, 1, At, B1); PG8_BAR; PG8_SCHED;
            } else {
            PG8_LDB(B0, 0, 0); PG8_SCHED; PG8_LDA(At, 0, 0); PG8_STAGE(PG8_SA(1, 1), a1 + hstepA, voffA);
            PG8_WAIT_L(8); PG8_BAR; PG8_WAIT_L(0); PG8_MMA(0, 0, At, B0); PG8_BAR; PG8_SCHED;
            PG8_LDB(B1, 0, 1); PG8_STAGE(PG8_SB(0, 0), b2, voffB);
            PG8_BAR; PG8_WAIT_L(0); PG8_MMA(0, 1, At, B1); PG8_BAR;
            PG8_LDA(At, 0, 1); PG8_STAGE(PG8_SA(0, 0), a2, voffA);
            PG8_BAR; PG8_WAIT_L(0); PG8_MMA(1, 0, At, B0); PG8_BAR; PG8_SCHED;
            PG8_STAGE(PG8_SB(0, 1), b2 + hstepB, voffB);
            PG8_WAIT_V(6); PG8_BAR; PG8_MMA(1, 1, At, B1); PG8_BAR;
            PG8_LDB(B0, 1, 0); PG8_SCHED; PG8_LDA(At, 1, 0); PG8_STAGE(PG8_SA(0, 1), a2 + hstepA, voffA);
            PG8_WAIT_L(8); PG8_BAR; PG8_WAIT_L(0); PG8_MMA(0, 0, At, B0); PG8_BAR; PG8_SCHED;
            PG8_LDB(B1, 1, 1); PG8_STAGE(PG8_SB(1, 0), b3, voffB);
            PG8_BAR; PG8_WAIT_L(0); PG8_MMA(0, 1, At, B1); PG8_BAR;
            PG8_LDA(At, 1, 1); PG8_STAGE(PG8_SA(1, 0), a3, voffA);
            PG8_BAR; PG8_WAIT_L(0); PG8_MMA(1, 0, At, B0); PG8_BAR; PG8_SCHED;
            PG8_STAGE(PG8_SB(1, 1), b3 + hstepB, voffB);
            PG8_WAIT_V(6); PG8_BAR; PG8_MMA(1, 1, At, B1); PG8_BAR;
            }
        }
        if constexpr (ALIGN_EPI) { if (wr == 0) PG8_BAR; }
        if constexpr (!Epi::AFTER_DRAIN) { E(acc, cur, wr, wc, fr, fq); S.done(cur); }
        if (!has_next) break;
#pragma unroll
        for (int a = 0; a < 2; ++a)
#pragma unroll
            for (int b = 0; b < 2; ++b)
#pragma unroll
                for (int m = 0; m < 4; ++m)
#pragma unroll
                    for (int n = 0; n < 2; ++n) acc[a][b][m][n] = (f32x4){0.f, 0.f, 0.f, 0.f};
        cur = nxt; cA = nA; cB = nB; ++ui;
        if constexpr (ALIGN_EPI) { if (wr == 1) PG8_BAR; }
    }
    PG8_WAIT_V(0);
    if constexpr (!ALIGN_EPI) { if (wr == 0) PG8_BAR; }
    PG8_BAR;
    if constexpr (Epi::AFTER_DRAIN) { E.fused(acc, cur, wr, wc, fr, fq, lds, wid, lane); S.done(cur); }
#undef PG8_SA
#undef PG8_SB
#undef PG8_STAGE
#undef PG8_LDA
#undef PG8_LDB
#undef PG8_MMA
#undef PG8_WAIT_V
#undef PG8_WAIT_L
#undef PG8_BAR
#undef PG8_SCHED
}
}
#ifndef PG8_SP2
#define PG8_SP2 true
#endif
#ifndef PG8_ALIGN
#define PG8_ALIGN true
#endif

constexpr int NWAVES = 8;
constexpr int RING_OFF = 0, RING_BYTES = 131072;
constexpr int LDSCTL_OFF = RING_BYTES, MISC_OFF = LDSCTL_OFF + 320;
constexpr int LDS_BYTES = 147456;
constexpr int CW_BAR = 4096;
constexpr size_t CTL_ZERO_BYTES = 64 * 1024;

constexpr size_t WO_WIN = WS_W;
constexpr size_t WO_WUQ = WO_WIN + (size_t)2560 * 1024 * 2;
constexpr size_t WO_WUKV = WO_WUQ + (size_t)768 * 384 * 2;
constexpr size_t WO_WO = WO_WUKV + (size_t)1024 * 256 * 2;
constexpr size_t WO_WXQ = WO_WO + (size_t)1024 * 1024 * 2;
constexpr size_t WO_WXKV = WO_WXQ + (size_t)1024 * 1024 * 2;
constexpr size_t WO_WXO = WO_WXKV + (size_t)2048 * 1024 * 2;
constexpr size_t WO_WPQ = WO_WXO + (size_t)1024 * 1024 * 2;
constexpr size_t WO_SK = WO_WPQ + (size_t)1024 * 1024 * 2;
constexpr size_t WO_END = WO_SK + (size_t)16 * 128 * 64 * 2;
static_assert(WO_END <= WS_UT, "weights region");
constexpr size_t PSS1_OFF = WS_RS;
constexpr size_t PSS4_OFF = PSS1_OFF + (size_t)12 * T_ * 4;
constexpr size_t PSS6_OFF = PSS4_OFF + (size_t)16 * T_ * 4;
static_assert(PSS6_OFF + (size_t)16 * T_ * 4 <= WS_RIDX, "pss region");

#define GAS __attribute__((address_space(1)))
#define LAS __attribute__((address_space(3)))
typedef unsigned v4u __attribute__((ext_vector_type(4)));
typedef float f32x4 __attribute__((ext_vector_type(4)));
typedef GAS unsigned gu32;
#define RLX_AGENT __ATOMIC_RELAXED, __HIP_MEMORY_SCOPE_AGENT
#define LDS_WAIT() asm volatile("s_waitcnt lgkmcnt(0)" ::: "memory")
#define VM_WAIT() asm volatile("s_waitcnt vmcnt(0)" ::: "memory")
__device__ __forceinline__ unsigned pk2(float lo, float hi) { return (unsigned)f2bf(lo) | ((unsigned)f2bf(hi) << 16); }

#define XB_TMO      128
#define XB_XCNT(j)  (256  + 64 * (j))
#define XB_XSUB(j)  (1280 + 64 * (j))
#define XB_XGEN(j)  (2304 + 64 * (j))
#define XB_TOP      3328
#define XB_TOPGEN   3392
#define XCD_BAR_WORDS 3456
#define XB_SPIN_CAP (1u << 18)
__device__ __forceinline__ unsigned xb_ld(unsigned* p)              { return __hip_atomic_load(p, __ATOMIC_RELAXED, __HIP_MEMORY_SCOPE_AGENT); }
__device__ __forceinline__ unsigned xb_add(unsigned* p, unsigned v) { return __hip_atomic_fetch_add(p, v, __ATOMIC_RELAXED, __HIP_MEMORY_SCOPE_AGENT); }
__device__ __forceinline__ unsigned xb_xcc_id() { return (unsigned)__builtin_amdgcn_s_getreg((3 << 11) | 20) & 0xFu; }
#define XB_SPIN(cond, bar) do { unsigned _sp = 0; while (cond) { __builtin_amdgcn_s_sleep(1); \
    if ((++_sp & 255u) == 0u) { if (xb_ld(&(bar)[XB_TMO])) break; if (_sp > XB_SPIN_CAP) { atomicAdd(&(bar)[XB_TMO], 1u); break; } } } } while (0)
struct XcdBarrier { unsigned* bar; unsigned x; volatile LAS unsigned* st; };
__device__ __forceinline__ XcdBarrier xcd_barrier_post(unsigned* bar, volatile LAS unsigned* st) {
    XcdBarrier b; b.bar = bar; b.x = xb_xcc_id(); b.st = st;
    if (threadIdx.x == 0) (void)xb_add(&bar[XB_XCNT(b.x)], 1u);
    return b;
}
__device__ __forceinline__ void xcd_barrier_complete(unsigned* bar, unsigned x, unsigned& nloc, unsigned& nx) {
    const unsigned G = gridDim.x * gridDim.y * gridDim.z;
    unsigned sum, cnt, mine, sp = 0u;
    for (;;) {
        sum = 0u; cnt = 0u; mine = 0u;
#pragma unroll
        for (unsigned j = 0; j < 16; ++j) { const unsigned c = xb_ld(&bar[XB_XCNT(j)]); sum += c; cnt += (c > 0u) ? 1u : 0u; mine = (j == x) ? c : mine; }
        if (sum == G) break;
        __builtin_amdgcn_s_sleep(1);
        if ((++sp & 255u) == 0u) { if (xb_ld(&bar[XB_TMO])) break; if (sp > XB_SPIN_CAP) { atomicAdd(&bar[XB_TMO], 1u); break; } }
    }
    nloc = mine > 0u ? mine : 1u; nx = cnt > 0u ? cnt : 1u;
}
__device__ __forceinline__ void xcd_barrier(const XcdBarrier& b) {
    asm volatile("s_waitcnt vmcnt(0)" ::: "memory");
    __syncthreads();
    if (threadIdx.x == 0) {
        unsigned* bar = b.bar;
        __builtin_amdgcn_s_waitcnt(0);
        unsigned nloc = b.st[0], nx = b.st[1];
        if (nloc == 0u) { xcd_barrier_complete(bar, b.x, nloc, nx); b.st[0] = nloc; b.st[1] = nx; }
        const unsigned old = xb_add(&bar[XB_XSUB(b.x)], 1u);
        const unsigned gen = old / nloc;
        if (old + 1u == (gen + 1u) * nloc) {
            __builtin_amdgcn_fence(__ATOMIC_RELEASE, "agent");
            asm volatile("s_waitcnt vmcnt(0)" ::: "memory");
            const unsigned og = xb_add(&bar[XB_TOP], 1u);
            const unsigned tg = og / nx;
            if (og + 1u == (tg + 1u) * nx) xb_add(&bar[XB_TOPGEN], 1u);
            else XB_SPIN(xb_ld(&bar[XB_TOPGEN]) == tg, bar);
            __builtin_amdgcn_fence(__ATOMIC_ACQUIRE, "agent");
            xb_add(&bar[XB_XGEN(b.x)], 1u);
            asm volatile("s_waitcnt vmcnt(0)" ::: "memory");
        } else {
            XB_SPIN(xb_ld(&bar[XB_XGEN(b.x)]) == gen, bar);
            __builtin_amdgcn_fence(__ATOMIC_ACQUIRE, "agent");
            asm volatile("s_waitcnt vmcnt(0)" ::: "memory");
        }
    }
    __syncthreads();
}

struct Args { const void* in[23]; float* out; unsigned char* ws; int ph_lo, ph_hi, bar_region, pad; };

struct Frame {
    LAS unsigned char* lds; int tid, lane, wave, G, gw, NGW;
    unsigned char* ws;
};

__device__ __forceinline__ int colmap(int which, int n) {
    if (which == 0) {
        if (n < 384) return n; if (n < 512) return -1; if (n < 768) return 384 + (n - 512); if (n < 800) return 640 + (n - 768); if (n < 1024) return -1; return 672 + (n - 1024);
    } else if (which == 1) {
        const int h = n / 96, p = n % 96; if (p < 64) return h * 96 + p; const int j = p - 64, i = j >> 1; return h * 96 + 64 + ((j & 1) ? 16 + i : i);
    } else if (which == 2) {
        if (n < 512) return (n >> 6) * 128 + (n & 63); const int q = n - 512; return (q >> 6) * 128 + 64 + (q & 63);
    }
    return n;
}
__device__ __forceinline__ void p0_transpose_item(const float* W, int ldw, const float* gk, int which, bf16_t* WT, int K, int Nd, LAS float* scr, int item, int lane) {
    const int nblk = Nd / 32, kb = item / nblk, nb = item % nblk, k0 = 64 * kb, n0 = 32 * nb;
    const int sc = colmap(which, n0 + (lane & 31));
#pragma unroll 8
    for (int i = 0; i < 32; ++i) { const int kk = 2 * i + (lane >> 5); float v = 0.f; if (sc >= 0) { v = W[(size_t)(k0 + kk) * ldw + sc]; if (gk) v *= gk[k0 + kk]; } scr[kk * 33 + (lane & 31)] = v; }
    LDS_WAIT(); asm volatile("" ::: "memory");
    const int c = lane & 7;
#pragma unroll
    for (int j = 0; j < 4; ++j) { const int n = (lane >> 3) + 8 * j; const LAS float* s = scr + (8 * c) * 33 + n;
        v4u o; o.x = pk2(s[0 * 33], s[1 * 33]); o.y = pk2(s[2 * 33], s[3 * 33]); o.z = pk2(s[4 * 33], s[5 * 33]); o.w = pk2(s[6 * 33], s[7 * 33]);
        *(GAS v4u*)(WT + (size_t)(n0 + n) * K + k0 + 8 * c) = o; }
    LDS_WAIT(); asm volatile("" ::: "memory");
}
__device__ __forceinline__ float wsum(float v) {
#pragma unroll
    for (int o = 1; o < 64; o <<= 1) v += __shfl_xor(v, o);
    return v;
}
__device__ __forceinline__ void rms_row_to_bf16(const float* xrow, const float* g, bf16_t* orow, int lane) {
    const GAS f32x4* xr = (const GAS f32x4*)xrow + lane; const GAS f32x4* gr = (const GAS f32x4*)g + lane;
    f32x4 v[4]; float s = 0.f;
#pragma unroll
    for (int j = 0; j < 4; ++j) { v[j] = xr[64 * j]; s += (v[j].x * v[j].x + v[j].y * v[j].y) + (v[j].z * v[j].z + v[j].w * v[j].w); }
    const float rstd = rsqrtf(wsum(s) * (1.f / 1024.f) + EPS_);
    GAS unsigned long long* o8 = (GAS unsigned long long*)orow + lane;
#pragma unroll
    for (int j = 0; j < 4; ++j) { const f32x4 gg = gr[64 * j]; o8[64 * j] = (unsigned long long)pk2(v[j].x * rstd * gg.x, v[j].y * rstd * gg.y) | ((unsigned long long)pk2(v[j].z * rstd * gg.z, v[j].w * rstd * gg.w) << 32); }
}

__device__ __forceinline__ void p0_prologue(Frame& F, const Args& a) {
    LAS float* scr = (LAS float*)(F.lds + RING_OFF + F.wave * 16384);
    unsigned char* ws = F.ws;
#pragma unroll 1
    for (int pass = 0; pass < 2; ++pass) {
    if (((F.wave & 1) == 0) == (pass == 0)) {
    constexpr int I_IN = 16 * 80, I_UQ = 6 * 24, I_UKV = 4 * 32, I_SQ = 16 * 32, I_XKV = 16 * 64;
    constexpr int NITEMS = I_IN + I_UQ + I_UKV + 4 * I_SQ + I_XKV;
    for (int it = F.gw; it < NITEMS; it += F.NGW) {
        int r = it;
        if (r < I_IN) { p0_transpose_item((const float*)a.in[4], 2208, nullptr, 0, (bf16_t*)(ws + WO_WIN), 1024, 2560, scr, r, F.lane); continue; } r -= I_IN;
        if (r < I_UQ) { p0_transpose_item((const float*)a.in[6], 768, (const float*)a.in[5], 1, (bf16_t*)(ws + WO_WUQ), 384, 768, scr, r, F.lane); continue; } r -= I_UQ;
        if (r < I_UKV) { p0_transpose_item((const float*)a.in[8], 1024, (const float*)a.in[7], 2, (bf16_t*)(ws + WO_WUKV), 256, 1024, scr, r, F.lane); continue; } r -= I_UKV;
        if (r < I_SQ) { p0_transpose_item((const float*)a.in[11], 1024, (const float*)a.in[10], 3, (bf16_t*)(ws + WO_WO), 1024, 1024, scr, r, F.lane); continue; } r -= I_SQ;
        if (r < I_SQ) { p0_transpose_item((const float*)a.in[14], 1024, (const float*)a.in[12], 3, (bf16_t*)(ws + WO_WXQ), 1024, 1024, scr, r, F.lane); continue; } r -= I_SQ;
        if (r < I_XKV) { p0_transpose_item((const float*)a.in[15], 2048, nullptr, 3, (bf16_t*)(ws + WO_WXKV), 1024, 2048, scr, r, F.lane); continue; } r -= I_XKV;
        if (r < I_SQ) { p0_transpose_item((const float*)a.in[16], 1024, nullptr, 3, (bf16_t*)(ws + WO_WXO), 1024, 1024, scr, r, F.lane); continue; } r -= I_SQ;
        p0_transpose_item((const float*)a.in[18], 1024, (const float*)a.in[17], 3, (bf16_t*)(ws + WO_WPQ), 1024, 1024, scr, r, F.lane);
    }
    const int mpw = (T_ + TM_ + F.NGW - 1) / F.NGW;
    for (int m = F.gw * mpw; m < (F.gw + 1) * mpw && m < T_ + TM_; ++m) {
        if (m < T_) rms_row_to_bf16((const float*)a.in[0] + (size_t)m * 1024, (const float*)a.in[3], (bf16_t*)(ws + WS_RA) + (size_t)m * 1024, F.lane);
        else rms_row_to_bf16((const float*)a.in[1] + (size_t)(m - T_) * 1024, (const float*)a.in[13], (bf16_t*)(ws + WS_MEMN) + (size_t)(m - T_) * 1024, F.lane);
    }
    } else {
    { const float* U = (const float*)a.in[20]; const float* V = (const float*)a.in[21]; const float* gf = (const float*)a.in[17];
      unsigned char* UT8 = ws + WS_UT; unsigned char* VT8 = ws + WS_VT; float* SU = (float*)(ws + WS_SCL); float* SV = SU + 16384;
      f32x4 g4[4];
#pragma unroll
      for (int q = 0; q < 4; ++q) g4[q] = *(const f32x4*)(gf + q * 256 + F.lane * 4);
      const int rpw = (2 * 16384 + F.NGW - 1) / F.NGW;
      for (int r = F.gw * rpw; r < (F.gw + 1) * rpw && r < 2 * 16384; ++r) {
          const bool isu = r < 16384; const int e = isu ? r : r - 16384;
          const float* src = (isu ? U : V) + (size_t)e * 1024 + F.lane * 4;
          f32x4 v[4]; float am = 0.f;
#pragma unroll
          for (int q = 0; q < 4; ++q) { v[q] = *(const f32x4*)(src + q * 256); if (isu) v[q] = v[q] * g4[q];
              am = fmaxf(am, fmaxf(fmaxf(fabsf(v[q].x), fabsf(v[q].y)), fmaxf(fabsf(v[q].z), fabsf(v[q].w)))); }
#pragma unroll
          for (int o = 1; o < 64; o <<= 1) am = fmaxf(am, __shfl_xor(am, o));
          const float sc = am > 0.f ? am * (1.f / 6.f) : 1.f, inv = 1.f / sc;
          unsigned short* dst = (unsigned short*)((isu ? UT8 : VT8) + (size_t)e * 512) + F.lane;
#pragma unroll
          for (int q = 0; q < 4; ++q) { unsigned w_ = 0; w_ = __builtin_amdgcn_cvt_scalef32_pk_fp4_f32(w_, v[q].x * inv, v[q].y * inv, 1.0f, 0); w_ = __builtin_amdgcn_cvt_scalef32_pk_fp4_f32(w_, v[q].z * inv, v[q].w * inv, 1.0f, 1);
              dst[q * 64] = (unsigned short)(w_ & 0xffffu); }
          if (F.lane == 0) (isu ? SU : SV)[e] = sc;
      } }
    }
    }
    { const float* SKf = (const float*)a.in[19]; bf16_t* SKb = (bf16_t*)(ws + WO_SK);
      for (int i = F.gw * 64 + F.lane; i < 16 * 128 * 64 / 2; i += F.NGW * 64) ((unsigned*)SKb)[i] = pk2(SKf[2 * i], SKf[2 * i + 1]); }
    { const int* pos = (const int*)a.in[2]; float* COS = (float*)(ws + WS_COS); float* SIN = (float*)(ws + WS_SIN);
      for (int i = F.gw * 64 + F.lane; i < T_ * 16; i += F.NGW * 64) { const int t = i >> 4, f = i & 15; const float inv = powf(10000.f, -(float)(2 * f) / 32.f); const float ang = (float)pos[t] * inv; COS[i] = cosf(ang); SIN[i] = sinf(ang); } }
}

__device__ __forceinline__ void p2_conv_job(Frame& F, const Args& a) {
    const bf16_t* PROJ = (const bf16_t*)(F.ws + WS_RB); bf16_t* Y = (bf16_t*)(F.ws + WS_RA); bf16_t* Kb = (bf16_t*)a.out + (size_t)T_ * 768;
    const float* cw = (const float*)a.in[9]; const float* COS = (const float*)(F.ws + WS_COS); const float* SIN = (const float*)(F.ws + WS_SIN);
    int lane = __builtin_amdgcn_mbcnt_hi(~0u, __builtin_amdgcn_mbcnt_lo(~0u, 0u)); asm volatile("" : "+v"(lane));
    const int ch0 = lane * 8;
    f32x4 w0[3], w1[3];
#pragma unroll
    for (int k = 0; k < 3; ++k) { w0[k] = *(const f32x4*)(cw + k * 512 + ch0); w1[k] = *(const f32x4*)(cw + k * 512 + ch0 + 4); }
    for (int t = F.gw; t < T_; t += F.NGW) {
        const int s = t & (S_ - 1);
        const bf16_t* p = PROJ + (size_t)t * PJ;
        const v4u gb = *(const v4u*)(p + 1024 + ch0);
        f32x4 z0 = (f32x4){0.f, 0.f, 0.f, 0.f}, z1 = z0;
#pragma unroll
        for (int k = 0; k < 3; ++k) { const int dt = 2 - k;
            if (s - dt >= 0) { const bf16_t* q = p - (size_t)dt * PJ; const v4u gc = *(const v4u*)(q + 1536 + ch0), hx = *(const v4u*)(q + 2048 + ch0);
                z0 += w0[k] * (f32x4){pg8::bflo(gc.x) * pg8::bflo(hx.x), pg8::bfhi(gc.x) * pg8::bfhi(hx.x), pg8::bflo(gc.y) * pg8::bflo(hx.y), pg8::bfhi(gc.y) * pg8::bfhi(hx.y)};
                z1 += w1[k] * (f32x4){pg8::bflo(gc.z) * pg8::bflo(hx.z), pg8::bfhi(gc.z) * pg8::bfhi(hx.z), pg8::bflo(gc.w) * pg8::bflo(hx.w), pg8::bfhi(gc.w) * pg8::bfhi(hx.w)}; } }
        const f32x4 y0 = z0 * (f32x4){pg8::bflo(gb.x), pg8::bfhi(gb.x), pg8::bflo(gb.y), pg8::bfhi(gb.y)}, y1 = z1 * (f32x4){pg8::bflo(gb.z), pg8::bfhi(gb.z), pg8::bflo(gb.w), pg8::bfhi(gb.w)};
        float ss = (y0[0] * y0[0] + y0[1] * y0[1]) + (y0[2] * y0[2] + y0[3] * y0[3]) + (y1[0] * y1[0] + y1[1] * y1[1]) + (y1[2] * y1[2] + y1[3] * y1[3]);
        ss += __shfl_xor(ss, 1); ss += __shfl_xor(ss, 2); ss += __shfl_xor(ss, 4);
        const float r = rsqrtf(ss * (1.f / 64.f) + EPS_);
        v4u o; o.x = pk2(y0[0] * r, y0[1] * r); o.y = pk2(y0[2] * r, y0[3] * r); o.z = pk2(y1[0] * r, y1[1] * r); o.w = pk2(y1[2] * r, y1[3] * r);
        *(v4u*)(Y + (size_t)t * 1024 + 512 + ch0) = o;
        if (lane < 16) { const float c = COS[t * 16 + lane], sn = SIN[t * 16 + lane]; const float t1 = bf2f(p[768 + lane]), t2 = bf2f(p[768 + 16 + lane]);
            const unsigned w = pk2(t1 * c - t2 * sn, t2 * c + t1 * sn);
#pragma unroll
            for (int h = 0; h < 8; ++h) *(unsigned*)(Kb + (size_t)t * 768 + h * 96 + 64 + 2 * lane) = w; }
    }
}

typedef __bf16 bf16x2_t __attribute__((ext_vector_type(2)));
typedef float f32x2 __attribute__((ext_vector_type(2)));
__device__ __forceinline__ float dot2bf(unsigned a, unsigned b, float c) { return __builtin_amdgcn_fdot2_f32_bf16(__builtin_bit_cast(bf16x2_t, a), __builtin_bit_cast(bf16x2_t, b), c, false); }
template <int CTRL> __device__ __forceinline__ float dppf(float x) { return __builtin_bit_cast(float, __builtin_amdgcn_mov_dpp(__builtin_bit_cast(int, x), CTRL, 0xf, 0xf, true)); }
__device__ __forceinline__ float gelu_fast(float x) {
    const float u = 0.7978845608028654f * (x + 0.044715f * x * x * x);
    return x / (1.f + __expf(-2.f * u));
}
__device__ __forceinline__ float reduce32(float (&p)[32], int lane) {
#pragma unroll
    for (int j = 0; j < 16; ++j) { auto r = __builtin_amdgcn_permlane32_swap(__float_as_uint(p[j]), __float_as_uint(p[j + 16]), false, false); p[j] = __uint_as_float(r[0]) + __uint_as_float(r[1]); }
#pragma unroll
    for (int j = 0; j < 8; ++j) { auto r = __builtin_amdgcn_permlane16_swap(__float_as_uint(p[j]), __float_as_uint(p[j + 8]), false, false); p[j] = __uint_as_float(r[0]) + __uint_as_float(r[1]); }
    const bool b3 = (lane & 8) != 0, b2 = (lane & 4) != 0, b1 = (lane & 2) != 0;
#pragma unroll
    for (int j = 0; j < 4; ++j) { const float keep = b3 ? p[j + 4] : p[j], send = b3 ? p[j] : p[j + 4]; p[j] = keep + dppf<0x128>(send); }
#pragma unroll
    for (int j = 0; j < 2; ++j) { const float keep = b2 ? p[j + 2] : p[j], send = b2 ? p[j] : p[j + 2]; p[j] = keep + dppf<0x141>(send); }
    { const float keep = b1 ? p[1] : p[0], send = b1 ? p[0] : p[1]; p[0] = keep + dppf<0x4E>(send); }
    return p[0] + dppf<0xB1>(p[0]);
}
__device__ __forceinline__ f32x2 fp8lo(unsigned w) { return __builtin_amdgcn_cvt_pk_f32_fp8((int)w, false); }
__device__ __forceinline__ f32x2 fp8hi(unsigned w) { return __builtin_amdgcn_cvt_pk_f32_fp8((int)w, true); }
__device__ __forceinline__ float dot16(const v4u w, const f32x2 (&x)[8]) {
    f32x2 s = fp8lo(w.x) * x[0]; s += fp8hi(w.x) * x[1]; s += fp8lo(w.y) * x[2]; s += fp8hi(w.y) * x[3];
    s += fp8lo(w.z) * x[4]; s += fp8hi(w.z) * x[5]; s += fp8lo(w.w) * x[6]; s += fp8hi(w.w) * x[7];
    return s.x + s.y;
}
__device__ __forceinline__ void axpy16(f32x2 (&acc)[8], float as, const v4u w) {
    const f32x2 a2 = (f32x2){as, as};
    acc[0] += a2 * fp8lo(w.x); acc[1] += a2 * fp8hi(w.x); acc[2] += a2 * fp8lo(w.y); acc[3] += a2 * fp8hi(w.y);
    acc[4] += a2 * fp8lo(w.z); acc[5] += a2 * fp8hi(w.z); acc[6] += a2 * fp8lo(w.w); acc[7] += a2 * fp8hi(w.w);
}
constexpr size_t WS_RSTD2 = 105 * MiB + 512 * 1024;
constexpr size_t WS_ACT = 40 * MiB;
template <int CTRL> __device__ __forceinline__ int dppi(int x) { return __builtin_amdgcn_mov_dpp(x, CTRL, 0xf, 0xf, true); }
__device__ __forceinline__ int reduce32i(int (&p)[32], int lane) {
#pragma unroll
    for (int j = 0; j < 16; ++j) { auto r = __builtin_amdgcn_permlane32_swap((unsigned)p[j], (unsigned)p[j + 16], false, false); p[j] = (int)(r[0] + r[1]); }
#pragma unroll
    for (int j = 0; j < 8; ++j) { auto r = __builtin_amdgcn_permlane16_swap((unsigned)p[j], (unsigned)p[j + 8], false, false); p[j] = (int)(r[0] + r[1]); }
    const bool b3 = (lane & 8) != 0, b2 = (lane & 4) != 0, b1 = (lane & 2) != 0;
#pragma unroll
    for (int j = 0; j < 4; ++j) { const int keep = b3 ? p[j + 4] : p[j], send = b3 ? p[j] : p[j + 4]; p[j] = keep + dppi<0x128>(send); }
#pragma unroll
    for (int j = 0; j < 2; ++j) { const int keep = b2 ? p[j + 2] : p[j], send = b2 ? p[j] : p[j + 2]; p[j] = keep + dppi<0x141>(send); }
    { const int keep = b1 ? p[1] : p[0], send = b1 ? p[0] : p[1]; p[0] = keep + dppi<0x4E>(send); }
    return p[0] + dppi<0xB1>(p[0]);
}
__device__ __forceinline__ int dot16i(const v4u w, const v4u x) {
    return __builtin_amdgcn_sdot4((int)w.w, (int)x.w, __builtin_amdgcn_sdot4((int)w.z, (int)x.z, __builtin_amdgcn_sdot4((int)w.y, (int)x.y, __builtin_amdgcn_sdot4((int)w.x, (int)x.x, 0, false), false), false), false);
}
__device__ __forceinline__ float reduce16h(float (&p)[16], int lane) {
#pragma unroll
    for (int j = 0; j < 8; ++j) { auto r = __builtin_amdgcn_permlane16_swap(__float_as_uint(p[j]), __float_as_uint(p[j + 8]), false, false); p[j] = __uint_as_float(r[0]) + __uint_as_float(r[1]); }
    const bool b3 = (lane & 8) != 0, b2 = (lane & 4) != 0, b1 = (lane & 2) != 0;
#pragma unroll
    for (int j = 0; j < 4; ++j) { const float keep = b3 ? p[j + 4] : p[j], send = b3 ? p[j] : p[j + 4]; p[j] = keep + dppf<0x128>(send); }
#pragma unroll
    for (int j = 0; j < 2; ++j) { const float keep = b2 ? p[j + 2] : p[j], send = b2 ? p[j] : p[j + 2]; p[j] = keep + dppf<0x141>(send); }
    { const float keep = b1 ? p[1] : p[0], send = b1 ? p[0] : p[1]; p[0] = keep + dppf<0x4E>(send); }
    return p[0] + dppf<0xB1>(p[0]);
}
typedef int v8i_t __attribute__((ext_vector_type(8)));
typedef float v4f_t __attribute__((ext_vector_type(4)));
__device__ __forceinline__ void p_peer_u(Frame& F, const Args& a) {
    const bf16_t* H2 = (const bf16_t*)(F.ws + WS_RA); const float* parts = (const float*)(F.ws + PSS6_OFF);
    const unsigned char* UT4 = F.ws + WS_UT; const float* SU = (const float*)(F.ws + WS_SCL); const float* SV = SU + 16384;
    float* ACT = (float*)(F.ws + WS_ACT); int* RI = (int*)(F.ws + WS_RIDX); const float* RG = (const float*)(F.ws + WS_RGATE);
    int lane = __builtin_amdgcn_mbcnt_hi(~0u, __builtin_amdgcn_mbcnt_lo(~0u, 0u)); asm volatile("" : "+v"(lane));
    LAS unsigned char* wb = F.lds + RING_OFF + F.wave * 17408;
    LAS int* fpl = (LAS int*)wb; LAS unsigned char* xw = wb + 512; LAS int* li = (LAS int*)(wb + 512 + 8192); LAS float* lg = (LAS float*)(wb + 512 + 8192 + 4096); LAS float* ls = (LAS float*)(wb + 512 + 8192 + 8192);
    const int xoff = 32 * ((lane & 7) + 8 * (lane >> 5)) + 16 * ((lane >> 4) & 1);
    const int coff = ((lane & 7) + 8 * (lane >> 4)) * 16; const int bsel = (lane & 8) ? 128 : 0;
    const int slot = 2 * ((lane >> 1) & 15) + (lane >> 5), sub = slot & 15; const bool second = slot >= 16;
    const bool dvalid = ((lane & 15) >> 2) == (lane >> 4), dr1 = (lane & 1) != 0, dr2 = (lane & 2) != 0;
#pragma unroll 1
    for (int base = F.gw; base < T_; base += 8 * F.NGW) {
      int i0a[8], i1a[8]; float g0a[8], g1a[8], spa[8]; v4u ha[8][2];
#pragma unroll
      for (int k = 0; k < 8; ++k) { const int t_ = base + k * F.NGW, tc = t_ < T_ ? t_ : base;
          i0a[k] = RI[(size_t)tc * 128 + lane]; i1a[k] = RI[(size_t)tc * 128 + 64 + lane]; g0a[k] = RG[(size_t)tc * 128 + lane]; g1a[k] = RG[(size_t)tc * 128 + 64 + lane];
          spa[k] = (lane < 16) ? parts[(size_t)lane * T_ + tc] : 0.f;
          ha[k][0] = *(const v4u*)(H2 + (size_t)tc * 1024 + lane * 16); ha[k][1] = *(const v4u*)(H2 + (size_t)tc * 1024 + lane * 16 + 8); }
#define PU_PRE(k) do { const int t = base + (k) * F.NGW; const bool tv = t < T_; \
          const int i0 = tv ? i0a[k] : 0, i1 = tv ? i1a[k] : 0; const float g0 = tv ? g0a[k] : 0.f, g1 = tv ? g1a[k] : 0.f; \
          int pos0 = -1, pos1 = -1, ov0 = 0, ov1 = 0, ovf = 0, fre = 0; \
          _Pragma("unroll") for (int q = 0; q < 8; ++q) { \
              const bool m0 = (i0 >> 11) == q, m1 = (i1 >> 11) == q; \
              const unsigned long long b0 = __ballot(m0), b1 = __ballot(m1); \
              const int c0 = __popcll(b0), c1 = __popcll(b1), nq = c0 + c1; \
              const int r0 = (int)__builtin_amdgcn_mbcnt_hi((unsigned)(b0 >> 32), __builtin_amdgcn_mbcnt_lo((unsigned)b0, 0u)); \
              const int r1 = c0 + (int)__builtin_amdgcn_mbcnt_hi((unsigned)(b1 >> 32), __builtin_amdgcn_mbcnt_lo((unsigned)b1, 0u)); \
              if (m0) { if (r0 < 16) pos0 = 16 * q + r0; else ov0 = ovf + (r0 - 16); } \
              if (m1) { if (r1 < 16) pos1 = 16 * q + r1; else ov1 = ovf + (r1 - 16); } \
              const int fq = nq < 16 ? 16 - nq : 0; \
              if (lane < fq) fpl[fre + lane] = 16 * q + nq + lane; \
              ovf += nq > 16 ? nq - 16 : 0; fre += fq; } \
          const float sp = wsum(spa[k]); \
          const v4u h = ha[k][0], g = ha[k][1]; \
          float am = fmaxf(fmaxf(fmaxf(fabsf(pg8::bflo(h.x)), fabsf(pg8::bfhi(h.x))), fmaxf(fabsf(pg8::bflo(h.y)), fabsf(pg8::bfhi(h.y)))), fmaxf(fmaxf(fabsf(pg8::bflo(h.z)), fabsf(pg8::bfhi(h.z))), fmaxf(fabsf(pg8::bflo(h.w)), fabsf(pg8::bfhi(h.w))))); \
          am = fmaxf(am, fmaxf(fmaxf(fmaxf(fabsf(pg8::bflo(g.x)), fabsf(pg8::bfhi(g.x))), fmaxf(fabsf(pg8::bflo(g.y)), fabsf(pg8::bfhi(g.y)))), fmaxf(fmaxf(fabsf(pg8::bflo(g.z)), fabsf(pg8::bfhi(g.z))), fmaxf(fabsf(pg8::bflo(g.w)), fabsf(pg8::bfhi(g.w)))))); \
          am = wave_max(am); \
          const float qs = am > 0.f ? 440.f / am : 0.f; v4u xq; \
          { int w = 0; w = __builtin_amdgcn_cvt_pk_fp8_f32(pg8::bflo(h.x) * qs, pg8::bfhi(h.x) * qs, w, false); w = __builtin_amdgcn_cvt_pk_fp8_f32(pg8::bflo(h.y) * qs, pg8::bfhi(h.y) * qs, w, true); xq.x = (unsigned)w; } \
          { int w = 0; w = __builtin_amdgcn_cvt_pk_fp8_f32(pg8::bflo(h.z) * qs, pg8::bfhi(h.z) * qs, w, false); w = __builtin_amdgcn_cvt_pk_fp8_f32(pg8::bflo(h.w) * qs, pg8::bfhi(h.w) * qs, w, true); xq.y = (unsigned)w; } \
          { int w = 0; w = __builtin_amdgcn_cvt_pk_fp8_f32(pg8::bflo(g.x) * qs, pg8::bfhi(g.x) * qs, w, false); w = __builtin_amdgcn_cvt_pk_fp8_f32(pg8::bflo(g.y) * qs, pg8::bfhi(g.y) * qs, w, true); xq.z = (unsigned)w; } \
          { int w = 0; w = __builtin_amdgcn_cvt_pk_fp8_f32(pg8::bflo(g.z) * qs, pg8::bfhi(g.z) * qs, w, false); w = __builtin_amdgcn_cvt_pk_fp8_f32(pg8::bflo(g.w) * qs, pg8::bfhi(g.w) * qs, w, true); xq.w = (unsigned)w; } \
          *(LAS v4u*)(xw + (k) * 1024 + lane * 16) = xq; \
          asm volatile("s_waitcnt lgkmcnt(0)" ::: "memory"); \
          if (pos0 < 0) pos0 = fpl[ov0]; \
          if (pos1 < 0) pos1 = fpl[ov1]; \
          asm volatile("s_waitcnt lgkmcnt(0)" ::: "memory"); \
          li[(k) * 128 + pos0] = i0; li[(k) * 128 + pos1] = i1; lg[(k) * 128 + pos0] = g0; lg[(k) * 128 + pos1] = g1; \
          if (tv) { RI[(size_t)t * 128 + pos0] = i0; RI[(size_t)t * 128 + pos1] = i1; } \
          if (lane == 0) ls[k] = rsqrtf(sp * (1.f / 1024.f) + EPS_) * (am * (1.f / 440.f)); } while (0)
#define PU_B(d, kk) do { const v4u q0_ = *(const LAS v4u*)(xw + (kk) * 1024 + xoff), q1_ = *(const LAS v4u*)(xw + (kk) * 1024 + xoff + 512); \
        d = (v8i_t){(int)q0_.x, (int)q0_.y, (int)q0_.z, (int)q0_.w, (int)q1_.x, (int)q1_.y, (int)q1_.z, (int)q1_.w}; } while (0)
#define PU_DIAG(D) ({ const float t01_ = dr1 ? (D).y : (D).x, t23_ = dr1 ? (D).w : (D).z; const float t_ = dr2 ? t23_ : t01_; dvalid ? t_ : 0.f; })
#define PU_MMA(m, B) do { const v8i_t a_ = (v8i_t){(int)bufs[m].x, (int)bufs[m].y, (int)bufs[m].z, (int)bufs[m].w, 0, 0, 0, 0}; const v4f_t z_ = (v4f_t){0.f, 0.f, 0.f, 0.f}; \
        const v4f_t d_ = __builtin_amdgcn_mfma_scale_f32_16x16x128_f8f6f4(a_, B, z_, 4, 0, 0, 0, 0, 0); p[m] = PU_DIAG(d_); } while (0)
#define PU_BA(pp, j) \
        const int kk_ = 2 * (j) + (second ? 1 : 0); const int tt = base + kk_ * F.NGW; \
        const int idxv = li[kk_ * 128 + (pp) * 16 + sub]; const float gatev = lg[kk_ * 128 + (pp) * 16 + sub]; const float rstd = ls[kk_]; \
        v4u bufs[16]; \
        _Pragma("unroll") for (int m = 0; m < 16; ++m) { const int e_ = __builtin_amdgcn_ds_bpermute(8 * m + bsel, idxv); bufs[m] = *(const v4u*)(UT4 + (size_t)e_ * 512 + coff); } \
        const float su = SU[idxv], sv = SV[idxv];
#define PU_BB(pp, j) do { \
        v8i_t BA, BB; PU_B(BA, 2 * (j)); PU_B(BB, 2 * (j) + 1); \
        float p[16]; \
        _Pragma("unroll") for (int m = 0; m < 8; ++m) PU_MMA(m, BA); \
        _Pragma("unroll") for (int m = 8; m < 16; ++m) PU_MMA(m, BB); \
        const float dt = reduce16h(p, lane); \
        if ((lane & 1) == 0 && tt < T_) ACT[(size_t)tt * 128 + (pp) * 16 + sub] = gelu_fast(dt * su * rstd) * gatev * sv; } while (0)
      PU_PRE(0); PU_PRE(1);
      { PU_BA(0, 0); PU_PRE(2); PU_PRE(3); PU_BB(0, 0); }
      { PU_BA(0, 1); PU_PRE(4); PU_PRE(5); PU_BB(0, 1); }
      { PU_BA(0, 2); PU_PRE(6); PU_PRE(7); PU_BB(0, 2); }
      { PU_BA(0, 3); PU_BB(0, 3); }
#pragma unroll 1
      for (int n = 4; n < 32; ++n) { const int pp = n >> 2, j = n & 3; PU_BA(pp, j); PU_BB(pp, j); }
#undef PU_PRE
#undef PU_B
#undef PU_DIAG
#undef PU_MMA
#undef PU_BA
#undef PU_BB
    }
}
typedef int v2i_t __attribute__((ext_vector_type(2)));
typedef unsigned v2u_t __attribute__((ext_vector_type(2)));
__device__ __forceinline__ void p_peer_v(Frame& F, const Args& a) {
    const bf16_t* H2 = (const bf16_t*)(F.ws + WS_RA); const unsigned char* VT4 = F.ws + WS_VT;
    const int* SE = (const int*)(F.ws + WS_RIDX); const float* ACT = (const float*)(F.ws + WS_ACT);
    const float* gfin = (const float*)a.in[22]; float* out = a.out;
    int lane = __builtin_amdgcn_mbcnt_hi(~0u, __builtin_amdgcn_mbcnt_lo(~0u, 0u)); asm volatile("" : "+v"(lane));
    const int lo = lane & 31; const bool up = lane >= 32; const int w = F.wave, wq = w & 3, g = lane >> 4;
    constexpr int PITCH = 520, SB = 128 * PITCH, A8_OFF = 2 * SB, SA_OFF = A8_OFF + 8192, TPITCH = 1040;
    static_assert(SA_OFF + 256 <= LDS_BYTES, "V phase LDS");
    LAS unsigned char* lds = F.lds;
    const int sub = lane & 15; const bool second = (lane & 16) != 0;
    LAS unsigned char* wptr = lds + (32 * (2 * (w >> 2) + (w & 1)) + 16 * ((w >> 1) & 1) + (up ? 8 : 0)) * PITCH + lo * 16;
    LAS unsigned char* rptr = lds + (64 * (g >> 1) + 16 * (g & 1) + (lane & 15)) * PITCH + 64 * w;
    const bool va0 = (lane & 15) == g, va1 = (lane & 15) == 4 + g, vb0 = (lane & 15) == 8 + g, vb1 = (lane & 15) == 12 + g;
#pragma unroll 1
    for (int k0 = 0; F.gw + k0 * F.NGW < T_; k0 += 8) {
        __syncthreads();
#pragma unroll 1
        for (int k = 0; k < 8; ++k) { const int t = F.gw + (k0 + k) * F.NGW; const bool tv = t < T_; const int tc = tv ? t : F.gw;
            int lane = __builtin_amdgcn_mbcnt_hi(~0u, __builtin_amdgcn_mbcnt_lo(~0u, 0u)); asm volatile("" : "+v"(lane));
            const float a0 = tv ? ACT[(size_t)tc * 128 + lane] : 0.f, a1 = tv ? ACT[(size_t)tc * 128 + 64 + lane] : 0.f;
            const float am = wave_max(fmaxf(fabsf(a0), fabsf(a1))); const float qs = am > 0.f ? 240.f / am : 0.f;
            const int pk = __builtin_amdgcn_cvt_pk_fp8_f32(a0 * qs, a1 * qs, 0, false);
            LAS unsigned char* d8 = lds + A8_OFF + (w * 8 + k) * 128;
            d8[lane] = (unsigned char)(pk & 0xff); d8[64 + lane] = (unsigned char)((pk >> 8) & 0xff);
            if (lane == 0) ((LAS float*)(lds + SA_OFF))[w * 8 + k] = am * (1.f / 240.f); }
#define PV_IDX(r_) ({ int il_ = __builtin_amdgcn_mbcnt_hi(~0u, __builtin_amdgcn_mbcnt_lo(~0u, 0u)); asm volatile("" : "+v"(il_)); \
        const int rr_ = (r_) < 32 ? (r_) : 31; const int t_ = F.gw + (k0 + 2 * (sg0 + ((rr_ >> 1) & 1)) + (rr_ & 1)) * F.NGW; const int tc_ = t_ < T_ ? t_ : F.gw; SE[(size_t)tc_ * 128 + (rr_ >> 2) * 16 + (il_ & 15)]; })
#define PV_ROWS(BUF, IDX) do { _Pragma("unroll") for (int i = 0; i < 8; ++i) { const int e_ = __builtin_amdgcn_ds_bpermute(4 * (i + (up ? 8 : 0)), IDX); BUF[i] = *(const v4u*)(VT4 + (size_t)e_ * 512 + lo * 16); } } while (0)
#define PV_ROUND(ACC, BUF, rr_, c_) do { const int r_ = (rr_); if (r_ < 32) { const int p_ = r_ >> 2; constexpr int stg_ = (c_) & 1, hh_ = (c_) & 1; const int sg_ = sg0 + ((c_) >> 1); \
            _Pragma("unroll") for (int i = 0; i < 8; ++i) { *(LAS v2u_t*)(wptr + stg_ * SB + i * PITCH) = (v2u_t){BUF[i].x, BUF[i].y}; *(LAS v2u_t*)(wptr + stg_ * SB + i * PITCH + 8) = (v2u_t){BUF[i].z, BUF[i].w}; } \
            if (r_ + 3 < 32) { const int idc_ = idx1; PV_ROWS(BUF, idc_); } \
            idx1 = idx2; idx2 = PV_IDX(r_ + 5); \
            asm volatile("s_waitcnt lgkmcnt(0)" ::: "memory"); __builtin_amdgcn_s_barrier(); \
            { const v4u q1_ = *(const LAS v4u*)(lds + A8_OFF + (g * 8 + 2 * sg_ + hh_) * 128 + p_ * 16); \
              const v4u q2_ = *(const LAS v4u*)(lds + A8_OFF + ((4 + g) * 8 + 2 * sg_ + hh_) * 128 + p_ * 16); \
              const bool s1_ = hh_ ? vb0 : va0, s2_ = hh_ ? vb1 : va1; \
              const v8i_t A_ = (v8i_t){s1_ ? (int)q1_.x : 0, s1_ ? (int)q1_.y : 0, s1_ ? (int)q1_.z : 0, s1_ ? (int)q1_.w : 0, s2_ ? (int)q2_.x : 0, s2_ ? (int)q2_.y : 0, s2_ ? (int)q2_.z : 0, s2_ ? (int)q2_.w : 0}; \
              _Pragma("unroll") for (int n = 0; n < 8; ++n) { \
                  const v2i_t r0_ = __builtin_amdgcn_ds_read_tr4_b64_v2i32((LAS v2i_t*)(rptr + stg_ * SB + 8 * n)); \
                  const v2i_t r1_ = __builtin_amdgcn_ds_read_tr4_b64_v2i32((LAS v2i_t*)(rptr + stg_ * SB + 8 * n + 32 * PITCH)); \
                  const v8i_t B_ = (v8i_t){r0_.x, r0_.y, r1_.x, r1_.y, 0, 0, 0, 0}; \
                  ACC[n] = __builtin_amdgcn_mfma_scale_f32_16x16x128_f8f6f4(A_, B_, ACC[n], 0, 4, 0, 0, 0, 0); } } } } while (0)
#define PV_FINSET(ACC, sg_) do { \
            int fl_ = __builtin_amdgcn_mbcnt_hi(~0u, __builtin_amdgcn_mbcnt_lo(~0u, 0u)); asm volatile("" : "+v"(fl_)); const int fg_ = fl_ >> 4, fj_ = fl_ & 15;     \
            LAS float* tile_ = (LAS float*)(F.lds + ((sg_) & 1) * SB); const LAS float* sa_ = (const LAS float*)(F.lds + SA_OFF); \
            _Pragma("unroll") for (int r = 0; r < 4; ++r) { const int m_ = 4 * fg_ + r; const float sc_ = sa_[(m_ & 7) * 8 + 2 * (sg_) + (m_ >> 3)]; \
                _Pragma("unroll") for (int n = 0; n < 8; ++n) tile_[m_ * TPITCH + 128 * F.wave + 16 * n + fj_] = ACC[n][r] * sc_; } \
            __syncthreads(); \
            _Pragma("unroll 1") for (int kk = 0; kk < 2; ++kk) { const int t_ = F.gw + (k0 + 2 * (sg_) + kk) * F.NGW; \
                if (t_ < T_) { const LAS f32x4* row_ = (const LAS f32x4*)(tile_ + (8 * kk + F.wave) * TPITCH + fl_ * 16); \
                    const v4u h0 = *(const v4u*)(H2 + (size_t)t_ * 1024 + fl_ * 16), h1 = *(const v4u*)(H2 + (size_t)t_ * 1024 + fl_ * 16 + 8); \
                    f32x4 v0 = row_[0], v1 = row_[1], v2 = row_[2], v3 = row_[3]; \
                    v0 += (f32x4){pg8::bflo(h0.x), pg8::bfhi(h0.x), pg8::bflo(h0.y), pg8::bfhi(h0.y)}; v1 += (f32x4){pg8::bflo(h0.z), pg8::bfhi(h0.z), pg8::bflo(h0.w), pg8::bfhi(h0.w)}; \
                    v2 += (f32x4){pg8::bflo(h1.x), pg8::bfhi(h1.x), pg8::bflo(h1.y), pg8::bfhi(h1.y)}; v3 += (f32x4){pg8::bflo(h1.z), pg8::bfhi(h1.z), pg8::bflo(h1.w), pg8::bfhi(h1.w)}; \
                    float ss = (v0.x * v0.x + v0.y * v0.y) + (v0.z * v0.z + v0.w * v0.w) + (v1.x * v1.x + v1.y * v1.y) + (v1.z * v1.z + v1.w * v1.w) \
                             + (v2.x * v2.x + v2.y * v2.y) + (v2.z * v2.z + v2.w * v2.w) + (v3.x * v3.x + v3.y * v3.y) + (v3.z * v3.z + v3.w * v3.w); \
                    ss = wsum(ss); const float rr = rsqrtf(ss * (1.f / 1024.f) + EPS_); float* o_ = out + (size_t)t_ * 1024 + fl_ * 16; \
                    const f32x4 g0 = *(const f32x4*)(gfin + fl_ * 16), g1 = *(const f32x4*)(gfin + fl_ * 16 + 4), g2 = *(const f32x4*)(gfin + fl_ * 16 + 8), g3 = *(const f32x4*)(gfin + fl_ * 16 + 12); \
                    *(f32x4*)(o_) = v0 * rr * g0; *(f32x4*)(o_ + 4) = v1 * rr * g1; *(f32x4*)(o_ + 8) = v2 * rr * g2; *(f32x4*)(o_ + 12) = v3 * rr * g3; } } } while (0)
#pragma unroll 1
        for (int sg0 = 0; sg0 < 4; sg0 += 2) {
            v4f_t accA[8], accB[8];
#pragma unroll
            for (int n = 0; n < 8; ++n) { accA[n] = (v4f_t){0.f, 0.f, 0.f, 0.f}; accB[n] = accA[n]; }
            v4u bf0[8], bf1[8], bf2[8]; int idx1, idx2;
            { const int i0 = PV_IDX(0), i1 = PV_IDX(1), i2 = PV_IDX(2); idx1 = PV_IDX(3); idx2 = PV_IDX(4);
              PV_ROWS(bf0, i0); PV_ROWS(bf1, i1); PV_ROWS(bf2, i2); }
            __syncthreads();
#pragma unroll 1
            for (int rb = 0; rb < 36; rb += 12) {
                PV_ROUND(accA, bf0, rb + 0, 0); PV_ROUND(accA, bf1, rb + 1, 1); PV_ROUND(accB, bf2, rb + 2, 2); PV_ROUND(accB, bf0, rb + 3, 3);
                PV_ROUND(accA, bf1, rb + 4, 0); PV_ROUND(accA, bf2, rb + 5, 1); PV_ROUND(accB, bf0, rb + 6, 2); PV_ROUND(accB, bf1, rb + 7, 3);
                PV_ROUND(accA, bf2, rb + 8, 0); PV_ROUND(accA, bf0, rb + 9, 1); PV_ROUND(accB, bf1, rb + 10, 2); PV_ROUND(accB, bf2, rb + 11, 3); }
            asm volatile("s_waitcnt lgkmcnt(0)" ::: "memory"); __builtin_amdgcn_s_barrier();
            PV_FINSET(accA, sg0); PV_FINSET(accB, sg0 + 1);
        }
#undef PV_IDX
#undef PV_ROWS
#undef PV_ROUND
#undef PV_FINSET
    }
}

namespace mla {
typedef short bf16x8 __attribute__((ext_vector_type(8)));
typedef short s16x4 __attribute__((ext_vector_type(4)));
typedef float f32x16 __attribute__((ext_vector_type(16)));
typedef unsigned u32x4 __attribute__((ext_vector_type(4)));
constexpr int KSLOT = 12288, VSLOT = 8192;
constexpr int L_K = 0, L_V = 2 * KSLOT, L_WS = L_V + 2 * VSLOT, L_ST = L_WS + 8 * 256, L_END = L_ST + 8 * 8192;
__device__ __forceinline__ int crow(int r, int hi) { return (r & 3) + 8 * (r >> 2) + 4 * hi; }
__device__ __forceinline__ unsigned cvtpk(float lo, float hi) { typedef float f2 __attribute__((ext_vector_type(2))); typedef __bf16 b2 __attribute__((ext_vector_type(2))); f2 v = {lo, hi}; b2 b = __builtin_convertvector(v, b2); return __builtin_bit_cast(unsigned, b); }
__device__ __forceinline__ s16x4 vtr(const LAS unsigned char* p) { typedef short v4i16_t __attribute__((ext_vector_type(4))); return __builtin_bit_cast(s16x4, __builtin_amdgcn_ds_read_tr16_b64_v4i16((LAS v4i16_t*)p)); }

template <int THRL>
__device__ __forceinline__ void unit(int b, int h, int qb, const bf16_t* Q, const bf16_t* K, const bf16_t* V, bf16_t* Y, LAS unsigned char* lds, int wid, int lane) {
    const int r32 = lane & 31, hi = lane >> 5;
    const long rowbase = (long)b * S_; const int q0 = qb * 256;
    const bf16_t* Qw = Q + (size_t)(rowbase + q0 + wid * 32 + r32) * 768 + h * 96 + hi * 8;
    bf16x8 qr[6];
#pragma unroll
    for (int d0 = 0; d0 < 6; ++d0) qr[d0] = *(const bf16x8*)(Qw + d0 * 16);
    const bf16_t* Kh = K + (size_t)rowbase * 768 + h * 96; const bf16_t* Vh = V + (size_t)rowbase * 512 + h * 64;
    const bf16_t* ksrc0 = Kh + (size_t)lane * 768 + wid * 8;
    const bf16_t* vsrc = Vh + (size_t)(16 * (wid & 3) + (lane >> 2)) * 512 + (wid >> 2) * 32 + (lane & 3) * 8;
    const int NT = (q0 + 256) / 64;
#define MLA_DMA(t, slot) do { \
        __builtin_amdgcn_global_load_lds((const unsigned*)(ksrc0 + (size_t)(t) * 64 * 768), (LAS unsigned*)(lds + L_K + (slot) * KSLOT + wid * 1024), 16, 0, 0); \
        if (wid < 4) __builtin_amdgcn_global_load_lds((const unsigned*)(ksrc0 + (size_t)(t) * 64 * 768 + 64), (LAS unsigned*)(lds + L_K + (slot) * KSLOT + (wid + 8) * 1024), 16, 0, 0); \
        __builtin_amdgcn_global_load_lds((const unsigned*)(vsrc + (size_t)(t) * 64 * 512), (LAS unsigned*)(lds + L_V + (slot) * VSLOT + wid * 1024), 16, 0, 0); } while (0)
    LAS float* wsf = (LAS float*)(lds + L_WS) + wid * 64;
    float m = -INFINITY, l_reg = 0.f;
    f32x16 o0 = f32x16{}, o1 = f32x16{};
    const int qrel = wid * 32 + r32;
    MLA_DMA(0, 0);
#pragma unroll 1
    for (int t = 0; t < NT; ++t) {
        asm volatile("s_waitcnt vmcnt(0)" ::: "memory");
        __builtin_amdgcn_s_barrier();
        asm volatile("" ::: "memory");
        if (t + 1 < NT) MLA_DMA(t + 1, (t + 1) & 1);
        const int jb = t - (NT - 4);
        if (jb >= 0 && 64 * jb > 32 * wid + 31) continue;
        const LAS unsigned char* kb = lds + L_K + (t & 1) * KSLOT + hi * 1024 + r32 * 16;
        f32x16 p0 = f32x16{}, p1 = f32x16{};
#pragma unroll
        for (int d0 = 0; d0 < 6; ++d0) {
            const bf16x8 a0 = *(const LAS bf16x8*)(kb + d0 * 2048), a1 = *(const LAS bf16x8*)(kb + d0 * 2048 + 512);
            p0 = __builtin_amdgcn_mfma_f32_32x32x16_bf16(a0, qr[d0], p0, 0, 0, 0);
            p1 = __builtin_amdgcn_mfma_f32_32x32x16_bf16(a1, qr[d0], p1, 0, 0, 0);
        }
        if (jb >= 0) { const int kbase = 64 * jb + 4 * hi;
#pragma unroll
            for (int r = 0; r < 16; ++r) { const int kv = kbase + (r & 3) + 8 * (r >> 2); if (kv > qrel) p0[r] = -INFINITY; if (kv + 32 > qrel) p1[r] = -INFINITY; } }
        float rm = fmaxf(p0[0], p1[0]);
#pragma unroll
        for (int r = 1; r < 16; ++r) rm = fmaxf(rm, fmaxf(p0[r], p1[r]));
        { auto rr = __builtin_amdgcn_permlane32_swap(__float_as_uint(rm), __float_as_uint(rm), false, false); rm = fmaxf(__uint_as_float(rr[0]), __uint_as_float(rr[1])); }
        if (__any(rm > m + (float)THRL)) {
            const float mn = fmaxf(m, rm); const float f = __builtin_amdgcn_exp2f(m - mn); m = mn; l_reg *= f;
            if (hi == 0) wsf[r32] = f;
            asm volatile("s_waitcnt lgkmcnt(0)" ::: "memory");
#pragma unroll
            for (int r = 0; r < 16; ++r) { const float fr_ = wsf[crow(r, hi)]; o0[r] *= fr_; o1[r] *= fr_; }
        }
        float sacc = 0.f;
#pragma unroll
        for (int r = 0; r < 16; ++r) { p0[r] = __builtin_amdgcn_exp2f(p0[r] - m); p1[r] = __builtin_amdgcn_exp2f(p1[r] - m); sacc += p0[r] + p1[r]; }
        l_reg += sacc;
        u32x4 pw[4];
#pragma unroll
        for (int s = 0; s < 2; ++s) {
            pw[s] = (u32x4){cvtpk(p0[8 * s], p0[8 * s + 1]), cvtpk(p0[8 * s + 2], p0[8 * s + 3]), cvtpk(p0[8 * s + 4], p0[8 * s + 5]), cvtpk(p0[8 * s + 6], p0[8 * s + 7])};
            pw[2 + s] = (u32x4){cvtpk(p1[8 * s], p1[8 * s + 1]), cvtpk(p1[8 * s + 2], p1[8 * s + 3]), cvtpk(p1[8 * s + 4], p1[8 * s + 5]), cvtpk(p1[8 * s + 6], p1[8 * s + 7])};
        }
        const LAS unsigned char* vb = lds + L_V + (t & 1) * VSLOT + ((lane >> 4) & 1) * 32 + (lane & 3) * 8 + (4 * hi + ((lane & 15) >> 2)) * 64;
#pragma unroll
        for (int s = 0; s < 4; ++s) {
            const s16x4 lo0 = vtr(vb + s * 1024), hi0 = vtr(vb + s * 1024 + 512), lo1 = vtr(vb + 4096 + s * 1024), hi1 = vtr(vb + 4096 + s * 1024 + 512);
            const bf16x8 pa = __builtin_bit_cast(bf16x8, pw[s]);
            o0 = __builtin_amdgcn_mfma_f32_32x32x16_bf16(pa, (bf16x8){lo0[0], lo0[1], lo0[2], lo0[3], hi0[0], hi0[1], hi0[2], hi0[3]}, o0, 0, 0, 0);
            o1 = __builtin_amdgcn_mfma_f32_32x32x16_bf16(pa, (bf16x8){lo1[0], lo1[1], lo1[2], lo1[3], hi1[0], hi1[1], hi1[2], hi1[3]}, o1, 0, 0, 0);
        }
    }
#undef MLA_DMA
    { auto rr = __builtin_amdgcn_permlane32_swap(__float_as_uint(l_reg), __float_as_uint(l_reg), false, false); l_reg = __uint_as_float(rr[0]) + __uint_as_float(rr[1]); }
    if (hi == 0) wsf[32 + r32] = l_reg;
    asm volatile("s_waitcnt lgkmcnt(0)" ::: "memory");
    LAS float* stg = (LAS float*)(lds + L_ST + wid * 8192);
#pragma unroll
    for (int r = 0; r < 16; ++r) { const int orow = crow(r, hi); const float rl = __builtin_amdgcn_rcpf(wsf[32 + orow]); stg[orow * 64 + r32] = o0[r] * rl; stg[orow * 64 + 32 + r32] = o1[r] * rl; }
    asm volatile("s_waitcnt lgkmcnt(0)" ::: "memory");
    bf16_t* Yw = Y + (size_t)(rowbase + q0 + wid * 32) * 1024 + h * 64;
#pragma unroll
    for (int i = 0; i < 4; ++i) {
        const int row = i * 8 + (lane >> 3), ch = lane & 7;
        const f32x4 a = *(const LAS f32x4*)(stg + row * 64 + ch * 8), c = *(const LAS f32x4*)(stg + row * 64 + ch * 8 + 4);
        float ss = (a[0] * a[0] + a[1] * a[1]) + (a[2] * a[2] + a[3] * a[3]) + (c[0] * c[0] + c[1] * c[1]) + (c[2] * c[2] + c[3] * c[3]);
        ss += __shfl_xor(ss, 1); ss += __shfl_xor(ss, 2); ss += __shfl_xor(ss, 4);
        const float rs = rsqrtf(ss * (1.f / 64.f) + EPS_);
        u32x4 w; w.x = cvtpk(a[0] * rs, a[1] * rs); w.y = cvtpk(a[2] * rs, a[3] * rs); w.z = cvtpk(c[0] * rs, c[1] * rs); w.w = cvtpk(c[2] * rs, c[3] * rs);
        *(u32x4*)(Yw + (size_t)row * 1024 + ch * 8) = w;
    }
    asm volatile("s_waitcnt lgkmcnt(0)" ::: "memory");
    __builtin_amdgcn_s_barrier();
    asm volatile("" ::: "memory");
}
}

namespace rt {
typedef short bf16x8 __attribute__((ext_vector_type(8)));
typedef float f32x16 __attribute__((ext_vector_type(16)));
__device__ __forceinline__ int mono(float f) { const int b = __float_as_int(f); return b ^ ((b >> 31) & 0x7fffffff); }
__device__ __forceinline__ float unmono(int k) { return __int_as_float(k ^ ((k >> 31) & 0x7fffffff)); }
template <int N> __device__ __forceinline__ void bitonic_sort_desc(int (&k)[N]) {
#pragma unroll
    for (int size = 2; size <= N; size <<= 1)
#pragma unroll
        for (int stride = size >> 1; stride > 0; stride >>= 1)
#pragma unroll
            for (int i = 0; i < N; ++i) { const int j = i ^ stride;
                if (j > i) { const int mx = max(k[i], k[j]), mn = min(k[i], k[j]); if ((i & size) == 0) { k[i] = mx; k[j] = mn; } else { k[i] = mn; k[j] = mx; } } }
}
__device__ __forceinline__ void bitonic_merge_desc16(int (&k)[16]) {
#pragma unroll
    for (int stride = 8; stride > 0; stride >>= 1)
#pragma unroll
        for (int i = 0; i < 16; ++i) { const int j = i ^ stride; if (j > i) { const int mx = max(k[i], k[j]), mn = min(k[i], k[j]); k[i] = mx; k[j] = mn; } }
}
__device__ __forceinline__ void merge_top16(int (&a)[16], const int (&b)[16]) {
#pragma unroll
    for (int i = 0; i < 16; ++i) a[i] = max(a[i], b[15 - i]);
    bitonic_merge_desc16(a);
}
__device__ __forceinline__ void cross_merge16(int (&a)[16], int hi) {
    int pnr[16];
#pragma unroll
    for (int i = 0; i < 16; ++i) { auto r = __builtin_amdgcn_permlane32_swap((unsigned)a[i], (unsigned)a[i], false, false); pnr[i] = hi ? (int)r[0] : (int)r[1]; }
#pragma unroll
    for (int i = 0; i < 16; ++i) a[i] = max(a[i], pnr[15 - i]);
    bitonic_merge_desc16(a);
}
__device__ constexpr int A0[25] = {0,0,0,0,0,0,0,0, 1,1,1,1, 2,2, 3,3, 4, 5,6,7, 2, 8,10,12,14};
__device__ constexpr int B0[25] = {0,1,2,3,4,5,6,7, 0,1,2,3, 0,1, 0,1, 0, 0,0,0, 4, 0,0,0,0};
__device__ constexpr int A1[25] = {0,0,0,0,0,0,0,0, 1,1,1,1, 2,2, 3,3, 4, 5,6,7, 4, 9,11,13,15};
__device__ constexpr int B1[25] = {8,9,10,11,12,13,14,15, 4,5,6,7, 2,3, 2,3, 1, 1,1,1, 2, 0,0,0,0};

__device__ __forceinline__ void top16_set(const bf16_t* qrow  , const LAS unsigned char* skset, int r32, int hi, int (&T)[16]) {
    bf16x8 qf[4];
#pragma unroll
    for (int s2 = 0; s2 < 4; ++s2) qf[s2] = *(const bf16x8*)(qrow + 16 * s2);
    int k[4][16];
#pragma unroll
    for (int kb = 0; kb < 4; ++kb) {
        f32x16 sc = f32x16{};
#pragma unroll
        for (int s2 = 0; s2 < 4; ++s2) { const bf16x8 a = *(const LAS bf16x8*)(skset + (2 * s2 + hi) * 2048 + (kb * 32 + r32) * 16); sc = __builtin_amdgcn_mfma_f32_32x32x16_bf16(a, qf[s2], sc, 0, 0, 0); }
#pragma unroll
        for (int r = 0; r < 16; ++r) k[kb][r] = ((mono(sc[r]) & ~0x7f) | (hi << 2)) | (kb * 32 + (r & 3) + 8 * (r >> 2));
        bitonic_sort_desc<16>(k[kb]);
    }
    merge_top16(k[0], k[1]); merge_top16(k[2], k[3]); merge_top16(k[0], k[2]);
#pragma unroll
    for (int i = 0; i < 16; ++i) T[i] = k[0][i];
    cross_merge16(T, hi);
}

__device__ __forceinline__ void route_unit(int pm, int pn, const bf16_t* QP, const bf16_t* SKb, int* RIDX, float* RGATE, LAS unsigned char* lds, int wid, int lane) {
    const int r32 = lane & 31, hi = lane >> 5;
    for (int pc = wid; pc < 64; pc += 8) {
        const int set = pc >> 4, ch = (pc >> 1) & 7, hf = pc & 1;
        const bf16_t* src = SKb + ((size_t)((2 * pn + (set >> 1)) * 2 + (set & 1)) * 128 + 64 * hf + lane) * 64 + ch * 8;
        __builtin_amdgcn_global_load_lds((const unsigned*)src, (LAS unsigned*)(lds + set * 16384 + ch * 2048 + hf * 1024), 16, 0, 0);
    }
    asm volatile("s_waitcnt vmcnt(0)" ::: "memory"); __builtin_amdgcn_s_barrier(); asm volatile("" ::: "memory");
    const int t = pm * 256 + wid * 32 + r32;
#pragma unroll 1
    for (int hsel = 0; hsel < 2; ++hsel) {
        const int hh = 2 * pn + hsel;
        int T0[16], T1[16];
        const bf16_t* qrow = QP + (size_t)t * 1024 + hh * 128 + 8 * hi;
        top16_set(qrow, lds + (hsel * 2 + 0) * 16384, r32, hi, T0);
        top16_set(qrow + 64, lds + (hsel * 2 + 1) * 16384, r32, hi, T1);
        int ck[32], ok[25];
#pragma unroll
        for (int k2 = 0; k2 < 25; ++k2) { const int ka = hi ? T0[A1[k2]] : T0[A0[k2]], kb2 = hi ? T1[B1[k2]] : T1[B0[k2]];
            const float sm = unmono(ka & ~0x7f) + unmono(kb2 & ~0x7f); ok[k2] = ((mono(sm) & ~0x3f) | hi) | (2 * k2); ck[k2] = ok[k2]; }
#pragma unroll
        for (int k2 = 25; k2 < 32; ++k2) ck[k2] = (int)0x80000000;
        bitonic_sort_desc<32>(ck);
        int c16[16];
#pragma unroll
        for (int i = 0; i < 16; ++i) c16[i] = ck[i];
        cross_merge16(c16, hi);
        const int K16 = c16[15];
        const float smax = unmono(T0[0] & ~0x7f) + unmono(T1[0] & ~0x7f);
        float tot = 0.f; int cnt = 0;
#pragma unroll
        for (int k2 = 0; k2 < 25; ++k2) { if (ok[k2] >= K16) { tot += __builtin_amdgcn_exp2f((unmono(ok[k2] & ~0x3f) - smax) * LOG2E); cnt += 1; } }
        float tot_all; int cnt_lo;
        { auto r = __builtin_amdgcn_permlane32_swap(__float_as_uint(tot), __float_as_uint(tot), false, false); tot_all = __uint_as_float(r[0]) + __uint_as_float(r[1]); }
        { auto r = __builtin_amdgcn_permlane32_swap((unsigned)cnt, (unsigned)cnt, false, false); cnt_lo = hi ? (int)r[0] : cnt; }
        const float inv = 1.f / tot_all;
        int pos = hi ? cnt_lo : 0;
        int* ri = RIDX + (size_t)t * 128 + hh * 16; float* rg = RGATE + (size_t)t * 128 + hh * 16;
#pragma unroll
        for (int k2 = 0; k2 < 25; ++k2) {
            if (ok[k2] >= K16) {
                const int ea = hi ? (T0[A1[k2]] & 0x7f) : (T0[A0[k2]] & 0x7f), eb = hi ? (T1[B1[k2]] & 0x7f) : (T1[B0[k2]] & 0x7f);
                ri[pos] = ea * 128 + eb; rg[pos] = __builtin_amdgcn_exp2f((unmono(ok[k2] & ~0x3f) - smax) * LOG2E) * inv; pos += 1;
            }
        }
    }
    asm volatile("s_waitcnt vmcnt(0) lgkmcnt(0)" ::: "memory"); __builtin_amdgcn_s_barrier(); asm volatile("" ::: "memory");
}
}

#ifndef REP_LIST
#define REP_LIST {1, 1, 1, 1, 1, 1, 1, 1, 1, 1, 1, 1, 1, 1}
#endif
__device__ constexpr int REP[14] = REP_LIST;
__global__ void __launch_bounds__(NWAVES * 64, 2) mk_fwd(Args args) {
    extern __shared__ __attribute__((aligned(16))) unsigned char lds[];
    Frame F;
    F.lds = (LAS unsigned char*)lds; F.tid = threadIdx.x; F.lane = F.tid & 63; F.wave = __builtin_amdgcn_readfirstlane(F.tid >> 6);
    F.G = gridDim.x; F.gw = blockIdx.x * NWAVES + F.wave; F.NGW = F.G * NWAVES; F.ws = args.ws;
    volatile LAS unsigned* MISC = (volatile LAS unsigned*)(F.lds + MISC_OFF);
    for (int u = F.tid; u < (LDS_BYTES - LDSCTL_OFF) / 4; u += NWAVES * 64) ((LAS unsigned*)(F.lds + LDSCTL_OFF))[u] = 0u;
    __syncthreads();
    unsigned* ctl = (unsigned*)(args.ws + WS_CTL);
    XcdBarrier bar = xcd_barrier_post(ctl + CW_BAR + args.bar_region * XCD_BAR_WORDS, MISC + 8);
    const int lo = args.ph_lo, hi = args.ph_hi;
#define IN(k) (lo <= (k) && (k) < hi)
#define NEXTP(k) ((k) == 5 ? 7 : (k) == 8 ? 10 : (k) + 1)
#define BOTH(k) (IN(k) && IN(NEXTP(k)))
    unsigned char* ws = args.ws;
    bf16_t* Qb = (bf16_t*)args.out; bf16_t* Kb = Qb + (size_t)T_ * 768; bf16_t* Vb = Kb + (size_t)T_ * 768;

    if (IN(0)) for (int rep_ = 0; rep_ < REP[0]; ++rep_) { p0_prologue(F, args); if (BOTH(0)) xcd_barrier(bar); }

    if (IN(1)) for (int rep_ = 0; rep_ < REP[1]; ++rep_) {
        { pg8::Gemm g{(const bf16_t*)(ws + WS_RA), (const bf16_t*)(ws + WO_WIN), 1024, 1024, T_, 2560, 1024};
          pg8::StaticOrder S; S.init(T_, 2560, F.G, (int)blockIdx.x);
          pg8::EpiGen<0, false, 0, true> E{(bf16_t*)(ws + WS_RB), PJ, nullptr, nullptr, 0, 0.f, 1.f, nullptr, 0, (float*)(ws + PSS1_OFF), 3, T_, nullptr, nullptr};
          pg8::gemm_phase<decltype(E), pg8::StaticOrder, PG8_ALIGN, PG8_SP2>(F.lds + RING_OFF, g, S, E, F.wave); }
        { pg8::Gemm g{(const bf16_t*)(ws + WS_MEMN), (const bf16_t*)(ws + WO_WXKV), 1024, 1024, TM_, 1024, 1024};
          pg8::StaticOrder S; S.init(TM_, 1024, F.G, (int)((blockIdx.x + F.G - 128) % F.G));
          pg8::EpiGen<0, false, 0, false> E{(bf16_t*)(ws + WS_KX), 1024, nullptr, nullptr, 0, 0.f, 1.f, nullptr, 0, nullptr, 0, TM_, nullptr, nullptr};
          pg8::gemm_phase<decltype(E), pg8::StaticOrder, PG8_ALIGN, PG8_SP2>(F.lds + RING_OFF, g, S, E, F.wave); }
        { pg8::Gemm g{(const bf16_t*)(ws + WO_WXKV) + (size_t)1024 * 1024, (const bf16_t*)(ws + WS_MEMN), 1024, 1024, 1024, TM_, 1024};
          pg8::StaticOrder S; S.init(1024, TM_, F.G, (int)((blockIdx.x + F.G - 160) % F.G));
          pg8::EpiGen<0, false, 0, false> E{(bf16_t*)(ws + WS_VXT), 2048, nullptr, nullptr, 0, 0.f, 1.f, nullptr, 0, nullptr, 0, 1024, nullptr, nullptr};
          pg8::gemm_phase<decltype(E), pg8::StaticOrder, PG8_ALIGN, PG8_SP2>(F.lds + RING_OFF, g, S, E, F.wave); }
        if (BOTH(1)) xcd_barrier(bar);
    }

    if (IN(2)) for (int rep_ = 0; rep_ < REP[2]; ++rep_) {
        { pg8::Gemm g{(const bf16_t*)(ws + WS_RB) + 512, (const bf16_t*)(ws + WO_WUKV), PJ, 256, T_, 1024, 256};
          pg8::StaticOrder S; S.init(T_, 1024, F.G, (int)blockIdx.x);
          pg8::EpiGen<2, true, 0, false> E{Kb, 768, Vb, (const float*)(ws + PSS1_OFF) + (size_t)8 * T_, 4, 1.f / 256.f, 1.f, nullptr, 0, nullptr, 0, T_, nullptr, nullptr};
          pg8::gemm_phase<decltype(E), pg8::StaticOrder, PG8_ALIGN, PG8_SP2>(F.lds + RING_OFF, g, S, E, F.wave); }
        { pg8::Gemm g{(const bf16_t*)(ws + WS_RB), (const bf16_t*)(ws + WO_WUQ), PJ, 384, T_, 768, 384};
          pg8::StaticOrder S; S.init(T_, 768, F.G, (int)((blockIdx.x + F.G - 64) % F.G));
          pg8::EpiGen<1, true, 0, false> E{Qb, 768, nullptr, (const float*)(ws + PSS1_OFF), 8, 1.f / 384.f, LOG2E * 0.10206207261596577f, nullptr, 0, nullptr, 0, T_, (const float*)(ws + WS_COS), (const float*)(ws + WS_SIN)};
          pg8::gemm_phase<decltype(E), pg8::StaticOrder, PG8_ALIGN, PG8_SP2>(F.lds + RING_OFF, g, S, E, F.wave); }
        p2_conv_job(F, args);
        if (BOTH(2)) xcd_barrier(bar);
    }

    if (IN(3)) for (int rep_ = 0; rep_ < REP[3]; ++rep_) {
        const int vcu = (F.G % 8 == 0) ? (int)((blockIdx.x % 8) * (F.G / 8) + blockIdx.x / 8) : (int)blockIdx.x;
        int lane = __builtin_amdgcn_mbcnt_hi(~0u, __builtin_amdgcn_mbcnt_lo(~0u, 0u)); asm volatile("" : "+v"(lane));
        for (int v = vcu; v < 256; v += F.G) {
            const int bh = v >> 2, sx = v & 3;
            mla::unit<8>(bh >> 3, bh & 7, 7 - sx, Qb, Kb, Vb, (bf16_t*)(ws + WS_RA), F.lds + RING_OFF, F.wave, lane);
            mla::unit<8>(bh >> 3, bh & 7, sx, Qb, Kb, Vb, (bf16_t*)(ws + WS_RA), F.lds + RING_OFF, F.wave, lane);
        }
        if (BOTH(3)) xcd_barrier(bar);
    }

    if (IN(4)) for (int rep_ = 0; rep_ < REP[4]; ++rep_) {
        pg8::Gemm g{(const bf16_t*)(ws + WS_RA), (const bf16_t*)(ws + WO_WO), 1024, 1024, T_, 1024, 1024};
        pg8::StaticOrder S; S.init(T_, 1024, F.G, (int)blockIdx.x);
        pg8::EpiGen<0, false, 1, true> E{(bf16_t*)(ws + WS_RB), 1024, nullptr, nullptr, 0, 0.f, 1.f, args.in[0], 1024, (float*)(ws + PSS4_OFF), 4, T_, nullptr, nullptr};
        pg8::gemm_phase<decltype(E), pg8::StaticOrder, PG8_ALIGN, PG8_SP2>(F.lds + RING_OFF, g, S, E, F.wave);
        if (BOTH(4)) xcd_barrier(bar);
    }

    if (IN(5)) for (int rep_ = 0; rep_ < REP[5]; ++rep_) {
        pg8::StaticOrder S0; S0.init(T_, 1024, F.G, (int)blockIdx.x);
        for (int ui = 0; ; ++ui) {
            pg8::Unit u; if (!S0.next(ui, u)) break;
            const int bb = u.pm >> 3, hh = u.pn;
            if (ui > 0) { __builtin_amdgcn_fence(__ATOMIC_ACQUIRE, "agent"); asm volatile("s_waitcnt vmcnt(0)" ::: "memory"); __syncthreads(); }
            bf16_t* QXt = (bf16_t*)(ws + WS_RA) + (size_t)u.pm * 256 * 1024 + hh * 256;
            bf16_t* PXt = (bf16_t*)(ws + WS_RD) + (size_t)blockIdx.x * 65536;
            { pg8::Gemm g{(const bf16_t*)(ws + WS_RB), (const bf16_t*)(ws + WO_WXQ), 1024, 1024, T_, 1024, 1024};
              pg8::FixedUnit S{u.pm, u.pn};
              pg8::EpiGen<0, true, 0, false> E{(bf16_t*)(ws + WS_RA), 1024, nullptr, (const float*)(ws + PSS4_OFF), 16, 1.f / 1024.f, LOG2E / 16.f, nullptr, 0, nullptr, 0, T_, nullptr, nullptr};
              pg8::gemm_phase<decltype(E), pg8::FixedUnit, false, PG8_SP2>(F.lds + RING_OFF, g, S, E, F.wave); }
            { pg8::Gemm g{QXt, (const bf16_t*)(ws + WS_KX) + (size_t)bb * 256 * 1024 + hh * 256, 1024, 1024, 256, 256, 256};
              pg8::SingleUnit S; pg8::EpiSoftmax E{PXt, 256};
              pg8::gemm_phase<pg8::EpiSoftmax, pg8::SingleUnit, false, PG8_SP2>(F.lds + RING_OFF, g, S, E, F.wave); }
            { pg8::Gemm g{PXt, (const bf16_t*)(ws + WS_VXT) + (size_t)hh * 256 * 2048 + bb * 256, 256, 2048, 256, 256, 256};
              pg8::SingleUnit S;
              pg8::EpiGen<0, false, 0, false> E{(bf16_t*)(ws + WS_RC) + (size_t)u.pm * 256 * 1024 + hh * 256, 1024, nullptr, nullptr, 0, 0.f, 1.f, nullptr, 0, nullptr, 0, T_, nullptr, nullptr};
              pg8::gemm_phase<decltype(E), pg8::SingleUnit, false, PG8_SP2>(F.lds + RING_OFF, g, S, E, F.wave); }
        }
        if (BOTH(5)) xcd_barrier(bar);
    }


    if (IN(7)) for (int rep_ = 0; rep_ < REP[7]; ++rep_) {
        pg8::Gemm g{(const bf16_t*)(ws + WS_RC), (const bf16_t*)(ws + WO_WXO), 1024, 1024, T_, 1024, 1024};
        pg8::StaticOrder S; S.init(T_, 1024, F.G, (int)blockIdx.x);
        pg8::EpiGen<0, false, 2, true> E{(bf16_t*)(ws + WS_RA), 1024, nullptr, nullptr, 0, 0.f, 1.f, (const void*)(ws + WS_RB), 1024, (float*)(ws + PSS6_OFF), 4, T_, nullptr, nullptr};
        pg8::gemm_phase<decltype(E), pg8::StaticOrder, PG8_ALIGN, PG8_SP2>(F.lds + RING_OFF, g, S, E, F.wave);
        if (BOTH(7)) xcd_barrier(bar);
    }

    if (IN(8)) for (int rep_ = 0; rep_ < REP[8]; ++rep_) {
        pg8::StaticOrder S0; S0.init(T_, 1024, F.G, (int)blockIdx.x);
        for (int ui = 0; ; ++ui) {
            pg8::Unit u; if (!S0.next(ui, u)) break;
            { pg8::Gemm g{(const bf16_t*)(ws + WS_RA), (const bf16_t*)(ws + WO_WPQ), 1024, 1024, T_, 1024, 1024};
              pg8::FixedUnit S{u.pm, u.pn};
              pg8::EpiGen<0, true, 0, false> E{(bf16_t*)(ws + WS_RC), 1024, nullptr, (const float*)(ws + PSS6_OFF), 16, 1.f / 1024.f, 1.f, nullptr, 0, nullptr, 0, T_, nullptr, nullptr};
              pg8::gemm_phase<decltype(E), pg8::FixedUnit, false, PG8_SP2>(F.lds + RING_OFF, g, S, E, F.wave); }
            int lane = __builtin_amdgcn_mbcnt_hi(~0u, __builtin_amdgcn_mbcnt_lo(~0u, 0u)); asm volatile("" : "+v"(lane));
            rt::route_unit(u.pm, u.pn, (const bf16_t*)(ws + WS_RC), (const bf16_t*)(ws + WO_SK), (int*)(ws + WS_RIDX), (float*)(ws + WS_RGATE), F.lds + RING_OFF, F.wave, lane);
        }
        if (BOTH(8)) xcd_barrier(bar);
    }


    if (IN(10)) for (int rep_ = 0; rep_ < REP[10]; ++rep_) { p_peer_u(F, args); if (BOTH(10)) xcd_barrier(bar); }
    if (IN(11)) for (int rep_ = 0; rep_ < REP[11]; ++rep_) { p_peer_v(F, args); }
#undef IN
#undef BOTH
}

extern "C" void kernel_launch(void* const* d_in, const int* in_sizes, int n_in, void* d_out, int out_size, void* d_ws, size_t ws_size, hipStream_t stream) {
    const float* x = (const float*)d_in[0];
    const float* g_out = (const float*)d_in[10]; const float* w_o = (const float*)d_in[11];
    const float* g_x = (const float*)d_in[12]; const float* w_xq = (const float*)d_in[14];
    const float* w_xo = (const float*)d_in[16]; const float* g_ffn = (const float*)d_in[17];
    const float* w_pq = (const float*)d_in[18]; const float* sub_keys = (const float*)d_in[19]; const float* u_exp = (const float*)d_in[20];
    const float* v_exp = (const float*)d_in[21]; const float* g_final = (const float*)d_in[22];
    float* out = (float*)d_out; unsigned char* ws = (unsigned char*)d_ws;
    if (ws_size < WS_END || n_in != 23) return;
    static int grid = 0;
    if (grid == 0) {
        int dev = 0, cus = 0;
        if (hipGetDevice(&dev) != hipSuccess || hipDeviceGetAttribute(&cus, hipDeviceAttributeMultiprocessorCount, dev) != hipSuccess) { grid = -1; return; }
        if (hipFuncSetAttribute((const void*)mk_fwd, hipFuncAttributeMaxDynamicSharedMemorySize, LDS_BYTES) != hipSuccess) { grid = -1; return; }
        grid = cus;
    }
    if (grid < 0) return;
    bf16_t* KX = (bf16_t*)(ws + WS_KX); bf16_t* VXT = (bf16_t*)(ws + WS_VXT);
    float* RS1 = (float*)(ws + WS_RIDX) - 2 * T_; float* RS2 = RS1 + T_;
    int* RIDX = (int*)(ws + WS_RIDX); float* RGATE = (float*)(ws + WS_RGATE);
    bf16_t* Y = (bf16_t*)(ws + WS_RA); bf16_t* QX = Y; bf16_t* H2 = Y;
    bf16_t* H1 = (bf16_t*)(ws + WS_RB);
    bf16_t* OX = (bf16_t*)(ws + WS_RC); bf16_t* QP = OX;
    bf16_t* Q = (bf16_t*)d_out; bf16_t* K = Q + (size_t)T_ * 768; bf16_t* V = K + (size_t)T_ * 768;

    hipMemsetAsync(ws + WS_CTL, 0, CTL_ZERO_BYTES, stream);
    Args a; memset(&a, 0, sizeof a);
    for (int i = 0; i < 23; ++i) a.in[i] = d_in[i];
    a.out = out; a.ws = ws;
    a.ph_lo = 0; a.ph_hi = 12; a.bar_region = 0;
    hipLaunchKernelGGL(mk_fwd, dim3(grid), dim3(NWAVES * 64), LDS_BYTES, stream, a);
}
```

```cpp
#include <hip/hip_runtime.h>
#include <stdint.h>
#include <math.h>
#include <string.h>

typedef unsigned short bf16_t;
constexpr int T_ = 16384, D_ = 1024, B_ = 8, S_ = 2048, ML_ = 256, TM_ = 2048;
constexpr int PJ = 2560;
constexpr float EPS_ = 1e-6f;
constexpr float LOG2E = 1.4426950408889634f;

constexpr size_t MiB = 1u << 20;
constexpr size_t WS_CTL = 0;
constexpr size_t WS_COS = 2 * MiB, WS_SIN = 3 * MiB;
constexpr size_t WS_W = 4 * MiB;
constexpr size_t WS_UT = 24 * MiB, WS_VT = 56 * MiB;
constexpr size_t WS_MEMN = 88 * MiB, WS_KX = 92 * MiB, WS_VXT = 96 * MiB;
constexpr size_t WS_RS = 100 * MiB;
constexpr size_t WS_SCL = 105 * MiB;
constexpr size_t WS_RIDX = 106 * MiB, WS_RGATE = 114 * MiB;
constexpr size_t WS_RA = 122 * MiB;
constexpr size_t WS_RB = 154 * MiB;
constexpr size_t WS_RC = 186 * MiB;
constexpr size_t WS_RD = 218 * MiB;
constexpr size_t WS_END = 256 * MiB;

__device__ __forceinline__ float bf2f(bf16_t b) { return __uint_as_float(((unsigned)b) << 16); }
__device__ __forceinline__ bf16_t f2bf(float f) { unsigned u = __float_as_uint(f); return (bf16_t)((u + 0x7fffu + ((u >> 16) & 1u)) >> 16); }
__device__ __forceinline__ unsigned q8pack(float f0, float f1, float f2, float f3, float qs) {
    const unsigned a0 = __float_as_uint(fmaf(f0, qs, 12582912.f)), a1 = __float_as_uint(fmaf(f1, qs, 12582912.f)), a2 = __float_as_uint(fmaf(f2, qs, 12582912.f)), a3 = __float_as_uint(fmaf(f3, qs, 12582912.f));
    return __builtin_amdgcn_perm(a1, a0, 0x0c0c0400u) | __builtin_amdgcn_perm(a3, a2, 0x04000c0cu);
}
__device__ __forceinline__ float wave_sum(float v) {
#pragma unroll
    for (int o = 1; o < 64; o <<= 1) v += __shfl_xor(v, o);
    return v;
}
__device__ __forceinline__ float wave_max(float v) {
#pragma unroll
    for (int o = 1; o < 64; o <<= 1) v = fmaxf(v, __shfl_xor(v, o));
    return v;
}

namespace pg8 {
#define PG8_LAS __attribute__((address_space(3)))
typedef short bf16x8 __attribute__((ext_vector_type(8)));
typedef float f32x4 __attribute__((ext_vector_type(4)));
typedef unsigned u32x4 __attribute__((ext_vector_type(4)));
constexpr int BM = 256, BK = 64, HALF = 128, HTB = HALF * BK * 2  , STAGE_BYTES = 8 * HTB, NXCD = 8, WGM = 8;

__host__ __device__ __forceinline__ int lds_byte(int r, int c) { const int st = (r >> 4) * 2 + (c >> 5), rr = r & 15, cc = c & 31, ob = rr * 64 + cc * 2; return st * 1024 + (ob ^ (((ob >> 9) & 1) << 5)); }
__host__ __device__ __forceinline__ void stage_rc(int b, int& R, int& C) { const int st = b / 1024, sb = b % 1024, swz = sb ^ (((sb >> 9) & 1) << 5); R = (st >> 1) * 16 + swz / 64; C = (st & 1) * 32 + (swz % 64) / 2; }
__host__ __device__ __forceinline__ int perm32(int rho) { const int n = rho >> 4, i = rho & 15; return 8 * (i >> 2) + 4 * n + (i & 3); }

struct Unit { int pm, pn; };
struct Gemm { const bf16_t* A; const bf16_t* Bt; int lda, ldb, M, N, K; };

struct StaticOrder {
    int nM, nN, nwg, G, c;
    __host__ __device__ __forceinline__ void init(int M, int N, int G_, int c_) { nM = M / BM; nN = N / BM; nwg = nM * nN; G = G_; c = c_; }
    __host__ __device__ __forceinline__ bool next(int i, Unit& u) const {
        const long L = (long)i * G + c; if (L >= nwg) return false;
        int wgid = (int)L; { const int q = nwg / NXCD, r = nwg % NXCD, xcd = wgid % NXCD, off = wgid / NXCD; wgid = (xcd < r ? xcd * (q + 1) : r * (q + 1) + (xcd - r) * q) + off; }
        const int nig = WGM * nN, gid = wgid / nig, fm = gid * WGM, gsz = (nM - fm) < WGM ? (nM - fm) : WGM;
        u.pm = fm + ((wgid % nig) % gsz); u.pn = (wgid % nig) / gsz; return true;
    }
    __device__ __forceinline__ void a_ready(const Unit&) const {}
    __device__ __forceinline__ void done(const Unit&) const {}
};

__device__ __forceinline__ unsigned cvt_pk_bf16(float lo, float hi) { unsigned r; asm volatile("v_cvt_pk_bf16_f32 %0, %1, %2" : "=v"(r) : "v"(lo), "v"(hi)); return r; }
__device__ __forceinline__ float bflo(unsigned w) { return __uint_as_float(w << 16); }
__device__ __forceinline__ float bfhi(unsigned w) { return __uint_as_float(w & 0xffff0000u); }

template <int MODE, bool RSCALE, int RES  , bool PSS>
struct EpiGen {
    static constexpr bool PERM = true, AFTER_DRAIN = false;
    bf16_t* O; int ldc; bf16_t* O2;
    const float* parts; int nparts; float inv_dim; float cscale;
    const void* R; int ldr;
    float* pss; int pss_tiles; int rows_total;
    const float* COS; const float* SIN;
    __device__ __forceinline__ void operator()(const f32x4 (&acc)[2][2][4][2], const Unit& u, int wr, int wc, int fr, int fq) const {
        { int ln = __builtin_amdgcn_mbcnt_hi(~0u, __builtin_amdgcn_mbcnt_lo(~0u, 0u)); asm volatile("" : "+v"(ln)); fr = ln & 15; fq = ln >> 4; }
        const int row0 = u.pm * BM + wr * 64 + fr;
        const int colb = u.pn * BM + wc * 32 + 8 * fq;
#pragma unroll
        for (int ai = 0; ai < 2; ++ai) {
            float psum[4]; f32x4 rf[4][2][2]; u32x4 rw[4][2];
#pragma unroll
            for (int m = 0; m < 4; ++m) {
                const int row = row0 + ai * HALF + m * 16;
                if (RSCALE) { float s = 0.f;
#pragma unroll
                    for (int i = 0; i < 4; ++i) { const int p = fq + 4 * i; const float pv = parts[(size_t)(p < nparts ? p : fq) * rows_total + row]; s += (p < nparts) ? pv : 0.f; }
                    psum[m] = s; }
#pragma unroll
                for (int bj = 0; bj < 2; ++bj) { const int col = colb + bj * HALF;
                    if (RES == 1) { const float* r = (const float*)R + (size_t)row * ldr + col; rf[m][bj][0] = *(const f32x4*)r; rf[m][bj][1] = *(const f32x4*)(r + 4); }
                    if (RES == 2) rw[m][bj] = *(const u32x4*)((const bf16_t*)R + (size_t)row * ldr + col); }
            }
#pragma unroll
            for (int m = 0; m < 4; ++m) {
                const int row = row0 + ai * HALF + m * 16;
                float rs = cscale;
                if (RSCALE) { float s = psum[m]; s += __shfl_xor(s, 16); s += __shfl_xor(s, 32); rs *= rsqrtf(s * inv_dim + 1e-6f); }
                float ss = 0.f;
#pragma unroll
                for (int bj = 0; bj < 2; ++bj) {
                    const int col = colb + bj * HALF;
                    f32x4 v0 = acc[ai][bj][m][0] * rs, v1 = acc[ai][bj][m][1] * rs;
                    if (RES == 1) { v0 += rf[m][bj][0]; v1 += rf[m][bj][1]; }
                    if (RES == 2) { const u32x4 w = rw[m][bj];
                        v0 += (f32x4){bflo(w.x), bfhi(w.x), bflo(w.y), bfhi(w.y)}; v1 += (f32x4){bflo(w.z), bfhi(w.z), bflo(w.w), bfhi(w.w)}; }
                    if (PSS) ss += (v0[0] * v0[0] + v0[1] * v0[1]) + (v0[2] * v0[2] + v0[3] * v0[3]) + (v1[0] * v1[0] + v1[1] * v1[1]) + (v1[2] * v1[2] + v1[3] * v1[3]);
                    bf16_t* dst;
                    if (MODE == 1) {
                        const int pr = col % 96;
                        if (pr >= 64) { const int i0 = (pr - 64) >> 1; const f32x4 c = *(const f32x4*)(COS + (size_t)row * 16 + i0), s = *(const f32x4*)(SIN + (size_t)row * 16 + i0);
                            const f32x4 a0 = v0, a1 = v1;
                            v0[0] = a0[0] * c[0] - a0[1] * s[0]; v0[1] = a0[1] * c[0] + a0[0] * s[0]; v0[2] = a0[2] * c[1] - a0[3] * s[1]; v0[3] = a0[3] * c[1] + a0[2] * s[1];
                            v1[0] = a1[0] * c[2] - a1[1] * s[2]; v1[1] = a1[1] * c[2] + a1[0] * s[2]; v1[2] = a1[2] * c[3] - a1[3] * s[3]; v1[3] = a1[3] * c[3] + a1[2] * s[3]; }
                        dst = O + (size_t)row * 768 + col;
                    } else if (MODE == 2) {
                        if (col < 512) dst = O + (size_t)row * 768 + (col >> 6) * 96 + (col & 63); else dst = O2 + (size_t)row * 512 + (col - 512);
                    } else dst = O + (size_t)row * ldc + col;
                    u32x4 w; w.x = cvt_pk_bf16(v0[0], v0[1]); w.y = cvt_pk_bf16(v0[2], v0[3]); w.z = cvt_pk_bf16(v1[0], v1[1]); w.w = cvt_pk_bf16(v1[2], v1[3]);
                    *(u32x4*)dst = w;
                }
                if (PSS) { if (u.pn < pss_tiles) { ss += __shfl_xor(ss, 16); ss += __shfl_xor(ss, 32); if (fq == 0) pss[(size_t)(u.pn * 4 + wc) * rows_total + row] = ss; } }
            }
            asm volatile("" ::: "memory");
        }
    }
};

struct SingleUnit {
    __device__ __forceinline__ bool next(int i, Unit& u) const { if (i > 0) return false; u.pm = 0; u.pn = 0; return true; }
    __device__ __forceinline__ void a_ready(const Unit&) const {}
    __device__ __forceinline__ void done(const Unit&) const {}
};
struct FixedUnit {
    int pm, pn;
    __device__ __forceinline__ bool next(int i, Unit& u) const { if (i > 0) return false; u.pm = pm; u.pn = pn; return true; }
    __device__ __forceinline__ void a_ready(const Unit&) const {}
    __device__ __forceinline__ void done(const Unit&) const {}
};

struct EpiSoftmax {
    static constexpr bool PERM = true, AFTER_DRAIN = true;
    bf16_t* O; int ldc;
    __device__ __forceinline__ void fused(f32x4 (&acc)[2][2][4][2], const Unit& u, int wr, int wc, int fr, int fq, PG8_LAS unsigned char* lds, int wid, int lane) const {
        PG8_LAS float* PM = (PG8_LAS float*)lds;
        PG8_LAS float* PS = (PG8_LAS float*)(lds + 4096);
#pragma unroll
        for (int ai = 0; ai < 2; ++ai)
#pragma unroll
            for (int m = 0; m < 4; ++m) {
                const int row = ai * HALF + wr * 64 + m * 16 + fr;
                float mx = -INFINITY;
#pragma unroll
                for (int bj = 0; bj < 2; ++bj)
#pragma unroll
                    for (int n = 0; n < 2; ++n) { const f32x4 v = acc[ai][bj][m][n]; mx = fmaxf(mx, fmaxf(fmaxf(v[0], v[1]), fmaxf(v[2], v[3]))); }
                mx = fmaxf(mx, __shfl_xor(mx, 16)); mx = fmaxf(mx, __shfl_xor(mx, 32));
                if (fq == 0) PM[row * 4 + wc] = mx;
            }
        asm volatile("s_waitcnt lgkmcnt(0)" ::: "memory"); __builtin_amdgcn_s_barrier(); asm volatile("" ::: "memory");
#pragma unroll
        for (int ai = 0; ai < 2; ++ai)
#pragma unroll
            for (int m = 0; m < 4; ++m) {
                const int row = ai * HALF + wr * 64 + m * 16 + fr;
                const f32x4 pm = *(const PG8_LAS f32x4*)(PM + row * 4);
                const float mrow = fmaxf(fmaxf(pm[0], pm[1]), fmaxf(pm[2], pm[3]));
                float sm = 0.f;
#pragma unroll
                for (int bj = 0; bj < 2; ++bj)
#pragma unroll
                    for (int n = 0; n < 2; ++n) { f32x4 v = acc[ai][bj][m][n];
                        v[0] = __builtin_amdgcn_exp2f(v[0] - mrow); v[1] = __builtin_amdgcn_exp2f(v[1] - mrow); v[2] = __builtin_amdgcn_exp2f(v[2] - mrow); v[3] = __builtin_amdgcn_exp2f(v[3] - mrow);
                        sm += (v[0] + v[1]) + (v[2] + v[3]); acc[ai][bj][m][n] = v; }
                sm += __shfl_xor(sm, 16); sm += __shfl_xor(sm, 32);
                if (fq == 0) PS[row * 4 + wc] = sm;
            }
        asm volatile("s_waitcnt lgkmcnt(0)" ::: "memory"); __builtin_amdgcn_s_barrier(); asm volatile("" ::: "memory");
#pragma unroll
        for (int ai = 0; ai < 2; ++ai)
#pragma unroll
            for (int m = 0; m < 4; ++m) {
                const int row = ai * HALF + wr * 64 + m * 16 + fr;
                const f32x4 ps = *(const PG8_LAS f32x4*)(PS + row * 4);
                const float inv = 1.f / ((ps[0] + ps[1]) + (ps[2] + ps[3]));
#pragma unroll
                for (int bj = 0; bj < 2; ++bj) {
                    const f32x4 v0 = acc[ai][bj][m][0] * inv, v1 = acc[ai][bj][m][1] * inv;
                    u32x4 w; w.x = cvt_pk_bf16(v0[0], v0[1]); w.y = cvt_pk_bf16(v0[2], v0[3]); w.z = cvt_pk_bf16(v1[0], v1[1]); w.w = cvt_pk_bf16(v1[2], v1[3]);
                    *(u32x4*)(O + (size_t)row * ldc + bj * HALF + wc * 32 + 8 * fq) = w;
                }
            }
        asm volatile("s_waitcnt vmcnt(0) lgkmcnt(0)" ::: "memory"); __builtin_amdgcn_s_barrier(); asm volatile("" ::: "memory");
    }
};

template <class Epi, class Sched, bool ALIGN_EPI = false, bool SP2 = false>
__device__ __forceinline__ void gemm_phase(PG8_LAS unsigned char* lds, const Gemm g, const Sched& S, const Epi& E, const int wid_in  ) {
    int lane_ = __builtin_amdgcn_mbcnt_hi(~0u, __builtin_amdgcn_mbcnt_lo(~0u, 0u)); asm volatile("" : "+v"(lane_));
    const int wid = wid_in, lane = lane_, tid = wid * 64 + lane, wr = wid >> 2, wc = wid & 3, fr = lane & 15, fq = lane >> 4;
    const int K = g.K, nt = K / BK;
    unsigned voffA[2], voffB[2];
#pragma unroll
    for (int i = 0; i < 2; ++i) { int R, C; stage_rc(tid * 16 + i * 8192, R, C); const int Rb = Epi::PERM ? ((R & ~31) + perm32(R & 31)) : R;
        voffA[i] = (unsigned)(R * g.lda + C) * 2u; voffB[i] = (unsigned)(Rb * g.ldb + C) * 2u; }
    const size_t kstep = (size_t)(BK * 2);
    const size_t hstepA = (size_t)HALF * g.lda * 2, hstepB = (size_t)HALF * g.ldb * 2;
    const size_t tstepA = 2 * hstepA, tstepB = 2 * hstepB;
    const unsigned ldsw = (unsigned)wid * 1024u;
    const int aoff = lds_byte(wr * 64 + fr, fq * 8), boff = lds_byte(wc * 32 + fr, fq * 8);
#define PG8_SA(b, h) (((b) * 2 + (h)) * HTB)
#define PG8_SB(b, h) ((4 + (b) * 2 + (h)) * HTB)
#define PG8_STAGE(bufoff, gbase, voff) do { _Pragma("unroll") for (int _i = 0; _i < 2; ++_i) \
        __builtin_amdgcn_global_load_lds((const unsigned*)((const char*)(gbase) + (voff)[_i]), (PG8_LAS unsigned*)(lds + (bufoff) + ldsw + _i * 8192), 16, 0, 0); } while (0)
#define PG8_LDA(dst, b, h) do { _Pragma("unroll") for (int m = 0; m < 4; ++m) _Pragma("unroll") for (int k = 0; k < 2; ++k) dst[m][k] = *(const PG8_LAS bf16x8*)(lds + PG8_SA(b, h) + aoff + m * 2048 + k * 1024); } while (0)
#define PG8_LDB(dst, b, h) do { _Pragma("unroll") for (int n = 0; n < 2; ++n) _Pragma("unroll") for (int k = 0; k < 2; ++k) dst[n][k] = *(const PG8_LAS bf16x8*)(lds + PG8_SB(b, h) + boff + n * 2048 + k * 1024); } while (0)
#define PG8_MMA(ai, bj, At, Bt) do { __builtin_amdgcn_s_setprio(1); _Pragma("unroll") for (int m = 0; m < 4; ++m) _Pragma("unroll") for (int n = 0; n < 2; ++n) _Pragma("unroll") for (int k = 0; k < 2; ++k) \
        acc[ai][bj][m][n] = __builtin_amdgcn_mfma_f32_16x16x32_bf16(Bt[n][k], At[m][k], acc[ai][bj][m][n], 0, 0, 0); __builtin_amdgcn_s_setprio(0); } while (0)
#define PG8_WAIT_V(n) asm volatile("s_waitcnt vmcnt(" #n ")" ::: "memory")
#define PG8_WAIT_L(n) asm volatile("s_waitcnt lgkmcnt(" #n ")" ::: "memory")
#define PG8_BAR __builtin_amdgcn_s_barrier()
#define PG8_SCHED __builtin_amdgcn_sched_barrier(0)
    Unit cur, nxt; int ui = 0;
    if (!S.next(0, cur)) return;
    f32x4 acc[2][2][4][2];
#pragma unroll
    for (int a = 0; a < 2; ++a)
#pragma unroll
        for (int b = 0; b < 2; ++b)
#pragma unroll
            for (int m = 0; m < 4; ++m)
#pragma unroll
                for (int n = 0; n < 2; ++n) acc[a][b][m][n] = (f32x4){0.f, 0.f, 0.f, 0.f};
    bf16x8 At[4][2], B0[2][2], B1[2][2];
    const char* cA = (const char*)g.A + (size_t)cur.pm * tstepA; const char* cB = (const char*)g.Bt + (size_t)cur.pn * tstepB;
    S.a_ready(cur);
    if constexpr (SP2) {
        PG8_STAGE(PG8_SB(0, 0), cB, voffB); PG8_STAGE(PG8_SB(0, 1), cB + hstepB, voffB); PG8_STAGE(PG8_SA(0, 0), cA, voffA); PG8_STAGE(PG8_SA(0, 1), cA + hstepA, voffA);
        if (wr == 1) PG8_BAR;
        PG8_WAIT_V(2); PG8_BAR;
        PG8_STAGE(PG8_SB(1, 0), cB + kstep, voffB); PG8_STAGE(PG8_SA(1, 0), cA + kstep, voffA); PG8_STAGE(PG8_SB(1, 1), cB + hstepB + kstep, voffB);
        PG8_WAIT_V(6); PG8_BAR;
    } else {
        PG8_STAGE(PG8_SB(0, 0), cB, voffB); PG8_STAGE(PG8_SA(0, 0), cA, voffA); PG8_STAGE(PG8_SB(0, 1), cB + hstepB, voffB); PG8_STAGE(PG8_SA(0, 1), cA + hstepA, voffA);
        if (wr == 1) PG8_BAR;
        PG8_WAIT_V(4); PG8_BAR;
        PG8_STAGE(PG8_SB(1, 0), cB + kstep, voffB); PG8_STAGE(PG8_SA(1, 0), cA + kstep, voffA); PG8_STAGE(PG8_SB(1, 1), cB + hstepB + kstep, voffB);
        PG8_WAIT_V(6); PG8_BAR;
    }
    for (;;) {
        const bool has_next = S.next(ui + 1, nxt);
        const char* nA = has_next ? (const char*)g.A + (size_t)nxt.pm * tstepA : cA; const char* nB = has_next ? (const char*)g.Bt + (size_t)nxt.pn * tstepB : cB;
#pragma unroll 1
        for (int t = 0; t < nt; t += 2) {
            const bool last = (t == nt - 2);
            const char* a1 = cA + (size_t)(t + 1) * kstep;
            const char* a2 = last ? nA : cA + (size_t)(t + 2) * kstep; const char* b2 = last ? nB : cB + (size_t)(t + 2) * kstep;
            const char* a3 = a2 + kstep; const char* b3 = b2 + kstep;
            if (last && has_next) S.a_ready(nxt);
            if constexpr (SP2) {
            PG8_LDB(B0, 0, 0); PG8_LDB(B1, 0, 1); PG8_SCHED; PG8_LDA(At, 0, 0); PG8_STAGE(PG8_SA(1, 1), a1 + hstepA, voffA);
            PG8_WAIT_V(8); PG8_WAIT_L(0); PG8_BAR; PG8_MMA(0, 0, At, B0); PG8_MMA(0, 1, At, B1); PG8_BAR; PG8_SCHED;
            PG8_LDA(At, 0, 1); PG8_STAGE(PG8_SB(0, 0), b2, voffB); PG8_STAGE(PG8_SB(0, 1), b2 + hstepB, voffB); PG8_STAGE(PG8_SA(0, 0), a2, voffA);
            PG8_WAIT_V(8); PG8_WAIT_L(0); PG8_BAR; PG8_MMA(1, 0, At, B0); PG8_MMA(1, 1, At, B1); PG8_BAR; PG8_SCHED;
            PG8_LDB(B0, 1, 0); PG8_LDB(B1, 1, 1); PG8_SCHED; PG8_LDA(At, 1, 0); PG8_STAGE(PG8_SA(0, 1), a2 + hstepA, voffA);
            PG8_WAIT_V(8); PG8_WAIT_L(0); PG8_BAR; PG8_MMA(0, 0, At, B0); PG8_MMA(0, 1, At, B1); PG8_BAR; PG8_SCHED;
            PG8_LDA(At, 1, 1); PG8_STAGE(PG8_SB(1, 0), b3, voffB); PG8_STAGE(PG8_SB(1, 1), b3 + hstepB, voffB); PG8_STAGE(PG8_SA(1, 0), a3, voffA);
            PG8_WAIT_V(8); PG8_WAIT_L(0); PG8_BAR; PG8_MMA(1, 0, At, B0); PG8_MMA(1, 1, At, B1); PG8_BAR; PG8_SCHED;
            } else {
            PG8_LDB(B0, 0, 0); PG8_SCHED; PG8_LDA(At, 0, 0); PG8_STAGE(PG8_SA(1, 1), a1 + hstepA, voffA);
            PG8_WAIT_L(8); PG8_BAR; PG8_WAIT_L(0); PG8_MMA(0, 0, At, B0); PG8_BAR; PG8_SCHED;
            PG8_LDB(B1, 0, 1); PG8_STAGE(PG8_SB(0, 0), b2, voffB);
            PG8_BAR; PG8_WAIT_L(0); PG8_MMA(0, 1, At, B1); PG8_BAR;
            PG8_LDA(At, 0, 1); PG8_STAGE(PG8_SA(0, 0), a2, voffA);
            PG8_BAR; PG8_WAIT_L(0); PG8_MMA(1, 0, At, B0); PG8_BAR; PG8_SCHED;
            PG8_STAGE(PG8_SB(0, 1), b2 + hstepB, voffB);
            PG8_WAIT_V(6); PG8_BAR; PG8_MMA(1, 1, At, B1); PG8_BAR;
            PG8_LDB(B0, 1, 0); PG8_SCHED; PG8_LDA(At, 1, 0); PG8_STAGE(PG8_SA(0, 1), a2 + hstepA, voffA);
            PG8_WAIT_L(8); PG8_BAR; PG8_WAIT_L(0); PG8_MMA(0, 0, At, B0); PG8_BAR; PG8_SCHED;
            PG8_LDB(B1, 1, 1); PG8_STAGE(PG8_SB(1, 0), b3, voffB);
            PG8_BAR; PG8_WAIT_L(0); PG8_MMA(0, 1, At, B1); PG8_BAR;
            PG8_LDA(At, 1, 1); PG8_STAGE(PG8_SA(1, 0), a3, voffA);
            PG8_BAR; PG8_WAIT_L(0); PG8_MMA(1, 0, At, B0); PG8_BAR; PG8_SCHED;
            PG8_STAGE(PG8_SB(1, 1), b3 + hstepB, voffB);
            PG8_WAIT_V(6); PG8_BAR; PG8_MMA(1, 1, At, B1); PG8_BAR;
            }
        }
        if constexpr (ALIGN_EPI) { if (wr == 0) PG8_BAR; }
        if constexpr (!Epi::AFTER_DRAIN) { E(acc, cur, wr, wc, fr, fq); S.done(cur); }
        if (!has_next) break;
#pragma unroll
        for (int a = 0; a < 2; ++a)
#pragma unroll
            for (int b = 0; b < 2; ++b)
#pragma unroll
                for (int m = 0; m < 4; ++m)
#pragma unroll
                    for (int n = 0; n < 2; ++n) acc[a][b][m][n] = (f32x4){0.f, 0.f, 0.f, 0.f};
        cur = nxt; cA = nA; cB = nB; ++ui;
        if constexpr (ALIGN_EPI) { if (wr == 1) PG8_BAR; }
    }
    PG8_WAIT_V(0);
    if constexpr (!ALIGN_EPI) { if (wr == 0) PG8_BAR; }
    PG8_BAR;
    if constexpr (Epi::AFTER_DRAIN) { E.fused(acc, cur, wr, wc, fr, fq, lds, wid, lane); S.done(cur); }
#undef PG8_SA
#undef PG8_SB
#undef PG8_STAGE
#undef PG8_LDA
#undef PG8_LDB
#undef PG8_MMA
#undef PG8_WAIT_V
#undef PG8_WAIT_L
#undef PG8_BAR
#undef PG8_SCHED
}
}
#ifndef PG8_SP2
#define PG8_SP2 true
#endif
#ifndef PG8_ALIGN
#define PG8_ALIGN true
#endif

constexpr int NWAVES = 8;
constexpr int RING_OFF = 0, RING_BYTES = 131072;
constexpr int LDSCTL_OFF = RING_BYTES, MISC_OFF = LDSCTL_OFF + 320;
constexpr int LDS_BYTES = 147456;
constexpr int CW_BAR = 4096;
constexpr size_t CTL_ZERO_BYTES = 64 * 1024;

constexpr size_t WO_WIN = WS_W;
constexpr size_t WO_WUQ = WO_WIN + (size_t)2560 * 1024 * 2;
constexpr size_t WO_WUKV = WO_WUQ + (size_t)768 * 384 * 2;
constexpr size_t WO_WO = WO_WUKV + (size_t)1024 * 256 * 2;
constexpr size_t WO_WXQ = WO_WO + (size_t)1024 * 1024 * 2;
constexpr size_t WO_WXKV = WO_WXQ + (size_t)1024 * 1024 * 2;
constexpr size_t WO_WXO = WO_WXKV + (size_t)2048 * 1024 * 2;
constexpr size_t WO_WPQ = WO_WXO + (size_t)1024 * 1024 * 2;
constexpr size_t WO_SK = WO_WPQ + (size_t)1024 * 1024 * 2;
constexpr size_t WO_END = WO_SK + (size_t)16 * 128 * 64 * 2;
static_assert(WO_END <= WS_UT, "weights region");
constexpr size_t PSS1_OFF = WS_RS;
constexpr size_t PSS4_OFF = PSS1_OFF + (size_t)12 * T_ * 4;
constexpr size_t PSS6_OFF = PSS4_OFF + (size_t)16 * T_ * 4;
static_assert(PSS6_OFF + (size_t)16 * T_ * 4 <= WS_RIDX, "pss region");

#define GAS __attribute__((address_space(1)))
#define LAS __attribute__((address_space(3)))
typedef unsigned v4u __attribute__((ext_vector_type(4)));
typedef float f32x4 __attribute__((ext_vector_type(4)));
typedef GAS unsigned gu32;
#define RLX_AGENT __ATOMIC_RELAXED, __HIP_MEMORY_SCOPE_AGENT
#define LDS_WAIT() asm volatile("s_waitcnt lgkmcnt(0)" ::: "memory")
#define VM_WAIT() asm volatile("s_waitcnt vmcnt(0)" ::: "memory")
__device__ __forceinline__ unsigned pk2(float lo, float hi) { return (unsigned)f2bf(lo) | ((unsigned)f2bf(hi) << 16); }

#define XB_TMO      128
#define XB_XCNT(j)  (256  + 64 * (j))
#define XB_XSUB(j)  (1280 + 64 * (j))
#define XB_XGEN(j)  (2304 + 64 * (j))
#define XB_TOP      3328
#define XB_TOPGEN   3392
#define XCD_BAR_WORDS 3456
#define XB_SPIN_CAP (1u << 18)
__device__ __forceinline__ unsigned xb_ld(unsigned* p)              { return __hip_atomic_load(p, __ATOMIC_RELAXED, __HIP_MEMORY_SCOPE_AGENT); }
__device__ __forceinline__ unsigned xb_add(unsigned* p, unsigned v) { return __hip_atomic_fetch_add(p, v, __ATOMIC_RELAXED, __HIP_MEMORY_SCOPE_AGENT); }
__device__ __forceinline__ unsigned xb_xcc_id() { return (unsigned)__builtin_amdgcn_s_getreg((3 << 11) | 20) & 0xFu; }
#define XB_SPIN(cond, bar) do { unsigned _sp = 0; while (cond) { __builtin_amdgcn_s_sleep(1); \
    if ((++_sp & 255u) == 0u) { if (xb_ld(&(bar)[XB_TMO])) break; if (_sp > XB_SPIN_CAP) { atomicAdd(&(bar)[XB_TMO], 1u); break; } } } } while (0)
struct XcdBarrier { unsigned* bar; unsigned x; volatile LAS unsigned* st; };
__device__ __forceinline__ XcdBarrier xcd_barrier_post(unsigned* bar, volatile LAS unsigned* st) {
    XcdBarrier b; b.bar = bar; b.x = xb_xcc_id(); b.st = st;
    if (threadIdx.x == 0) (void)xb_add(&bar[XB_XCNT(b.x)], 1u);
    return b;
}
__device__ __forceinline__ void xcd_barrier_complete(unsigned* bar, unsigned x, unsigned& nloc, unsigned& nx) {
    const unsigned G = gridDim.x * gridDim.y * gridDim.z;
    unsigned sum, cnt, mine, sp = 0u;
    for (;;) {
        sum = 0u; cnt = 0u; mine = 0u;
#pragma unroll
        for (unsigned j = 0; j < 16; ++j) { const unsigned c = xb_ld(&bar[XB_XCNT(j)]); sum += c; cnt += (c > 0u) ? 1u : 0u; mine = (j == x) ? c : mine; }
        if (sum == G) break;
        __builtin_amdgcn_s_sleep(1);
        if ((++sp & 255u) == 0u) { if (xb_ld(&bar[XB_TMO])) break; if (sp > XB_SPIN_CAP) { atomicAdd(&bar[XB_TMO], 1u); break; } }
    }
    nloc = mine > 0u ? mine : 1u; nx = cnt > 0u ? cnt : 1u;
}
__device__ __forceinline__ void xcd_barrier(const XcdBarrier& b) {
    asm volatile("s_waitcnt vmcnt(0)" ::: "memory");
    __syncthreads();
    if (threadIdx.x == 0) {
        unsigned* bar = b.bar;
        __builtin_amdgcn_s_waitcnt(0);
        unsigned nloc = b.st[0], nx = b.st[1];
        if (nloc == 0u) { xcd_barrier_complete(bar, b.x, nloc, nx); b.st[0] = nloc; b.st[1] = nx; }
        const unsigned old = xb_add(&bar[XB_XSUB(b.x)], 1u);
        const unsigned gen = old / nloc;
        if (old + 1u == (gen + 1u) * nloc) {
            __builtin_amdgcn_fence(__ATOMIC_RELEASE, "agent");
            asm volatile("s_waitcnt vmcnt(0)" ::: "memory");
            const unsigned og = xb_add(&bar[XB_TOP], 1u);
            const unsigned tg = og / nx;
            if (og + 1u == (tg + 1u) * nx) xb_add(&bar[XB_TOPGEN], 1u);
            else XB_SPIN(xb_ld(&bar[XB_TOPGEN]) == tg, bar);
            __builtin_amdgcn_fence(__ATOMIC_ACQUIRE, "agent");
            xb_add(&bar[XB_XGEN(b.x)], 1u);
            asm volatile("s_waitcnt vmcnt(0)" ::: "memory");
        } else {
            XB_SPIN(xb_ld(&bar[XB_XGEN(b.x)]) == gen, bar);
            __builtin_amdgcn_fence(__ATOMIC_ACQUIRE, "agent");
            asm volatile("s_waitcnt vmcnt(0)" ::: "memory");
        }
    }
    __syncthreads();
}

struct Args { const void* in[23]; float* out; unsigned char* ws; int ph_lo, ph_hi, bar_region, pad; };

struct Frame {
    LAS unsigned char* lds; int tid, lane, wave, G, gw, NGW;
    unsigned char* ws;
};

__device__ __forceinline__ int colmap(int which, int n) {
    if (which == 0) {
        if (n < 384) return n; if (n < 512) return -1; if (n < 768) return 384 + (n - 512); if (n < 800) return 640 + (n - 768); if (n < 1024) return -1; return 672 + (n - 1024);
    } else if (which == 1) {
        const int h = n / 96, p = n % 96; if (p < 64) return h * 96 + p; const int j = p - 64, i = j >> 1; return h * 96 + 64 + ((j & 1) ? 16 + i : i);
    } else if (which == 2) {
        if (n < 512) return (n >> 6) * 128 + (n & 63); const int q = n - 512; return (q >> 6) * 128 + 64 + (q & 63);
    }
    return n;
}
__device__ __forceinline__ void p0_transpose_item(const float* W, int ldw, const float* gk, int which, bf16_t* WT, int K, int Nd, LAS float* scr, int item, int lane) {
    const int nblk = Nd / 32, kb = item / nblk, nb = item % nblk, k0 = 64 * kb, n0 = 32 * nb;
    const int sc = colmap(which, n0 + (lane & 31));
#pragma unroll 8
    for (int i = 0; i < 32; ++i) { const int kk = 2 * i + (lane >> 5); float v = 0.f; if (sc >= 0) { v = W[(size_t)(k0 + kk) * ldw + sc]; if (gk) v *= gk[k0 + kk]; } scr[kk * 33 + (lane & 31)] = v; }
    LDS_WAIT(); asm volatile("" ::: "memory");
    const int c = lane & 7;
#pragma unroll
    for (int j = 0; j < 4; ++j) { const int n = (lane >> 3) + 8 * j; const LAS float* s = scr + (8 * c) * 33 + n;
        v4u o; o.x = pk2(s[0 * 33], s[1 * 33]); o.y = pk2(s[2 * 33], s[3 * 33]); o.z = pk2(s[4 * 33], s[5 * 33]); o.w = pk2(s[6 * 33], s[7 * 33]);
        *(GAS v4u*)(WT + (size_t)(n0 + n) * K + k0 + 8 * c) = o; }
    LDS_WAIT(); asm volatile("" ::: "memory");
}
__device__ __forceinline__ float wsum(float v) {
#pragma unroll
    for (int o = 1; o < 64; o <<= 1) v += __shfl_xor(v, o);
    return v;
}
__device__ __forceinline__ void rms_row_to_bf16(const float* xrow, const float* g, bf16_t* orow, int lane) {
    const GAS f32x4* xr = (const GAS f32x4*)xrow + lane; const GAS f32x4* gr = (const GAS f32x4*)g + lane;
    f32x4 v[4]; float s = 0.f;
#pragma unroll
    for (int j = 0; j < 4; ++j) { v[j] = xr[64 * j]; s += (v[j].x * v[j].x + v[j].y * v[j].y) + (v[j].z * v[j].z + v[j].w * v[j].w); }
    const float rstd = rsqrtf(wsum(s) * (1.f / 1024.f) + EPS_);
    GAS unsigned long long* o8 = (GAS unsigned long long*)orow + lane;
#pragma unroll
    for (int j = 0; j < 4; ++j) { const f32x4 gg = gr[64 * j]; o8[64 * j] = (unsigned long long)pk2(v[j].x * rstd * gg.x, v[j].y * rstd * gg.y) | ((unsigned long long)pk2(v[j].z * rstd * gg.z, v[j].w * rstd * gg.w) << 32); }
}

__device__ __forceinline__ void p0_prologue(Frame& F, const Args& a) {
    LAS float* scr = (LAS float*)(F.lds + RING_OFF + F.wave * 16384);
    unsigned char* ws = F.ws;
#pragma unroll 1
    for (int pass = 0; pass < 2; ++pass) {
    if (((F.wave & 1) == 0) == (pass == 0)) {
    constexpr int I_IN = 16 * 80, I_UQ = 6 * 24, I_UKV = 4 * 32, I_SQ = 16 * 32, I_XKV = 16 * 64;
    constexpr int NITEMS = I_IN + I_UQ + I_UKV + 4 * I_SQ + I_XKV;
    for (int it = F.gw; it < NITEMS; it += F.NGW) {
        int r = it;
        if (r < I_IN) { p0_transpose_item((const float*)a.in[4], 2208, nullptr, 0, (bf16_t*)(ws + WO_WIN), 1024, 2560, scr, r, F.lane); continue; } r -= I_IN;
        if (r < I_UQ) { p0_transpose_item((const float*)a.in[6], 768, (const float*)a.in[5], 1, (bf16_t*)(ws + WO_WUQ), 384, 768, scr, r, F.lane); continue; } r -= I_UQ;
        if (r < I_UKV) { p0_transpose_item((const float*)a.in[8], 1024, (const float*)a.in[7], 2, (bf16_t*)(ws + WO_WUKV), 256, 1024, scr, r, F.lane); continue; } r -= I_UKV;
        if (r < I_SQ) { p0_transpose_item((const float*)a.in[11], 1024, (const float*)a.in[10], 3, (bf16_t*)(ws + WO_WO), 1024, 1024, scr, r, F.lane); continue; } r -= I_SQ;
        if (r < I_SQ) { p0_transpose_item((const float*)a.in[14], 1024, (const float*)a.in[12], 3, (bf16_t*)(ws + WO_WXQ), 1024, 1024, scr, r, F.lane); continue; } r -= I_SQ;
        if (r < I_XKV) { p0_transpose_item((const float*)a.in[15], 2048, nullptr, 3, (bf16_t*)(ws + WO_WXKV), 1024, 2048, scr, r, F.lane); continue; } r -= I_XKV;
        if (r < I_SQ) { p0_transpose_item((const float*)a.in[16], 1024, nullptr, 3, (bf16_t*)(ws + WO_WXO), 1024, 1024, scr, r, F.lane); continue; } r -= I_SQ;
        p0_transpose_item((const float*)a.in[18], 1024, (const float*)a.in[17], 3, (bf16_t*)(ws + WO_WPQ), 1024, 1024, scr, r, F.lane);
    }
    const int mpw = (T_ + TM_ + F.NGW - 1) / F.NGW;
    for (int m = F.gw * mpw; m < (F.gw + 1) * mpw && m < T_ + TM_; ++m) {
        if (m < T_) rms_row_to_bf16((const float*)a.in[0] + (size_t)m * 1024, (const float*)a.in[3], (bf16_t*)(ws + WS_RA) + (size_t)m * 1024, F.lane);
        else rms_row_to_bf16((const float*)a.in[1] + (size_t)(m - T_) * 1024, (const float*)a.in[13], (bf16_t*)(ws + WS_MEMN) + (size_t)(m - T_) * 1024, F.lane);
    }
    } else {
    { const float* U = (const float*)a.in[20]; const float* V = (const float*)a.in[21]; const float* gf = (const float*)a.in[17];
      unsigned char* UT8 = ws + WS_UT; unsigned char* VT8 = ws + WS_VT; float* SU = (float*)(ws + WS_SCL); float* SV = SU + 16384;
      f32x4 g4[4];
#pragma unroll
      for (int q = 0; q < 4; ++q) g4[q] = *(const f32x4*)(gf + q * 256 + F.lane * 4);
      const int rpw = (2 * 16384 + F.NGW - 1) / F.NGW;
      for (int r = F.gw * rpw; r < (F.gw + 1) * rpw && r < 2 * 16384; ++r) {
          const bool isu = r < 16384; const int e = isu ? r : r - 16384;
          const float* src = (isu ? U : V) + (size_t)e * 1024 + F.lane * 4;
          f32x4 v[4]; float am = 0.f;
#pragma unroll
          for (int q = 0; q < 4; ++q) { v[q] = *(const f32x4*)(src + q * 256); if (isu) v[q] = v[q] * g4[q];
              am = fmaxf(am, fmaxf(fmaxf(fabsf(v[q].x), fabsf(v[q].y)), fmaxf(fabsf(v[q].z), fabsf(v[q].w)))); }
#pragma unroll
          for (int o = 1; o < 64; o <<= 1) am = fmaxf(am, __shfl_xor(am, o));
          const float sc = am > 0.f ? am * (1.f / 6.f) : 1.f, inv = 1.f / sc;
          unsigned short* dst = (unsigned short*)((isu ? UT8 : VT8) + (size_t)e * 512) + F.lane;
#pragma unroll
          for (int q = 0; q < 4; ++q) { unsigned w_ = 0; w_ = __builtin_amdgcn_cvt_scalef32_pk_fp4_f32(w_, v[q].x * inv, v[q].y * inv, 1.0f, 0); w_ = __builtin_amdgcn_cvt_scalef32_pk_fp4_f32(w_, v[q].z * inv, v[q].w * inv, 1.0f, 1);
              dst[q * 64] = (unsigned short)(w_ & 0xffffu); }
          if (F.lane == 0) (isu ? SU : SV)[e] = sc;
      } }
    }
    }
    { const float* SKf = (const float*)a.in[19]; bf16_t* SKb = (bf16_t*)(ws + WO_SK);
      for (int i = F.gw * 64 + F.lane; i < 16 * 128 * 64 / 2; i += F.NGW * 64) ((unsigned*)SKb)[i] = pk2(SKf[2 * i], SKf[2 * i + 1]); }
    { const int* pos = (const int*)a.in[2]; float* COS = (float*)(ws + WS_COS); float* SIN = (float*)(ws + WS_SIN);
      for (int i = F.gw * 64 + F.lane; i < T_ * 16; i += F.NGW * 64) { const int t = i >> 4, f = i & 15; const float inv = powf(10000.f, -(float)(2 * f) / 32.f); const float ang = (float)pos[t] * inv; COS[i] = cosf(ang); SIN[i] = sinf(ang); } }
}

__device__ __forceinline__ void p2_conv_job(Frame& F, const Args& a) {
    const bf16_t* PROJ = (const bf16_t*)(F.ws + WS_RB); bf16_t* Y = (bf16_t*)(F.ws + WS_RA); bf16_t* Kb = (bf16_t*)a.out + (size_t)T_ * 768;
    const float* cw = (const float*)a.in[9]; const float* COS = (const float*)(F.ws + WS_COS); const float* SIN = (const float*)(F.ws + WS_SIN);
    int lane = __builtin_amdgcn_mbcnt_hi(~0u, __builtin_amdgcn_mbcnt_lo(~0u, 0u)); asm volatile("" : "+v"(lane));
    const int ch0 = lane * 8;
    f32x4 w0[3], w1[3];
#pragma unroll
    for (int k = 0; k < 3; ++k) { w0[k] = *(const f32x4*)(cw + k * 512 + ch0); w1[k] = *(const f32x4*)(cw + k * 512 + ch0 + 4); }
    for (int t = F.gw; t < T_; t += F.NGW) {
        const int s = t & (S_ - 1);
        const bf16_t* p = PROJ + (size_t)t * PJ;
        const v4u gb = *(const v4u*)(p + 1024 + ch0);
        f32x4 z0 = (f32x4){0.f, 0.f, 0.f, 0.f}, z1 = z0;
#pragma unroll
        for (int k = 0; k < 3; ++k) { const int dt = 2 - k;
            if (s - dt >= 0) { const bf16_t* q = p - (size_t)dt * PJ; const v4u gc = *(const v4u*)(q + 1536 + ch0), hx = *(const v4u*)(q + 2048 + ch0);
                z0 += w0[k] * (f32x4){pg8::bflo(gc.x) * pg8::bflo(hx.x), pg8::bfhi(gc.x) * pg8::bfhi(hx.x), pg8::bflo(gc.y) * pg8::bflo(hx.y), pg8::bfhi(gc.y) * pg8::bfhi(hx.y)};
                z1 += w1[k] * (f32x4){pg8::bflo(gc.z) * pg8::bflo(hx.z), pg8::bfhi(gc.z) * pg8::bfhi(hx.z), pg8::bflo(gc.w) * pg8::bflo(hx.w), pg8::bfhi(gc.w) * pg8::bfhi(hx.w)}; } }
        const f32x4 y0 = z0 * (f32x4){pg8::bflo(gb.x), pg8::bfhi(gb.x), pg8::bflo(gb.y), pg8::bfhi(gb.y)}, y1 = z1 * (f32x4){pg8::bflo(gb.z), pg8::bfhi(gb.z), pg8::bflo(gb.w), pg8::bfhi(gb.w)};
        float ss = (y0[0] * y0[0] + y0[1] * y0[1]) + (y0[2] * y0[2] + y0[3] * y0[3]) + (y1[0] * y1[0] + y1[1] * y1[1]) + (y1[2] * y1[2] + y1[3] * y1[3]);
        ss += __shfl_xor(ss, 1); ss += __shfl_xor(ss, 2); ss += __shfl_xor(ss, 4);
        const float r = rsqrtf(ss * (1.f / 64.f) + EPS_);
        v4u o; o.x = pk2(y0[0] * r, y0[1] * r); o.y = pk2(y0[2] * r, y0[3] * r); o.z = pk2(y1[0] * r, y1[1] * r); o.w = pk2(y1[2] * r, y1[3] * r);
        *(v4u*)(Y + (size_t)t * 1024 + 512 + ch0) = o;
        if (lane < 16) { const float c = COS[t * 16 + lane], sn = SIN[t * 16 + lane]; const float t1 = bf2f(p[768 + lane]), t2 = bf2f(p[768 + 16 + lane]);
            const unsigned w = pk2(t1 * c - t2 * sn, t2 * c + t1 * sn);
#pragma unroll
            for (int h = 0; h < 8; ++h) *(unsigned*)(Kb + (size_t)t * 768 + h * 96 + 64 + 2 * lane) = w; }
    }
}

typedef __bf16 bf16x2_t __attribute__((ext_vector_type(2)));
typedef float f32x2 __attribute__((ext_vector_type(2)));
__device__ __forceinline__ float dot2bf(unsigned a, unsigned b, float c) { return __builtin_amdgcn_fdot2_f32_bf16(__builtin_bit_cast(bf16x2_t, a), __builtin_bit_cast(bf16x2_t, b), c, false); }
template <int CTRL> __device__ __forceinline__ float dppf(float x) { return __builtin_bit_cast(float, __builtin_amdgcn_mov_dpp(__builtin_bit_cast(int, x), CTRL, 0xf, 0xf, true)); }
__device__ __forceinline__ float gelu_fast(float x) {
    const float u = 0.7978845608028654f * (x + 0.044715f * x * x * x);
    return x / (1.f + __expf(-2.f * u));
}
__device__ __forceinline__ float reduce32(float (&p)[32], int lane) {
#pragma unroll
    for (int j = 0; j < 16; ++j) { auto r = __builtin_amdgcn_permlane32_swap(__float_as_uint(p[j]), __float_as_uint(p[j + 16]), false, false); p[j] = __uint_as_float(r[0]) + __uint_as_float(r[1]); }
#pragma unroll
    for (int j = 0; j < 8; ++j) { auto r = __builtin_amdgcn_permlane16_swap(__float_as_uint(p[j]), __float_as_uint(p[j + 8]), false, false); p[j] = __uint_as_float(r[0]) + __uint_as_float(r[1]); }
    const bool b3 = (lane & 8) != 0, b2 = (lane & 4) != 0, b1 = (lane & 2) != 0;
#pragma unroll
    for (int j = 0; j < 4; ++j) { const float keep = b3 ? p[j + 4] : p[j], send = b3 ? p[j] : p[j + 4]; p[j] = keep + dppf<0x128>(send); }
#pragma unroll
    for (int j = 0; j < 2; ++j) { const float keep = b2 ? p[j + 2] : p[j], send = b2 ? p[j] : p[j + 2]; p[j] = keep + dppf<0x141>(send); }
    { const float keep = b1 ? p[1] : p[0], send = b1 ? p[0] : p[1]; p[0] = keep + dppf<0x4E>(send); }
    return p[0] + dppf<0xB1>(p[0]);
}
__device__ __forceinline__ f32x2 fp8lo(unsigned w) { return __builtin_amdgcn_cvt_pk_f32_fp8((int)w, false); }
__device__ __forceinline__ f32x2 fp8hi(unsigned w) { return __builtin_amdgcn_cvt_pk_f32_fp8((int)w, true); }
__device__ __forceinline__ float dot16(const v4u w, const f32x2 (&x)[8]) {
    f32x2 s = fp8lo(w.x) * x[0]; s += fp8hi(w.x) * x[1]; s += fp8lo(w.y) * x[2]; s += fp8hi(w.y) * x[3];
    s += fp8lo(w.z) * x[4]; s += fp8hi(w.z) * x[5]; s += fp8lo(w.w) * x[6]; s += fp8hi(w.w) * x[7];
    return s.x + s.y;
}
__device__ __forceinline__ void axpy16(f32x2 (&acc)[8], float as, const v4u w) {
    const f32x2 a2 = (f32x2){as, as};
    acc[0] += a2 * fp8lo(w.x); acc[1] += a2 * fp8hi(w.x); acc[2] += a2 * fp8lo(w.y); acc[3] += a2 * fp8hi(w.y);
    acc[4] += a2 * fp8lo(w.z); acc[5] += a2 * fp8hi(w.z); acc[6] += a2 * fp8lo(w.w); acc[7] += a2 * fp8hi(w.w);
}
constexpr size_t WS_RSTD2 = 105 * MiB + 512 * 1024;
constexpr size_t WS_ACT = 40 * MiB;
template <int CTRL> __device__ __forceinline__ int dppi(int x) { return __builtin_amdgcn_mov_dpp(x, CTRL, 0xf, 0xf, true); }
__device__ __forceinline__ int reduce32i(int (&p)[32], int lane) {
#pragma unroll
    for (int j = 0; j < 16; ++j) { auto r = __builtin_amdgcn_permlane32_swap((unsigned)p[j], (unsigned)p[j + 16], false, false); p[j] = (int)(r[0] + r[1]); }
#pragma unroll
    for (int j = 0; j < 8; ++j) { auto r = __builtin_amdgcn_permlane16_swap((unsigned)p[j], (unsigned)p[j + 8], false, false); p[j] = (int)(r[0] + r[1]); }
    const bool b3 = (lane & 8) != 0, b2 = (lane & 4) != 0, b1 = (lane & 2) != 0;
#pragma unroll
    for (int j = 0; j < 4; ++j) { const int keep = b3 ? p[j + 4] : p[j], send = b3 ? p[j] : p[j + 4]; p[j] = keep + dppi<0x128>(send); }
#pragma unroll
    for (int j = 0; j < 2; ++j) { const int keep = b2 ? p[j + 2] : p[j], send = b2 ? p[j] : p[j + 2]; p[j] = keep + dppi<0x141>(send); }
    { const int keep = b1 ? p[1] : p[0], send = b1 ? p[0] : p[1]; p[0] = keep + dppi<0x4E>(send); }
    return p[0] + dppi<0xB1>(p[0]);
}
__device__ __forceinline__ int dot16i(const v4u w, const v4u x) {
    return __builtin_amdgcn_sdot4((int)w.w, (int)x.w, __builtin_amdgcn_sdot4((int)w.z, (int)x.z, __builtin_amdgcn_sdot4((int)w.y, (int)x.y, __builtin_amdgcn_sdot4((int)w.x, (int)x.x, 0, false), false), false), false);
}
__device__ __forceinline__ float reduce16h(float (&p)[16], int lane) {
#pragma unroll
    for (int j = 0; j < 8; ++j) { auto r = __builtin_amdgcn_permlane16_swap(__float_as_uint(p[j]), __float_as_uint(p[j + 8]), false, false); p[j] = __uint_as_float(r[0]) + __uint_as_float(r[1]); }
    const bool b3 = (lane & 8) != 0, b2 = (lane & 4) != 0, b1 = (lane & 2) != 0;
#pragma unroll
    for (int j = 0; j < 4; ++j) { const float keep = b3 ? p[j + 4] : p[j], send = b3 ? p[j] : p[j + 4]; p[j] = keep + dppf<0x128>(send); }
#pragma unroll
    for (int j = 0; j < 2; ++j) { const float keep = b2 ? p[j + 2] : p[j], send = b2 ? p[j] : p[j + 2]; p[j] = keep + dppf<0x141>(send); }
    { const float keep = b1 ? p[1] : p[0], send = b1 ? p[0] : p[1]; p[0] = keep + dppf<0x4E>(send); }
    return p[0] + dppf<0xB1>(p[0]);
}
typedef int v8i_t __attribute__((ext_vector_type(8)));
typedef float v4f_t __attribute__((ext_vector_type(4)));
__device__ __forceinline__ void p_peer_u(Frame& F, const Args& a) {
    const bf16_t* H2 = (const bf16_t*)(F.ws + WS_RA); const float* parts = (const float*)(F.ws + PSS6_OFF);
    const unsigned char* UT4 = F.ws + WS_UT; const float* SU = (const float*)(F.ws + WS_SCL); const float* SV = SU + 16384;
    float* ACT = (float*)(F.ws + WS_ACT); int* RI = (int*)(F.ws + WS_RIDX); const float* RG = (const float*)(F.ws + WS_RGATE);
    int lane = __builtin_amdgcn_mbcnt_hi(~0u, __builtin_amdgcn_mbcnt_lo(~0u, 0u)); asm volatile("" : "+v"(lane));
    LAS unsigned char* wb = F.lds + RING_OFF + F.wave * 17408;
    LAS int* fpl = (LAS int*)wb; LAS unsigned char* xw = wb + 512; LAS int* li = (LAS int*)(wb + 512 + 8192); LAS float* lg = (LAS float*)(wb + 512 + 8192 + 4096); LAS float* ls = (LAS float*)(wb + 512 + 8192 + 8192);
    const int xoff = 32 * ((lane & 7) + 8 * (lane >> 5)) + 16 * ((lane >> 4) & 1);
    const int coff = ((lane & 7) + 8 * (lane >> 4)) * 16; const int bsel = (lane & 8) ? 128 : 0;
    const int slot = 2 * ((lane >> 1) & 15) + (lane >> 5), sub = slot & 15; const bool second = slot >= 16;
    const bool dvalid = ((lane & 15) >> 2) == (lane >> 4), dr1 = (lane & 1) != 0, dr2 = (lane & 2) != 0;
#pragma unroll 1
    for (int base = F.gw; base < T_; base += 8 * F.NGW) {
      int i0a[8], i1a[8]; float g0a[8], g1a[8], spa[8]; v4u ha[8][2];
#pragma unroll
      for (int k = 0; k < 8; ++k) { const int t_ = base + k * F.NGW, tc = t_ < T_ ? t_ : base;
          i0a[k] = RI[(size_t)tc * 128 + lane]; i1a[k] = RI[(size_t)tc * 128 + 64 + lane]; g0a[k] = RG[(size_t)tc * 128 + lane]; g1a[k] = RG[(size_t)tc * 128 + 64 + lane];
          spa[k] = (lane < 16) ? parts[(size_t)lane * T_ + tc] : 0.f;
          ha[k][0] = *(const v4u*)(H2 + (size_t)tc * 1024 + lane * 16); ha[k][1] = *(const v4u*)(H2 + (size_t)tc * 1024 + lane * 16 + 8); }
#define PU_PRE(k) do { const int t = base + (k) * F.NGW; const bool tv = t < T_; \
          const int i0 = tv ? i0a[k] : 0, i1 = tv ? i1a[k] : 0; const float g0 = tv ? g0a[k] : 0.f, g1 = tv ? g1a[k] : 0.f; \
          int pos0 = -1, pos1 = -1, ov0 = 0, ov1 = 0, ovf = 0, fre = 0; \
          _Pragma("unroll") for (int q = 0; q < 8; ++q) { \
              const bool m0 = (i0 >> 11) == q, m1 = (i1 >> 11) == q; \
              const unsigned long long b0 = __ballot(m0), b1 = __ballot(m1); \
              const int c0 = __popcll(b0), c1 = __popcll(b1), nq = c0 + c1; \
              const int r0 = (int)__builtin_amdgcn_mbcnt_hi((unsigned)(b0 >> 32), __builtin_amdgcn_mbcnt_lo((unsigned)b0, 0u)); \
              const int r1 = c0 + (int)__builtin_amdgcn_mbcnt_hi((unsigned)(b1 >> 32), __builtin_amdgcn_mbcnt_lo((unsigned)b1, 0u)); \
              if (m0) { if (r0 < 16) pos0 = 16 * q + r0; else ov0 = ovf + (r0 - 16); } \
              if (m1) { if (r1 < 16) pos1 = 16 * q + r1; else ov1 = ovf + (r1 - 16); } \
              const int fq = nq < 16 ? 16 - nq : 0; \
              if (lane < fq) fpl[fre + lane] = 16 * q + nq + lane; \
              ovf += nq > 16 ? nq - 16 : 0; fre += fq; } \
          const float sp = wsum(spa[k]); \
          const v4u h = ha[k][0], g = ha[k][1]; \
          float am = fmaxf(fmaxf(fmaxf(fabsf(pg8::bflo(h.x)), fabsf(pg8::bfhi(h.x))), fmaxf(fabsf(pg8::bflo(h.y)), fabsf(pg8::bfhi(h.y)))), fmaxf(fmaxf(fabsf(pg8::bflo(h.z)), fabsf(pg8::bfhi(h.z))), fmaxf(fabsf(pg8::bflo(h.w)), fabsf(pg8::bfhi(h.w))))); \
          am = fmaxf(am, fmaxf(fmaxf(fmaxf(fabsf(pg8::bflo(g.x)), fabsf(pg8::bfhi(g.x))), fmaxf(fabsf(pg8::bflo(g.y)), fabsf(pg8::bfhi(g.y)))), fmaxf(fmaxf(fabsf(pg8::bflo(g.z)), fabsf(pg8::bfhi(g.z))), fmaxf(fabsf(pg8::bflo(g.w)), fabsf(pg8::bfhi(g.w)))))); \
          am = wave_max(am); \
          const float qs = am > 0.f ? 440.f / am : 0.f; v4u xq; \
          { int w = 0; w = __builtin_amdgcn_cvt_pk_fp8_f32(pg8::bflo(h.x) * qs, pg8::bfhi(h.x) * qs, w, false); w = __builtin_amdgcn_cvt_pk_fp8_f32(pg8::bflo(h.y) * qs, pg8::bfhi(h.y) * qs, w, true); xq.x = (unsigned)w; } \
          { int w = 0; w = __builtin_amdgcn_cvt_pk_fp8_f32(pg8::bflo(h.z) * qs, pg8::bfhi(h.z) * qs, w, false); w = __builtin_amdgcn_cvt_pk_fp8_f32(pg8::bflo(h.w) * qs, pg8::bfhi(h.w) * qs, w, true); xq.y = (unsigned)w; } \
          { int w = 0; w = __builtin_amdgcn_cvt_pk_fp8_f32(pg8::bflo(g.x) * qs, pg8::bfhi(g.x) * qs, w, false); w = __builtin_amdgcn_cvt_pk_fp8_f32(pg8::bflo(g.y) * qs, pg8::bfhi(g.y) * qs, w, true); xq.z = (unsigned)w; } \
          { int w = 0; w = __builtin_amdgcn_cvt_pk_fp8_f32(pg8::bflo(g.z) * qs, pg8::bfhi(g.z) * qs, w, false); w = __builtin_amdgcn_cvt_pk_fp8_f32(pg8::bflo(g.w) * qs, pg8::bfhi(g.w) * qs, w, true); xq.w = (unsigned)w; } \
          *(LAS v4u*)(xw + (k) * 1024 + lane * 16) = xq; \
          asm volatile("s_waitcnt lgkmcnt(0)" ::: "memory"); \
          if (pos0 < 0) pos0 = fpl[ov0]; \
          if (pos1 < 0) pos1 = fpl[ov1]; \
          asm volatile("s_waitcnt lgkmcnt(0)" ::: "memory"); \
          li[(k) * 128 + pos0] = i0; li[(k) * 128 + pos1] = i1; lg[(k) * 128 + pos0] = g0; lg[(k) * 128 + pos1] = g1; \
          if (tv) { RI[(size_t)t * 128 + pos0] = i0; RI[(size_t)t * 128 + pos1] = i1; } \
          if (lane == 0) ls[k] = rsqrtf(sp * (1.f / 1024.f) + EPS_) * (am * (1.f / 440.f)); } while (0)
#define PU_B(d, kk) do { const v4u q0_ = *(const LAS v4u*)(xw + (kk) * 1024 + xoff), q1_ = *(const LAS v4u*)(xw + (kk) * 1024 + xoff + 512); \
        d = (v8i_t){(int)q0_.x, (int)q0_.y, (int)q0_.z, (int)q0_.w, (int)q1_.x, (int)q1_.y, (int)q1_.z, (int)q1_.w}; } while (0)
#define PU_DIAG(D) ({ const float t01_ = dr1 ? (D).y : (D).x, t23_ = dr1 ? (D).w : (D).z; const float t_ = dr2 ? t23_ : t01_; dvalid ? t_ : 0.f; })
#define PU_MMA(m, B) do { const v8i_t a_ = (v8i_t){(int)bufs[m].x, (int)bufs[m].y, (int)bufs[m].z, (int)bufs[m].w, 0, 0, 0, 0}; const v4f_t z_ = (v4f_t){0.f, 0.f, 0.f, 0.f}; \
        const v4f_t d_ = __builtin_amdgcn_mfma_scale_f32_16x16x128_f8f6f4(a_, B, z_, 4, 0, 0, 0, 0, 0); p[m] = PU_DIAG(d_); } while (0)
#define PU_BA(pp, j) \
        const int kk_ = 2 * (j) + (second ? 1 : 0); const int tt = base + kk_ * F.NGW; \
        const int idxv = li[kk_ * 128 + (pp) * 16 + sub]; const float gatev = lg[kk_ * 128 + (pp) * 16 + sub]; const float rstd = ls[kk_]; \
        v4u bufs[16]; \
        _Pragma("unroll") for (int m = 0; m < 16; ++m) { const int e_ = __builtin_amdgcn_ds_bpermute(8 * m + bsel, idxv); bufs[m] = *(const v4u*)(UT4 + (size_t)e_ * 512 + coff); } \
        const float su = SU[idxv], sv = SV[idxv];
#define PU_BB(pp, j) do { \
        v8i_t BA, BB; PU_B(BA, 2 * (j)); PU_B(BB, 2 * (j) + 1); \
        float p[16]; \
        _Pragma("unroll") for (int m = 0; m < 8; ++m) PU_MMA(m, BA); \
        _Pragma("unroll") for (int m = 8; m < 16; ++m) PU_MMA(m, BB); \
        const float dt = reduce16h(p, lane); \
        if ((lane & 1) == 0 && tt < T_) ACT[(size_t)tt * 128 + (pp) * 16 + sub] = gelu_fast(dt * su * rstd) * gatev * sv; } while (0)
      PU_PRE(0); PU_PRE(1);
      { PU_BA(0, 0); PU_PRE(2); PU_PRE(3); PU_BB(0, 0); }
      { PU_BA(0, 1); PU_PRE(4); PU_PRE(5); PU_BB(0, 1); }
      { PU_BA(0, 2); PU_PRE(6); PU_PRE(7); PU_BB(0, 2); }
      { PU_BA(0, 3); PU_BB(0, 3); }
#pragma unroll 1
      for (int n = 4; n < 32; ++n) { const int pp = n >> 2, j = n & 3; PU_BA(pp, j); PU_BB(pp, j); }
#undef PU_PRE
#undef PU_B
#undef PU_DIAG
#undef PU_MMA
#undef PU_BA
#undef PU_BB
    }
}
typedef int v2i_t __attribute__((ext_vector_type(2)));
typedef unsigned v2u_t __attribute__((ext_vector_type(2)));
__device__ __forceinline__ void p_peer_v(Frame& F, const Args& a) {
    const bf16_t* H2 = (const bf16_t*)(F.ws + WS_RA); const unsigned char* VT4 = F.ws + WS_VT;
    const int* SE = (const int*)(F.ws + WS_RIDX); const float* ACT = (const float*)(F.ws + WS_ACT);
    const float* gfin = (const float*)a.in[22]; float* out = a.out;
    int lane = __builtin_amdgcn_mbcnt_hi(~0u, __builtin_amdgcn_mbcnt_lo(~0u, 0u)); asm volatile("" : "+v"(lane));
    const int lo = lane & 31; const bool up = lane >= 32; const int w = F.wave, wq = w & 3, g = lane >> 4;
    constexpr int PITCH = 520, SB = 128 * PITCH, A8_OFF = 2 * SB, SA_OFF = A8_OFF + 8192, TPITCH = 1040;
    static_assert(SA_OFF + 256 <= LDS_BYTES, "V phase LDS");
    LAS unsigned char* lds = F.lds;
    const int sub = lane & 15; const bool second = (lane & 16) != 0;
    LAS unsigned char* wptr = lds + (32 * (2 * (w >> 2) + (w & 1)) + 16 * ((w >> 1) & 1) + (up ? 8 : 0)) * PITCH + lo * 16;
    LAS unsigned char* rptr = lds + (64 * (g >> 1) + 16 * (g & 1) + (lane & 15)) * PITCH + 64 * w;
    const bool va0 = (lane & 15) == g, va1 = (lane & 15) == 4 + g, vb0 = (lane & 15) == 8 + g, vb1 = (lane & 15) == 12 + g;
#pragma unroll 1
    for (int k0 = 0; F.gw + k0 * F.NGW < T_; k0 += 8) {
        __syncthreads();
#pragma unroll 1
        for (int k = 0; k < 8; ++k) { const int t = F.gw + (k0 + k) * F.NGW; const bool tv = t < T_; const int tc = tv ? t : F.gw;
            int lane = __builtin_amdgcn_mbcnt_hi(~0u, __builtin_amdgcn_mbcnt_lo(~0u, 0u)); asm volatile("" : "+v"(lane));
            const float a0 = tv ? ACT[(size_t)tc * 128 + lane] : 0.f, a1 = tv ? ACT[(size_t)tc * 128 + 64 + lane] : 0.f;
            const float am = wave_max(fmaxf(fabsf(a0), fabsf(a1))); const float qs = am > 0.f ? 240.f / am : 0.f;
            const int pk = __builtin_amdgcn_cvt_pk_fp8_f32(a0 * qs, a1 * qs, 0, false);
            LAS unsigned char* d8 = lds + A8_OFF + (w * 8 + k) * 128;
            d8[lane] = (unsigned char)(pk & 0xff); d8[64 + lane] = (unsigned char)((pk >> 8) & 0xff);
            if (lane == 0) ((LAS float*)(lds + SA_OFF))[w * 8 + k] = am * (1.f / 240.f); }
#define PV_IDX(r_) ({ int il_ = __builtin_amdgcn_mbcnt_hi(~0u, __builtin_amdgcn_mbcnt_lo(~0u, 0u)); asm volatile("" : "+v"(il_)); \
        const int rr_ = (r_) < 32 ? (r_) : 31; const int t_ = F.gw + (k0 + 2 * (sg0 + ((rr_ >> 1) & 1)) + (rr_ & 1)) * F.NGW; const int tc_ = t_ < T_ ? t_ : F.gw; SE[(size_t)tc_ * 128 + (rr_ >> 2) * 16 + (il_ & 15)]; })
#define PV_ROWS(BUF, IDX) do { _Pragma("unroll") for (int i = 0; i < 8; ++i) { const int e_ = __builtin_amdgcn_ds_bpermute(4 * (i + (up ? 8 : 0)), IDX); BUF[i] = *(const v4u*)(VT4 + (size_t)e_ * 512 + lo * 16); } } while (0)
#define PV_ROUND(ACC, BUF, rr_, c_) do { const int r_ = (rr_); if (r_ < 32) { const int p_ = r_ >> 2; constexpr int stg_ = (c_) & 1, hh_ = (c_) & 1; const int sg_ = sg0 + ((c_) >> 1); \
            _Pragma("unroll") for (int i = 0; i < 8; ++i) { *(LAS v2u_t*)(wptr + stg_ * SB + i * PITCH) = (v2u_t){BUF[i].x, BUF[i].y}; *(LAS v2u_t*)(wptr + stg_ * SB + i * PITCH + 8) = (v2u_t){BUF[i].z, BUF[i].w}; } \
            if (r_ + 3 < 32) { const int idc_ = idx1; PV_ROWS(BUF, idc_); } \
            idx1 = idx2; idx2 = PV_IDX(r_ + 5); \
            asm volatile("s_waitcnt lgkmcnt(0)" ::: "memory"); __builtin_amdgcn_s_barrier(); \
            { const v4u q1_ = *(const LAS v4u*)(lds + A8_OFF + (g * 8 + 2 * sg_ + hh_) * 128 + p_ * 16); \
              const v4u q2_ = *(const LAS v4u*)(lds + A8_OFF + ((4 + g) * 8 + 2 * sg_ + hh_) * 128 + p_ * 16); \
              const bool s1_ = hh_ ? vb0 : va0, s2_ = hh_ ? vb1 : va1; \
              const v8i_t A_ = (v8i_t){s1_ ? (int)q1_.x : 0, s1_ ? (int)q1_.y : 0, s1_ ? (int)q1_.z : 0, s1_ ? (int)q1_.w : 0, s2_ ? (int)q2_.x : 0, s2_ ? (int)q2_.y : 0, s2_ ? (int)q2_.z : 0, s2_ ? (int)q2_.w : 0}; \
              _Pragma("unroll") for (int n = 0; n < 8; ++n) { \
                  const v2i_t r0_ = __builtin_amdgcn_ds_read_tr4_b64_v2i32((LAS v2i_t*)(rptr + stg_ * SB + 8 * n)); \
                  const v2i_t r1_ = __builtin_amdgcn_ds_read_tr4_b64_v2i32((LAS v2i_t*)(rptr + stg_ * SB + 8 * n + 32 * PITCH)); \
                  const v8i_t B_ = (v8i_t){r0_.x, r0_.y, r1_.x, r1_.y, 0, 0, 0, 0}; \
                  ACC[n] = __builtin_amdgcn_mfma_scale_f32_16x16x128_f8f6f4(A_, B_, ACC[n], 0, 4, 0, 0, 0, 0); } } } } while (0)
#define PV_FINSET(ACC, sg_) do { \
            int fl_ = __builtin_amdgcn_mbcnt_hi(~0u, __builtin_amdgcn_mbcnt_lo(~0u, 0u)); asm volatile("" : "+v"(fl_)); const int fg_ = fl_ >> 4, fj_ = fl_ & 15;     \
            LAS float* tile_ = (LAS float*)(F.lds + ((sg_) & 1) * SB); const LAS float* sa_ = (const LAS float*)(F.lds + SA_OFF); \
            _Pragma("unroll") for (int r = 0; r < 4; ++r) { const int m_ = 4 * fg_ + r; const float sc_ = sa_[(m_ & 7) * 8 + 2 * (sg_) + (m_ >> 3)]; \
                _Pragma("unroll") for (int n = 0; n < 8; ++n) tile_[m_ * TPITCH + 128 * F.wave + 16 * n + fj_] = ACC[n][r] * sc_; } \
            __syncthreads(); \
            _Pragma("unroll 1") for (int kk = 0; kk < 2; ++kk) { const int t_ = F.gw + (k0 + 2 * (sg_) + kk) * F.NGW; \
                if (t_ < T_) { const LAS f32x4* row_ = (const LAS f32x4*)(tile_ + (8 * kk + F.wave) * TPITCH + fl_ * 16); \
                    const v4u h0 = *(const v4u*)(H2 + (size_t)t_ * 1024 + fl_ * 16), h1 = *(const v4u*)(H2 + (size_t)t_ * 1024 + fl_ * 16 + 8); \
                    f32x4 v0 = row_[0], v1 = row_[1], v2 = row_[2], v3 = row_[3]; \
                    v0 += (f32x4){pg8::bflo(h0.x), pg8::bfhi(h0.x), pg8::bflo(h0.y), pg8::bfhi(h0.y)}; v1 += (f32x4){pg8::bflo(h0.z), pg8::bfhi(h0.z), pg8::bflo(h0.w), pg8::bfhi(h0.w)}; \
                    v2 += (f32x4){pg8::bflo(h1.x), pg8::bfhi(h1.x), pg8::bflo(h1.y), pg8::bfhi(h1.y)}; v3 += (f32x4){pg8::bflo(h1.z), pg8::bfhi(h1.z), pg8::bflo(h1.w), pg8::bfhi(h1.w)}; \
                    float ss = (v0.x * v0.x + v0.y * v0.y) + (v0.z * v0.z + v0.w * v0.w) + (v1.x * v1.x + v1.y * v1.y) + (v1.z * v1.z + v1.w * v1.w) \
                             + (v2.x * v2.x + v2.y * v2.y) + (v2.z * v2.z + v2.w * v2.w) + (v3.x * v3.x + v3.y * v3.y) + (v3.z * v3.z + v3.w * v3.w); \
                    ss = wsum(ss); const float rr = rsqrtf(ss * (1.f / 1024.f) + EPS_); float* o_ = out + (size_t)t_ * 1024 + fl_ * 16; \
                    const f32x4 g0 = *(const f32x4*)(gfin + fl_ * 16), g1 = *(const f32x4*)(gfin + fl_ * 16 + 4), g2 = *(const f32x4*)(gfin + fl_ * 16 + 8), g3 = *(const f32x4*)(gfin + fl_ * 16 + 12); \
                    *(f32x4*)(o_) = v0 * rr * g0; *(f32x4*)(o_ + 4) = v1 * rr * g1; *(f32x4*)(o_ + 8) = v2 * rr * g2; *(f32x4*)(o_ + 12) = v3 * rr * g3; } } } while (0)
#pragma unroll 1
        for (int sg0 = 0; sg0 < 4; sg0 += 2) {
            v4f_t accA[8], accB[8];
#pragma unroll
            for (int n = 0; n < 8; ++n) { accA[n] = (v4f_t){0.f, 0.f, 0.f, 0.f}; accB[n] = accA[n]; }
            v4u bf0[8], bf1[8], bf2[8]; int idx1, idx2;
            { const int i0 = PV_IDX(0), i1 = PV_IDX(1), i2 = PV_IDX(2); idx1 = PV_IDX(3); idx2 = PV_IDX(4);
              PV_ROWS(bf0, i0); PV_ROWS(bf1, i1); PV_ROWS(bf2, i2); }
            __syncthreads();
#pragma unroll 1
            for (int rb = 0; rb < 36; rb += 12) {
                PV_ROUND(accA, bf0, rb + 0, 0); PV_ROUND(accA, bf1, rb + 1, 1); PV_ROUND(accB, bf2, rb + 2, 2); PV_ROUND(accB, bf0, rb + 3, 3);
                PV_ROUND(accA, bf1, rb + 4, 0); PV_ROUND(accA, bf2, rb + 5, 1); PV_ROUND(accB, bf0, rb + 6, 2); PV_ROUND(accB, bf1, rb + 7, 3);
                PV_ROUND(accA, bf2, rb + 8, 0); PV_ROUND(accA, bf0, rb + 9, 1); PV_ROUND(accB, bf1, rb + 10, 2); PV_ROUND(accB, bf2, rb + 11, 3); }
            asm volatile("s_waitcnt lgkmcnt(0)" ::: "memory"); __builtin_amdgcn_s_barrier();
            PV_FINSET(accA, sg0); PV_FINSET(accB, sg0 + 1);
        }
#undef PV_IDX
#undef PV_ROWS
#undef PV_ROUND
#undef PV_FINSET
    }
}

namespace mla {
typedef short bf16x8 __attribute__((ext_vector_type(8)));
typedef short s16x4 __attribute__((ext_vector_type(4)));
typedef float f32x16 __attribute__((ext_vector_type(16)));
typedef unsigned u32x4 __attribute__((ext_vector_type(4)));
constexpr int KSLOT = 12288, VSLOT = 8192;
constexpr int L_K = 0, L_V = 2 * KSLOT, L_WS = L_V + 2 * VSLOT, L_ST = L_WS + 8 * 256, L_END = L_ST + 8 * 8192;
__device__ __forceinline__ int crow(int r, int hi) { return (r & 3) + 8 * (r >> 2) + 4 * hi; }
__device__ __forceinline__ unsigned cvtpk(float lo, float hi) { typedef float f2 __attribute__((ext_vector_type(2))); typedef __bf16 b2 __attribute__((ext_vector_type(2))); f2 v = {lo, hi}; b2 b = __builtin_convertvector(v, b2); return __builtin_bit_cast(unsigned, b); }
__device__ __forceinline__ s16x4 vtr(const LAS unsigned char* p) { typedef short v4i16_t __attribute__((ext_vector_type(4))); return __builtin_bit_cast(s16x4, __builtin_amdgcn_ds_read_tr16_b64_v4i16((LAS v4i16_t*)p)); }

template <int THRL>
__device__ __forceinline__ void unit(int b, int h, int qb, const bf16_t* Q, const bf16_t* K, const bf16_t* V, bf16_t* Y, LAS unsigned char* lds, int wid, int lane) {
    const int r32 = lane & 31, hi = lane >> 5;
    const long rowbase = (long)b * S_; const int q0 = qb * 256;
    const bf16_t* Qw = Q + (size_t)(rowbase + q0 + wid * 32 + r32) * 768 + h * 96 + hi * 8;
    bf16x8 qr[6];
#pragma unroll
    for (int d0 = 0; d0 < 6; ++d0) qr[d0] = *(const bf16x8*)(Qw + d0 * 16);
    const bf16_t* Kh = K + (size_t)rowbase * 768 + h * 96; const bf16_t* Vh = V + (size_t)rowbase * 512 + h * 64;
    const bf16_t* ksrc0 = Kh + (size_t)lane * 768 + wid * 8;
    const bf16_t* vsrc = Vh + (size_t)(16 * (wid & 3) + (lane >> 2)) * 512 + (wid >> 2) * 32 + (lane & 3) * 8;
    const int NT = (q0 + 256) / 64;
#define MLA_DMA(t, slot) do { \
        __builtin_amdgcn_global_load_lds((const unsigned*)(ksrc0 + (size_t)(t) * 64 * 768), (LAS unsigned*)(lds + L_K + (slot) * KSLOT + wid * 1024), 16, 0, 0); \
        if (wid < 4) __builtin_amdgcn_global_load_lds((const unsigned*)(ksrc0 + (size_t)(t) * 64 * 768 + 64), (LAS unsigned*)(lds + L_K + (slot) * KSLOT + (wid + 8) * 1024), 16, 0, 0); \
        __builtin_amdgcn_global_load_lds((const unsigned*)(vsrc + (size_t)(t) * 64 * 512), (LAS unsigned*)(lds + L_V + (slot) * VSLOT + wid * 1024), 16, 0, 0); } while (0)
    LAS float* wsf = (LAS float*)(lds + L_WS) + wid * 64;
    float m = -INFINITY, l_reg = 0.f;
    f32x16 o0 = f32x16{}, o1 = f32x16{};
    const int qrel = wid * 32 + r32;
    MLA_DMA(0, 0);
#pragma unroll 1
    for (int t = 0; t < NT; ++t) {
        asm volatile("s_waitcnt vmcnt(0)" ::: "memory");
        __builtin_amdgcn_s_barrier();
        asm volatile("" ::: "memory");
        if (t + 1 < NT) MLA_DMA(t + 1, (t + 1) & 1);
        const int jb = t - (NT - 4);
        if (jb >= 0 && 64 * jb > 32 * wid + 31) continue;
        const LAS unsigned char* kb = lds + L_K + (t & 1) * KSLOT + hi * 1024 + r32 * 16;
        f32x16 p0 = f32x16{}, p1 = f32x16{};
#pragma unroll
        for (int d0 = 0; d0 < 6; ++d0) {
            const bf16x8 a0 = *(const LAS bf16x8*)(kb + d0 * 2048), a1 = *(const LAS bf16x8*)(kb + d0 * 2048 + 512);
            p0 = __builtin_amdgcn_mfma_f32_32x32x16_bf16(a0, qr[d0], p0, 0, 0, 0);
            p1 = __builtin_amdgcn_mfma_f32_32x32x16_bf16(a1, qr[d0], p1, 0, 0, 0);
        }
        if (jb >= 0) { const int kbase = 64 * jb + 4 * hi;
#pragma unroll
            for (int r = 0; r < 16; ++r) { const int kv = kbase + (r & 3) + 8 * (r >> 2); if (kv > qrel) p0[r] = -INFINITY; if (kv + 32 > qrel) p1[r] = -INFINITY; } }
        float rm = fmaxf(p0[0], p1[0]);
#pragma unroll
        for (int r = 1; r < 16; ++r) rm = fmaxf(rm, fmaxf(p0[r], p1[r]));
        { auto rr = __builtin_amdgcn_permlane32_swap(__float_as_uint(rm), __float_as_uint(rm), false, false); rm = fmaxf(__uint_as_float(rr[0]), __uint_as_float(rr[1])); }
        if (__any(rm > m + (float)THRL)) {
            const float mn = fmaxf(m, rm); const float f = __builtin_amdgcn_exp2f(m - mn); m = mn; l_reg *= f;
            if (hi == 0) wsf[r32] = f;
            asm volatile("s_waitcnt lgkmcnt(0)" ::: "memory");
#pragma unroll
            for (int r = 0; r < 16; ++r) { const float fr_ = wsf[crow(r, hi)]; o0[r] *= fr_; o1[r] *= fr_; }
        }
        float sacc = 0.f;
#pragma unroll
        for (int r = 0; r < 16; ++r) { p0[r] = __builtin_amdgcn_exp2f(p0[r] - m); p1[r] = __builtin_amdgcn_exp2f(p1[r] - m); sacc += p0[r] + p1[r]; }
        l_reg += sacc;
        u32x4 pw[4];
#pragma unroll
        for (int s = 0; s < 2; ++s) {
            pw[s] = (u32x4){cvtpk(p0[8 * s], p0[8 * s + 1]), cvtpk(p0[8 * s + 2], p0[8 * s + 3]), cvtpk(p0[8 * s + 4], p0[8 * s + 5]), cvtpk(p0[8 * s + 6], p0[8 * s + 7])};
            pw[2 + s] = (u32x4){cvtpk(p1[8 * s], p1[8 * s + 1]), cvtpk(p1[8 * s + 2], p1[8 * s + 3]), cvtpk(p1[8 * s + 4], p1[8 * s + 5]), cvtpk(p1[8 * s + 6], p1[8 * s + 7])};
        }
        const LAS unsigned char* vb = lds + L_V + (t & 1) * VSLOT + ((lane >> 4) & 1) * 32 + (lane & 3) * 8 + (4 * hi + ((lane & 15) >> 2)) * 64;
#pragma unroll
        for (int s = 0; s < 4; ++s) {
            const s16x4 lo0 = vtr(vb + s * 1024), hi0 = vtr(vb + s * 1024 + 512), lo1 = vtr(vb + 4096 + s * 1024), hi1 = vtr(vb + 4096 + s * 1024 + 512);
            const bf16x8 pa = __builtin_bit_cast(bf16x8, pw[s]);
            o0 = __builtin_amdgcn_mfma_f32_32x32x16_bf16(pa, (bf16x8){lo0[0], lo0[1], lo0[2], lo0[3], hi0[0], hi0[1], hi0[2], hi0[3]}, o0, 0, 0, 0);
            o1 = __builtin_amdgcn_mfma_f32_32x32x16_bf16(pa, (bf16x8){lo1[0], lo1[1], lo1[2], lo1[3], hi1[0], hi1[1], hi1[2], hi1[3]}, o1, 0, 0, 0);
        }
    }
#undef MLA_DMA
    { auto rr = __builtin_amdgcn_permlane32_swap(__float_as_uint(l_reg), __float_as_uint(l_reg), false, false); l_reg = __uint_as_float(rr[0]) + __uint_as_float(rr[1]); }
    if (hi == 0) wsf[32 + r32] = l_reg;
    asm volatile("s_waitcnt lgkmcnt(0)" ::: "memory");
    LAS float* stg = (LAS float*)(lds + L_ST + wid * 8192);
#pragma unroll
    for (int r = 0; r < 16; ++r) { const int orow = crow(r, hi); const float rl = __builtin_amdgcn_rcpf(wsf[32 + orow]); stg[orow * 64 + r32] = o0[r] * rl; stg[orow * 64 + 32 + r32] = o1[r] * rl; }
    asm volatile("s_waitcnt lgkmcnt(0)" ::: "memory");
    bf16_t* Yw = Y + (size_t)(rowbase + q0 + wid * 32) * 1024 + h * 64;
#pragma unroll
    for (int i = 0; i < 4; ++i) {
        const int row = i * 8 + (lane >> 3), ch = lane & 7;
        const f32x4 a = *(const LAS f32x4*)(stg + row * 64 + ch * 8), c = *(const LAS f32x4*)(stg + row * 64 + ch * 8 + 4);
        float ss = (a[0] * a[0] + a[1] * a[1]) + (a[2] * a[2] + a[3] * a[3]) + (c[0] * c[0] + c[1] * c[1]) + (c[2] * c[2] + c[3] * c[3]);
        ss += __shfl_xor(ss, 1); ss += __shfl_xor(ss, 2); ss += __shfl_xor(ss, 4);
        const float rs = rsqrtf(ss * (1.f / 64.f) + EPS_);
        u32x4 w; w.x = cvtpk(a[0] * rs, a[1] * rs); w.y = cvtpk(a[2] * rs, a[3] * rs); w.z = cvtpk(c[0] * rs, c[1] * rs); w.w = cvtpk(c[2] * rs, c[3] * rs);
        *(u32x4*)(Yw + (size_t)row * 1024 + ch * 8) = w;
    }
    asm volatile("s_waitcnt lgkmcnt(0)" ::: "memory");
    __builtin_amdgcn_s_barrier();
    asm volatile("" ::: "memory");
}
}

namespace rt {
typedef short bf16x8 __attribute__((ext_vector_type(8)));
typedef float f32x16 __attribute__((ext_vector_type(16)));
__device__ __forceinline__ int mono(float f) { const int b = __float_as_int(f); return b ^ ((b >> 31) & 0x7fffffff); }
__device__ __forceinline__ float unmono(int k) { return __int_as_float(k ^ ((k >> 31) & 0x7fffffff)); }
template <int N> __device__ __forceinline__ void bitonic_sort_desc(int (&k)[N]) {
#pragma unroll
    for (int size = 2; size <= N; size <<= 1)
#pragma unroll
        for (int stride = size >> 1; stride > 0; stride >>= 1)
#pragma unroll
            for (int i = 0; i < N; ++i) { const int j = i ^ stride;
                if (j > i) { const int mx = max(k[i], k[j]), mn = min(k[i], k[j]); if ((i & size) == 0) { k[i] = mx; k[j] = mn; } else { k[i] = mn; k[j] = mx; } } }
}
__device__ __forceinline__ void bitonic_merge_desc16(int (&k)[16]) {
#pragma unroll
    for (int stride = 8; stride > 0; stride >>= 1)
#pragma unroll
        for (int i = 0; i < 16; ++i) { const int j = i ^ stride; if (j > i) { const int mx = max(k[i], k[j]), mn = min(k[i], k[j]); k[i] = mx; k[j] = mn; } }
}
__device__ __forceinline__ void merge_top16(int (&a)[16], const int (&b)[16]) {
#pragma unroll
    for (int i = 0; i < 16; ++i) a[i] = max(a[i], b[15 - i]);
    bitonic_merge_desc16(a);
}
__device__ __forceinline__ void cross_merge16(int (&a)[16], int hi) {
    int pnr[16];
#pragma unroll
    for (int i = 0; i < 16; ++i) { auto r = __builtin_amdgcn_permlane32_swap((unsigned)a[i], (unsigned)a[i], false, false); pnr[i] = hi ? (int)r[0] : (int)r[1]; }
#pragma unroll
    for (int i = 0; i < 16; ++i) a[i] = max(a[i], pnr[15 - i]);
    bitonic_merge_desc16(a);
}
__device__ constexpr int A0[25] = {0,0,0,0,0,0,0,0, 1,1,1,1, 2,2, 3,3, 4, 5,6,7, 2, 8,10,12,14};
__device__ constexpr int B0[25] = {0,1,2,3,4,5,6,7, 0,1,2,3, 0,1, 0,1, 0, 0,0,0, 4, 0,0,0,0};
__device__ constexpr int A1[25] = {0,0,0,0,0,0,0,0, 1,1,1,1, 2,2, 3,3, 4, 5,6,7, 4, 9,11,13,15};
__device__ constexpr int B1[25] = {8,9,10,11,12,13,14,15, 4,5,6,7, 2,3, 2,3, 1, 1,1,1, 2, 0,0,0,0};

__device__ __forceinline__ void top16_set(const bf16_t* qrow  , const LAS unsigned char* skset, int r32, int hi, int (&T)[16]) {
    bf16x8 qf[4];
#pragma unroll
    for (int s2 = 0; s2 < 4; ++s2) qf[s2] = *(const bf16x8*)(qrow + 16 * s2);
    int k[4][16];
#pragma unroll
    for (int kb = 0; kb < 4; ++kb) {
        f32x16 sc = f32x16{};
#pragma unroll
        for (int s2 = 0; s2 < 4; ++s2) { const bf16x8 a = *(const LAS bf16x8*)(skset + (2 * s2 + hi) * 2048 + (kb * 32 + r32) * 16); sc = __builtin_amdgcn_mfma_f32_32x32x16_bf16(a, qf[s2], sc, 0, 0, 0); }
#pragma unroll
        for (int r = 0; r < 16; ++r) k[kb][r] = ((mono(sc[r]) & ~0x7f) | (hi << 2)) | (kb * 32 + (r & 3) + 8 * (r >> 2));
        bitonic_sort_desc<16>(k[kb]);
    }
    merge_top16(k[0], k[1]); merge_top16(k[2], k[3]); merge_top16(k[0], k[2]);
#pragma unroll
    for (int i = 0; i < 16; ++i) T[i] = k[0][i];
    cross_merge16(T, hi);
}

__device__ __forceinline__ void route_unit(int pm, int pn, const bf16_t* QP, const bf16_t* SKb, int* RIDX, float* RGATE, LAS unsigned char* lds, int wid, int lane) {
    const int r32 = lane & 31, hi = lane >> 5;
    for (int pc = wid; pc < 64; pc += 8) {
        const int set = pc >> 4, ch = (pc >> 1) & 7, hf = pc & 1;
        const bf16_t* src = SKb + ((size_t)((2 * pn + (set >> 1)) * 2 + (set & 1)) * 128 + 64 * hf + lane) * 64 + ch * 8;
        __builtin_amdgcn_global_load_lds((const unsigned*)src, (LAS unsigned*)(lds + set * 16384 + ch * 2048 + hf * 1024), 16, 0, 0);
    }
    asm volatile("s_waitcnt vmcnt(0)" ::: "memory"); __builtin_amdgcn_s_barrier(); asm volatile("" ::: "memory");
    const int t = pm * 256 + wid * 32 + r32;
#pragma unroll 1
    for (int hsel = 0; hsel < 2; ++hsel) {
        const int hh = 2 * pn + hsel;
        int T0[16], T1[16];
        const bf16_t* qrow = QP + (size_t)t * 1024 + hh * 128 + 8 * hi;
        top16_set(qrow, lds + (hsel * 2 + 0) * 16384, r32, hi, T0);
        top16_set(qrow + 64, lds + (hsel * 2 + 1) * 16384, r32, hi, T1);
        int ck[32], ok[25];
#pragma unroll
        for (int k2 = 0; k2 < 25; ++k2) { const int ka = hi ? T0[A1[k2]] : T0[A0[k2]], kb2 = hi ? T1[B1[k2]] : T1[B0[k2]];
            const float sm = unmono(ka & ~0x7f) + unmono(kb2 & ~0x7f); ok[k2] = ((mono(sm) & ~0x3f) | hi) | (2 * k2); ck[k2] = ok[k2]; }
#pragma unroll
        for (int k2 = 25; k2 < 32; ++k2) ck[k2] = (int)0x80000000;
        bitonic_sort_desc<32>(ck);
        int c16[16];
#pragma unroll
        for (int i = 0; i < 16; ++i) c16[i] = ck[i];
        cross_merge16(c16, hi);
        const int K16 = c16[15];
        const float smax = unmono(T0[0] & ~0x7f) + unmono(T1[0] & ~0x7f);
        float tot = 0.f; int cnt = 0;
#pragma unroll
        for (int k2 = 0; k2 < 25; ++k2) { if (ok[k2] >= K16) { tot += __builtin_amdgcn_exp2f((unmono(ok[k2] & ~0x3f) - smax) * LOG2E); cnt += 1; } }
        float tot_all; int cnt_lo;
        { auto r = __builtin_amdgcn_permlane32_swap(__float_as_uint(tot), __float_as_uint(tot), false, false); tot_all = __uint_as_float(r[0]) + __uint_as_float(r[1]); }
        { auto r = __builtin_amdgcn_permlane32_swap((unsigned)cnt, (unsigned)cnt, false, false); cnt_lo = hi ? (int)r[0] : cnt; }
        const float inv = 1.f / tot_all;
        int pos = hi ? cnt_lo : 0;
        int* ri = RIDX + (size_t)t * 128 + hh * 16; float* rg = RGATE + (size_t)t * 128 + hh * 16;
#pragma unroll
        for (int k2 = 0; k2 < 25; ++k2) {
            if (ok[k2] >= K16) {
                const int ea = hi ? (T0[A1[k2]] & 0x7f) : (T0[A0[k2]] & 0x7f), eb = hi ? (T1[B1[k2]] & 0x7f) : (T1[B0[k2]] & 0x7f);
                ri[pos] = ea * 128 + eb; rg[pos] = __builtin_amdgcn_exp2f((unmono(ok[k2] & ~0x3f) - smax) * LOG2E) * inv; pos += 1;
            }
        }
    }
    asm volatile("s_waitcnt vmcnt(0) lgkmcnt(0)" ::: "memory"); __builtin_amdgcn_s_barrier(); asm volatile("" ::: "memory");
}
}

#ifndef REP_LIST
#define REP_LIST {1, 1, 1, 1, 1, 1, 1, 1, 1, 1, 1, 1, 1, 1}
#endif
__device__ constexpr int REP[14] = REP_LIST;
__global__ void __launch_bounds__(NWAVES * 64, 2) mk_fwd(Args args) {
    extern __shared__ __attribute__((aligned(16))) unsigned char lds[];
    Frame F;
    F.lds = (LAS unsigned char*)lds; F.tid = threadIdx.x; F.lane = F.tid & 63; F.wave = __builtin_amdgcn_readfirstlane(F.tid >> 6);
    F.G = gridDim.x; F.gw = blockIdx.x * NWAVES + F.wave; F.NGW = F.G * NWAVES; F.ws = args.ws;
    volatile LAS unsigned* MISC = (volatile LAS unsigned*)(F.lds + MISC_OFF);
    for (int u = F.tid; u < (LDS_BYTES - LDSCTL_OFF) / 4; u += NWAVES * 64) ((LAS unsigned*)(F.lds + LDSCTL_OFF))[u] = 0u;
    __syncthreads();
    unsigned* ctl = (unsigned*)(args.ws + WS_CTL);
    XcdBarrier bar = xcd_barrier_post(ctl + CW_BAR + args.bar_region * XCD_BAR_WORDS, MISC + 8);
    const int lo = args.ph_lo, hi = args.ph_hi;
#define IN(k) (lo <= (k) && (k) < hi)
#define NEXTP(k) ((k) == 5 ? 7 : (k) == 8 ? 10 : (k) + 1)
#define BOTH(k) (IN(k) && IN(NEXTP(k)))
    unsigned char* ws = args.ws;
    bf16_t* Qb = (bf16_t*)args.out; bf16_t* Kb = Qb + (size_t)T_ * 768; bf16_t* Vb = Kb + (size_t)T_ * 768;

    if (IN(0)) for (int rep_ = 0; rep_ < REP[0]; ++rep_) { p0_prologue(F, args); if (BOTH(0)) xcd_barrier(bar); }

    if (IN(1)) for (int rep_ = 0; rep_ < REP[1]; ++rep_) {
        { pg8::Gemm g{(const bf16_t*)(ws + WS_RA), (const bf16_t*)(ws + WO_WIN), 1024, 1024, T_, 2560, 1024};
          pg8::StaticOrder S; S.init(T_, 2560, F.G, (int)blockIdx.x);
          pg8::EpiGen<0, false, 0, true> E{(bf16_t*)(ws + WS_RB), PJ, nullptr, nullptr, 0, 0.f, 1.f, nullptr, 0, (float*)(ws + PSS1_OFF), 3, T_, nullptr, nullptr};
          pg8::gemm_phase<decltype(E), pg8::StaticOrder, PG8_ALIGN, PG8_SP2>(F.lds + RING_OFF, g, S, E, F.wave); }
        { pg8::Gemm g{(const bf16_t*)(ws + WS_MEMN), (const bf16_t*)(ws + WO_WXKV), 1024, 1024, TM_, 1024, 1024};
          pg8::StaticOrder S; S.init(TM_, 1024, F.G, (int)((blockIdx.x + F.G - 128) % F.G));
          pg8::EpiGen<0, false, 0, false> E{(bf16_t*)(ws + WS_KX), 1024, nullptr, nullptr, 0, 0.f, 1.f, nullptr, 0, nullptr, 0, TM_, nullptr, nullptr};
          pg8::gemm_phase<decltype(E), pg8::StaticOrder, PG8_ALIGN, PG8_SP2>(F.lds + RING_OFF, g, S, E, F.wave); }
        { pg8::Gemm g{(const bf16_t*)(ws + WO_WXKV) + (size_t)1024 * 1024, (const bf16_t*)(ws + WS_MEMN), 1024, 1024, 1024, TM_, 1024};
          pg8::StaticOrder S; S.init(1024, TM_, F.G, (int)((blockIdx.x + F.G - 160) % F.G));
          pg8::EpiGen<0, false, 0, false> E{(bf16_t*)(ws + WS_VXT), 2048, nullptr, nullptr, 0, 0.f, 1.f, nullptr, 0, nullptr, 0, 1024, nullptr, nullptr};
          pg8::gemm_phase<decltype(E), pg8::StaticOrder, PG8_ALIGN, PG8_SP2>(F.lds + RING_OFF, g, S, E, F.wave); }
        if (BOTH(1)) xcd_barrier(bar);
    }

    if (IN(2)) for (int rep_ = 0; rep_ < REP[2]; ++rep_) {
        { pg8::Gemm g{(const bf16_t*)(ws + WS_RB) + 512, (const bf16_t*)(ws + WO_WUKV), PJ, 256, T_, 1024, 256};
          pg8::StaticOrder S; S.init(T_, 1024, F.G, (int)blockIdx.x);
          pg8::EpiGen<2, true, 0, false> E{Kb, 768, Vb, (const float*)(ws + PSS1_OFF) + (size_t)8 * T_, 4, 1.f / 256.f, 1.f, nullptr, 0, nullptr, 0, T_, nullptr, nullptr};
          pg8::gemm_phase<decltype(E), pg8::StaticOrder, PG8_ALIGN, PG8_SP2>(F.lds + RING_OFF, g, S, E, F.wave); }
        { pg8::Gemm g{(const bf16_t*)(ws + WS_RB), (const bf16_t*)(ws + WO_WUQ), PJ, 384, T_, 768, 384};
          pg8::StaticOrder S; S.init(T_, 768, F.G, (int)((blockIdx.x + F.G - 64) % F.G));
          pg8::EpiGen<1, true, 0, false> E{Qb, 768, nullptr, (const float*)(ws + PSS1_OFF), 8, 1.f / 384.f, LOG2E * 0.10206207261596577f, nullptr, 0, nullptr, 0, T_, (const float*)(ws + WS_COS), (const float*)(ws + WS_SIN)};
          pg8::gemm_phase<decltype(E), pg8::StaticOrder, PG8_ALIGN, PG8_SP2>(F.lds + RING_OFF, g, S, E, F.wave); }
        p2_conv_job(F, args);
        if (BOTH(2)) xcd_barrier(bar);
    }

    if (IN(3)) for (int rep_ = 0; rep_ < REP[3]; ++rep_) {
        const int vcu = (F.G % 8 == 0) ? (int)((blockIdx.x % 8) * (F.G / 8) + blockIdx.x / 8) : (int)blockIdx.x;
        int lane = __builtin_amdgcn_mbcnt_hi(~0u, __builtin_amdgcn_mbcnt_lo(~0u, 0u)); asm volatile("" : "+v"(lane));
        for (int v = vcu; v < 256; v += F.G) {
            const int bh = v >> 2, sx = v & 3;
            mla::unit<8>(bh >> 3, bh & 7, 7 - sx, Qb, Kb, Vb, (bf16_t*)(ws + WS_RA), F.lds + RING_OFF, F.wave, lane);
            mla::unit<8>(bh >> 3, bh & 7, sx, Qb, Kb, Vb, (bf16_t*)(ws + WS_RA), F.lds + RING_OFF, F.wave, lane);
        }
        if (BOTH(3)) xcd_barrier(bar);
    }

    if (IN(4)) for (int rep_ = 0; rep_ < REP[4]; ++rep_) {
        pg8::Gemm g{(const bf16_t*)(ws + WS_RA), (const bf16_t*)(ws + WO_WO), 1024, 1024, T_, 1024, 1024};
        pg8::StaticOrder S; S.init(T_, 1024, F.G, (int)blockIdx.x);
        pg8::EpiGen<0, false, 1, true> E{(bf16_t*)(ws + WS_RB), 1024, nullptr, nullptr, 0, 0.f, 1.f, args.in[0], 1024, (float*)(ws + PSS4_OFF), 4, T_, nullptr, nullptr};
        pg8::gemm_phase<decltype(E), pg8::StaticOrder, PG8_ALIGN, PG8_SP2>(F.lds + RING_OFF, g, S, E, F.wave);
        if (BOTH(4)) xcd_barrier(bar);
    }

    if (IN(5)) for (int rep_ = 0; rep_ < REP[5]; ++rep_) {
        pg8::StaticOrder S0; S0.init(T_, 1024, F.G, (int)blockIdx.x);
        for (int ui = 0; ; ++ui) {
            pg8::Unit u; if (!S0.next(ui, u)) break;
            const int bb = u.pm >> 3, hh = u.pn;
            if (ui > 0) { __builtin_amdgcn_fence(__ATOMIC_ACQUIRE, "agent"); asm volatile("s_waitcnt vmcnt(0)" ::: "memory"); __syncthreads(); }
            bf16_t* QXt = (bf16_t*)(ws + WS_RA) + (size_t)u.pm * 256 * 1024 + hh * 256;
            bf16_t* PXt = (bf16_t*)(ws + WS_RD) + (size_t)blockIdx.x * 65536;
            { pg8::Gemm g{(const bf16_t*)(ws + WS_RB), (const bf16_t*)(ws + WO_WXQ), 1024, 1024, T_, 1024, 1024};
              pg8::FixedUnit S{u.pm, u.pn};
              pg8::EpiGen<0, true, 0, false> E{(bf16_t*)(ws + WS_RA), 1024, nullptr, (const float*)(ws + PSS4_OFF), 16, 1.f / 1024.f, LOG2E / 16.f, nullptr, 0, nullptr, 0, T_, nullptr, nullptr};
              pg8::gemm_phase<decltype(E), pg8::FixedUnit, false, PG8_SP2>(F.lds + RING_OFF, g, S, E, F.wave); }
            { pg8::Gemm g{QXt, (const bf16_t*)(ws + WS_KX) + (size_t)bb * 256 * 1024 + hh * 256, 1024, 1024, 256, 256, 256};
              pg8::SingleUnit S; pg8::EpiSoftmax E{PXt, 256};
              pg8::gemm_phase<pg8::EpiSoftmax, pg8::SingleUnit, false, PG8_SP2>(F.lds + RING_OFF, g, S, E, F.wave); }
            { pg8::Gemm g{PXt, (const bf16_t*)(ws + WS_VXT) + (size_t)hh * 256 * 2048 + bb * 256, 256, 2048, 256, 256, 256};
              pg8::SingleUnit S;
              pg8::EpiGen<0, false, 0, false> E{(bf16_t*)(ws + WS_RC) + (size_t)u.pm * 256 * 1024 + hh * 256, 1024, nullptr, nullptr, 0, 0.f, 1.f, nullptr, 0, nullptr, 0, T_, nullptr, nullptr};
              pg8::gemm_phase<decltype(E), pg8::SingleUnit, false, PG8_SP2>(F.lds + RING_OFF, g, S, E, F.wave); }
        }
        if (BOTH(5)) xcd_barrier(bar);
    }


    if (IN(7)) for (int rep_ = 0; rep_ < REP[7]; ++rep_) {
        pg8::Gemm g{(const bf16_t*)(ws + WS_RC), (const bf16_t*)(ws + WO_WXO), 1024, 1024, T_, 1024, 1024};
        pg8::StaticOrder S; S.init(T_, 1024, F.G, (int)blockIdx.x);
        pg8::EpiGen<0, false, 2, true> E{(bf16_t*)(ws + WS_RA), 1024, nullptr, nullptr, 0, 0.f, 1.f, (const void*)(ws + WS_RB), 1024, (float*)(ws + PSS6_OFF), 4, T_, nullptr, nullptr};
        pg8::gemm_phase<decltype(E), pg8::StaticOrder, PG8_ALIGN, PG8_SP2>(F.lds + RING_OFF, g, S, E, F.wave);
        if (BOTH(7)) xcd_barrier(bar);
    }

    if (IN(8)) for (int rep_ = 0; rep_ < REP[8]; ++rep_) {
        pg8::StaticOrder S0; S0.init(T_, 1024, F.G, (int)blockIdx.x);
        for (int ui = 0; ; ++ui) {
            pg8::Unit u; if (!S0.next(ui, u)) break;
            { pg8::Gemm g{(const bf16_t*)(ws + WS_RA), (const bf16_t*)(ws + WO_WPQ), 1024, 1024, T_, 1024, 1024};
              pg8::FixedUnit S{u.pm, u.pn};
              pg8::EpiGen<0, true, 0, false> E{(bf16_t*)(ws + WS_RC), 1024, nullptr, (const float*)(ws + PSS6_OFF), 16, 1.f / 1024.f, 1.f, nullptr, 0, nullptr, 0, T_, nullptr, nullptr};
              pg8::gemm_phase<decltype(E), pg8::FixedUnit, false, PG8_SP2>(F.lds + RING_OFF, g, S, E, F.wave); }
            int lane = __builtin_amdgcn_mbcnt_hi(~0u, __builtin_amdgcn_mbcnt_lo(~0u, 0u)); asm volatile("" : "+v"(lane));
            rt::route_unit(u.pm, u.pn, (const bf16_t*)(ws + WS_RC), (const bf16_t*)(ws + WO_SK), (int*)(ws + WS_RIDX), (float*)(ws + WS_RGATE), F.lds + RING_OFF, F.wave, lane);
        }
        if (BOTH(8)) xcd_barrier(bar);
    }


    if (IN(10)) for (int rep_ = 0; rep_ < REP[10]; ++rep_) { p_peer_u(F, args); if (BOTH(10)) xcd_barrier(bar); }
    if (IN(11)) for (int rep_ = 0; rep_ < REP[11]; ++rep_) { p_peer_v(F, args); }
#undef IN
#undef BOTH
}

extern "C" void kernel_launch(void* const* d_in, const int* in_sizes, int n_in, void* d_out, int out_size, void* d_ws, size_t ws_size, hipStream_t stream) {
    const float* x = (const float*)d_in[0];
    const float* g_out = (const float*)d_in[10]; const float* w_o = (const float*)d_in[11];
    const float* g_x = (const float*)d_in[12]; const float* w_xq = (const float*)d_in[14];
    const float* w_xo = (const float*)d_in[16]; const float* g_ffn = (const float*)d_in[17];
    const float* w_pq = (const float*)d_in[18]; const float* sub_keys = (const float*)d_in[19]; const float* u_exp = (const float*)d_in[20];
    const float* v_exp = (const float*)d_in[21]; const float* g_final = (const float*)d_in[22];
    float* out = (float*)d_out; unsigned char* ws = (unsigned char*)d_ws;
    if (ws_size < WS_END || n_in != 23) return;
    static int grid = 0;
    if (grid == 0) {
        int dev = 0, cus = 0;
        if (hipGetDevice(&dev) != hipSuccess || hipDeviceGetAttribute(&cus, hipDeviceAttributeMultiprocessorCount, dev) != hipSuccess) { grid = -1; return; }
        if (hipFuncSetAttribute((const void*)mk_fwd, hipFuncAttributeMaxDynamicSharedMemorySize, LDS_BYTES) != hipSuccess) { grid = -1; return; }
        grid = cus;
    }
    if (grid < 0) return;
    bf16_t* KX = (bf16_t*)(ws + WS_KX); bf16_t* VXT = (bf16_t*)(ws + WS_VXT);
    float* RS1 = (float*)(ws + WS_RIDX) - 2 * T_; float* RS2 = RS1 + T_;
    int* RIDX = (int*)(ws + WS_RIDX); float* RGATE = (float*)(ws + WS_RGATE);
    bf16_t* Y = (bf16_t*)(ws + WS_RA); bf16_t* QX = Y; bf16_t* H2 = Y;
    bf16_t* H1 = (bf16_t*)(ws + WS_RB);
    bf16_t* OX = (bf16_t*)(ws + WS_RC); bf16_t* QP = OX;
    bf16_t* Q = (bf16_t*)d_out; bf16_t* K = Q + (size_t)T_ * 768; bf16_t* V = K + (size_t)T_ * 768;

    hipMemsetAsync(ws + WS_CTL, 0, CTL_ZERO_BYTES, stream);
    Args a; memset(&a, 0, sizeof a);
    for (int i = 0; i < 23; ++i) a.in[i] = d_in[i];
    a.out = out; a.ws = ws;
    a.ph_lo = 0; a.ph_hi = 12; a.bar_region = 0;
    hipLaunchKernelGGL(mk_fwd, dim3(grid), dim3(NWAVES * 64), LDS_BYTES, stream, a);
}
```

```cpp
#include <hip/hip_runtime.h>
#include <stdint.h>
#include <math.h>
#include <string.h>

typedef unsigned short bf16_t;
constexpr int T_ = 16384, D_ = 1024, B_ = 8, S_ = 2048, ML_ = 256, TM_ = 2048;
constexpr int PJ = 2560;
constexpr float EPS_ = 1e-6f;
constexpr float LOG2E = 1.4426950408889634f;

constexpr size_t MiB = 1u << 20;
constexpr size_t WS_CTL = 0;
constexpr size_t WS_COS = 2 * MiB, WS_SIN = 3 * MiB;
constexpr size_t WS_W = 4 * MiB;
constexpr size_t WS_UT = 24 * MiB, WS_VT = 56 * MiB;
constexpr size_t WS_MEMN = 88 * MiB, WS_KX = 92 * MiB, WS_VXT = 96 * MiB;
constexpr size_t WS_RS = 100 * MiB;
constexpr size_t WS_SCL = 105 * MiB;
constexpr size_t WS_RIDX = 106 * MiB, WS_RGATE = 114 * MiB;
constexpr size_t WS_RA = 122 * MiB;
constexpr size_t WS_RB = 154 * MiB;
constexpr size_t WS_RC = 186 * MiB;
constexpr size_t WS_RD = 218 * MiB;
constexpr size_t WS_END = 256 * MiB;

__device__ __forceinline__ float bf2f(bf16_t b) { return __uint_as_float(((unsigned)b) << 16); }
__device__ __forceinline__ bf16_t f2bf(float f) { unsigned u = __float_as_uint(f); return (bf16_t)((u + 0x7fffu + ((u >> 16) & 1u)) >> 16); }
__device__ __forceinline__ unsigned q8pack(float f0, float f1, float f2, float f3, float qs) {
    const unsigned a0 = __float_as_uint(fmaf(f0, qs, 12582912.f)), a1 = __float_as_uint(fmaf(f1, qs, 12582912.f)), a2 = __float_as_uint(fmaf(f2, qs, 12582912.f)), a3 = __float_as_uint(fmaf(f3, qs, 12582912.f));
    return __builtin_amdgcn_perm(a1, a0, 0x0c0c0400u) | __builtin_amdgcn_perm(a3, a2, 0x04000c0cu);
}
__device__ __forceinline__ float wave_sum(float v) {
#pragma unroll
    for (int o = 1; o < 64; o <<= 1) v += __shfl_xor(v, o);
    return v;
}
__device__ __forceinline__ float wave_max(float v) {
#pragma unroll
    for (int o = 1; o < 64; o <<= 1) v = fmaxf(v, __shfl_xor(v, o));
    return v;
}

namespace pg8 {
#define PG8_LAS __attribute__((address_space(3)))
typedef short bf16x8 __attribute__((ext_vector_type(8)));
typedef float f32x4 __attribute__((ext_vector_type(4)));
typedef unsigned u32x4 __attribute__((ext_vector_type(4)));
constexpr int BM = 256, BK = 64, HALF = 128, HTB = HALF * BK * 2  , STAGE_BYTES = 8 * HTB, NXCD = 8, WGM = 8;

__host__ __device__ __forceinline__ int lds_byte(int r, int c) { const int st = (r >> 4) * 2 + (c >> 5), rr = r & 15, cc = c & 31, ob = rr * 64 + cc * 2; return st * 1024 + (ob ^ (((ob >> 9) & 1) << 5)); }
__host__ __device__ __forceinline__ void stage_rc(int b, int& R, int& C) { const int st = b / 1024, sb = b % 1024, swz = sb ^ (((sb >> 9) & 1) << 5); R = (st >> 1) * 16 + swz / 64; C = (st & 1) * 32 + (swz % 64) / 2; }
__host__ __device__ __forceinline__ int perm32(int rho) { const int n = rho >> 4, i = rho & 15; return 8 * (i >> 2) + 4 * n + (i & 3); }

struct Unit { int pm, pn; };
struct Gemm { const bf16_t* A; const bf16_t* Bt; int lda, ldb, M, N, K; };

struct StaticOrder {
    int nM, nN, nwg, G, c;
    __host__ __device__ __forceinline__ void init(int M, int N, int G_, int c_) { nM = M / BM; nN = N / BM; nwg = nM * nN; G = G_; c = c_; }
    __host__ __device__ __forceinline__ bool next(int i, Unit& u) const {
        const long L = (long)i * G + c; if (L >= nwg) return false;
        int wgid = (int)L; { const int q = nwg / NXCD, r = nwg % NXCD, xcd = wgid % NXCD, off = wgid / NXCD; wgid = (xcd < r ? xcd * (q + 1) : r * (q + 1) + (xcd - r) * q) + off; }
        const int nig = WGM * nN, gid = wgid / nig, fm = gid * WGM, gsz = (nM - fm) < WGM ? (nM - fm) : WGM;
        u.pm = fm + ((wgid % nig) % gsz); u.pn = (wgid % nig) / gsz; return true;
    }
    __device__ __forceinline__ void a_ready(const Unit&) const {}
    __device__ __forceinline__ void done(const Unit&) const {}
};

__device__ __forceinline__ unsigned cvt_pk_bf16(float lo, float hi) { unsigned r; asm volatile("v_cvt_pk_bf16_f32 %0, %1, %2" : "=v"(r) : "v"(lo), "v"(hi)); return r; }
__device__ __forceinline__ float bflo(unsigned w) { return __uint_as_float(w << 16); }
__device__ __forceinline__ float bfhi(unsigned w) { return __uint_as_float(w & 0xffff0000u); }

template <int MODE, bool RSCALE, int RES  , bool PSS>
struct EpiGen {
    static constexpr bool PERM = true, AFTER_DRAIN = false;
    bf16_t* O; int ldc; bf16_t* O2;
    const float* parts; int nparts; float inv_dim; float cscale;
    const void* R; int ldr;
    float* pss; int pss_tiles; int rows_total;
    const float* COS; const float* SIN;
    __device__ __forceinline__ void operator()(const f32x4 (&acc)[2][2][4][2], const Unit& u, int wr, int wc, int fr, int fq) const {
        { int ln = __builtin_amdgcn_mbcnt_hi(~0u, __builtin_amdgcn_mbcnt_lo(~0u, 0u)); asm volatile("" : "+v"(ln)); fr = ln & 15; fq = ln >> 4; }
        const int row0 = u.pm * BM + wr * 64 + fr;
        const int colb = u.pn * BM + wc * 32 + 8 * fq;
#pragma unroll
        for (int ai = 0; ai < 2; ++ai) {
            float psum[4]; f32x4 rf[4][2][2]; u32x4 rw[4][2];
#pragma unroll
            for (int m = 0; m < 4; ++m) {
                const int row = row0 + ai * HALF + m * 16;
                if (RSCALE) { float s = 0.f;
#pragma unroll
                    for (int i = 0; i < 4; ++i) { const int p = fq + 4 * i; const float pv = parts[(size_t)(p < nparts ? p : fq) * rows_total + row]; s += (p < nparts) ? pv : 0.f; }
                    psum[m] = s; }
#pragma unroll
                for (int bj = 0; bj < 2; ++bj) { const int col = colb + bj * HALF;
                    if (RES == 1) { const float* r = (const float*)R + (size_t)row * ldr + col; rf[m][bj][0] = *(const f32x4*)r; rf[m][bj][1] = *(const f32x4*)(r + 4); }
                    if (RES == 2) rw[m][bj] = *(const u32x4*)((const bf16_t*)R + (size_t)row * ldr + col); }
            }
#pragma unroll
            for (int m = 0; m < 4; ++m) {
                const int row = row0 + ai * HALF + m * 16;
                float rs = cscale;
                if (RSCALE) { float s = psum[m]; s += __shfl_xor(s, 16); s += __shfl_xor(s, 32); rs *= rsqrtf(s * inv_dim + 1e-6f); }
                float ss = 0.f;
#pragma unroll
                for (int bj = 0; bj < 2; ++bj) {
                    const int col = colb + bj * HALF;
                    f32x4 v0 = acc[ai][bj][m][0] * rs, v1 = acc[ai][bj][m][1] * rs;
                    if (RES == 1) { v0 += rf[m][bj][0]; v1 += rf[m][bj][1]; }
                    if (RES == 2) { const u32x4 w = rw[m][bj];
                        v0 += (f32x4){bflo(w.x), bfhi(w.x), bflo(w.y), bfhi(w.y)}; v1 += (f32x4){bflo(w.z), bfhi(w.z), bflo(w.w), bfhi(w.w)}; }
                    if (PSS) ss += (v0[0] * v0[0] + v0[1] * v0[1]) + (v0[2] * v0[2] + v0[3] * v0[3]) + (v1[0] * v1[0] + v1[1] * v1[1]) + (v1[2] * v1[2] + v1[3] * v1[3]);
                    bf16_t* dst;
                    if (MODE == 1) {
                        const int pr = col % 96;
                        if (pr >= 64) { const int i0 = (pr - 64) >> 1; const f32x4 c = *(const f32x4*)(COS + (size_t)row * 16 + i0), s = *(const f32x4*)(SIN + (size_t)row * 16 + i0);
                            const f32x4 a0 = v0, a1 = v1;
                            v0[0] = a0[0] * c[0] - a0[1] * s[0]; v0[1] = a0[1] * c[0] + a0[0] * s[0]; v0[2] = a0[2] * c[1] - a0[3] * s[1]; v0[3] = a0[3] * c[1] + a0[2] * s[1];
                            v1[0] = a1[0] * c[2] - a1[1] * s[2]; v1[1] = a1[1] * c[2] + a1[0] * s[2]; v1[2] = a1[2] * c[3] - a1[3] * s[3]; v1[3] = a1[3] * c[3] + a1[2] * s[3]; }
                        dst = O + (size_t)row * 768 + col;
                    } else if (MODE == 2) {
                        if (col < 512) dst = O + (size_t)row * 768 + (col >> 6) * 96 + (col & 63); else dst = O2 + (size_t)row * 512 + (col - 512);
                    } else dst = O + (size_t)row * ldc + col;
                    u32x4 w; w.x = cvt_pk_bf16(v0[0], v0[1]); w.y = cvt_pk_bf16(v0[2], v0[3]); w.z = cvt_pk_bf16(v1[0], v1[1]); w.w = cvt_pk_bf16(v1[2], v1[3]);
                    *(u32x4*)dst = w;
                }
                if (PSS) { if (u.pn < pss_tiles) { ss += __shfl_xor(ss, 16); ss += __shfl_xor(ss, 32); if (fq == 0) pss[(size_t)(u.pn * 4 + wc) * rows_total + row] = ss; } }
            }
            asm volatile("" ::: "memory");
        }
    }
};

struct SingleUnit {
    __device__ __forceinline__ bool next(int i, Unit& u) const { if (i > 0) return false; u.pm = 0; u.pn = 0; return true; }
    __device__ __forceinline__ void a_ready(const Unit&) const {}
    __device__ __forceinline__ void done(const Unit&) const {}
};
struct FixedUnit {
    int pm, pn;
    __device__ __forceinline__ bool next(int i, Unit& u) const { if (i > 0) return false; u.pm = pm; u.pn = pn; return true; }
    __device__ __forceinline__ void a_ready(const Unit&) const {}
    __device__ __forceinline__ void done(const Unit&) const {}
};

struct EpiSoftmax {
    static constexpr bool PERM = true, AFTER_DRAIN = true;
    bf16_t* O; int ldc;
    __device__ __forceinline__ void fused(f32x4 (&acc)[2][2][4][2], const Unit& u, int wr, int wc, int fr, int fq, PG8_LAS unsigned char* lds, int wid, int lane) const {
        PG8_LAS float* PM = (PG8_LAS float*)lds;
        PG8_LAS float* PS = (PG8_LAS float*)(lds + 4096);
#pragma unroll
        for (int ai = 0; ai < 2; ++ai)
#pragma unroll
            for (int m = 0; m < 4; ++m) {
                const int row = ai * HALF + wr * 64 + m * 16 + fr;
                float mx = -INFINITY;
#pragma unroll
                for (int bj = 0; bj < 2; ++bj)
#pragma unroll
                    for (int n = 0; n < 2; ++n) { const f32x4 v = acc[ai][bj][m][n]; mx = fmaxf(mx, fmaxf(fmaxf(v[0], v[1]), fmaxf(v[2], v[3]))); }
                mx = fmaxf(mx, __shfl_xor(mx, 16)); mx = fmaxf(mx, __shfl_xor(mx, 32));
                if (fq == 0) PM[row * 4 + wc] = mx;
            }
        asm volatile("s_waitcnt lgkmcnt(0)" ::: "memory"); __builtin_amdgcn_s_barrier(); asm volatile("" ::: "memory");
#pragma unroll
        for (int ai = 0; ai < 2; ++ai)
#pragma unroll
            for (int m = 0; m < 4; ++m) {
                const int row = ai * HALF + wr * 64 + m * 16 + fr;
                const f32x4 pm = *(const PG8_LAS f32x4*)(PM + row * 4);
                const float mrow = fmaxf(fmaxf(pm[0], pm[1]), fmaxf(pm[2], pm[3]));
                float sm = 0.f;
#pragma unroll
                for (int bj = 0; bj < 2; ++bj)
#pragma unroll
                    for (int n = 0; n < 2; ++n) { f32x4 v = acc[ai][bj][m][n];
                        v[0] = __builtin_amdgcn_exp2f(v[0] - mrow); v[1] = __builtin_amdgcn_exp2f(v[1] - mrow); v[2] = __builtin_amdgcn_exp2f(v[2] - mrow); v[3] = __builtin_amdgcn_exp2f(v[3] - mrow);
                        sm += (v[0] + v[1]) + (v[2] + v[3]); acc[ai][bj][m][n] = v; }
                sm += __shfl_xor(sm, 16); sm += __shfl_xor(sm, 32);
                if (fq == 0) PS[row * 4 + wc] = sm;
            }
        asm volatile("s_waitcnt lgkmcnt(0)" ::: "memory"); __builtin_amdgcn_s_barrier(); asm volatile("" ::: "memory");
#pragma unroll
        for (int ai = 0; ai < 2; ++ai)
#pragma unroll
            for (int m = 0; m < 4; ++m) {
                const int row = ai * HALF + wr * 64 + m * 16 + fr;
                const f32x4 ps = *(const PG8_LAS f32x4*)(PS + row * 4);
                const float inv = 1.f / ((ps[0] + ps[1]) + (ps[2] + ps[3]));
#pragma unroll
                for (int bj = 0; bj < 2; ++bj) {
                    const f32x4 v0 = acc[ai][bj][m][0] * inv, v1 = acc[ai][bj][m][1] * inv;
                    u32x4 w; w.x = cvt_pk_bf16(v0[0], v0[1]); w.y = cvt_pk_bf16(v0[2], v0[3]); w.z = cvt_pk_bf16(v1[0], v1[1]); w.w = cvt_pk_bf16(v1[2], v1[3]);
                    *(u32x4*)(O + (size_t)row * ldc + bj * HALF + wc * 32 + 8 * fq) = w;
                }
            }
        asm volatile("s_waitcnt vmcnt(0) lgkmcnt(0)" ::: "memory"); __builtin_amdgcn_s_barrier(); asm volatile("" ::: "memory");
    }
};

template <class Epi, class Sched, bool ALIGN_EPI = false, bool SP2 = false>
__device__ __forceinline__ void gemm_phase(PG8_LAS unsigned char* lds, const Gemm g, const Sched& S, const Epi& E, const int wid_in  ) {
    int lane_ = __builtin_amdgcn_mbcnt_hi(~0u, __builtin_amdgcn_mbcnt_lo(~0u, 0u)); asm volatile("" : "+v"(lane_));
    const int wid = wid_in, lane = lane_, tid = wid * 64 + lane, wr = wid >> 2, wc = wid & 3, fr = lane & 15, fq = lane >> 4;
    const int K = g.K, nt = K / BK;
    unsigned voffA[2], voffB[2];
#pragma unroll
    for (int i = 0; i < 2; ++i) { int R, C; stage_rc(tid * 16 + i * 8192, R, C); const int Rb = Epi::PERM ? ((R & ~31) + perm32(R & 31)) : R;
        voffA[i] = (unsigned)(R * g.lda + C) * 2u; voffB[i] = (unsigned)(Rb * g.ldb + C) * 2u; }
    const size_t kstep = (size_t)(BK * 2);
    const size_t hstepA = (size_t)HALF * g.lda * 2, hstepB = (size_t)HALF * g.ldb * 2;
    const size_t tstepA = 2 * hstepA, tstepB = 2 * hstepB;
    const unsigned ldsw = (unsigned)wid * 1024u;
    const int aoff = lds_byte(wr * 64 + fr, fq * 8), boff = lds_byte(wc * 32 + fr, fq * 8);
#define PG8_SA(b, h) (((b) * 2 + (h)) * HTB)
#define PG8_SB(b, h) ((4 + (b) * 2 + (h)) * HTB)
#define PG8_STAGE(bufoff, gbase, voff) do { _Pragma("unroll") for (int _i = 0; _i < 2; ++_i) \
        __builtin_amdgcn_global_load_lds((const unsigned*)((const char*)(gbase) + (voff)[_i]), (PG8_LAS unsigned*)(lds + (bufoff) + ldsw + _i * 8192), 16, 0, 0); } while (0)
#define PG8_LDA(dst, b, h) do { _Pragma("unroll") for (int m = 0; m < 4; ++m) _Pragma("unroll") for (int k = 0; k < 2; ++k) dst[m][k] = *(const PG8_LAS bf16x8*)(lds + PG8_SA(b, h) + aoff + m * 2048 + k * 1024); } while (0)
#define PG8_LDB(dst, b, h) do { _Pragma("unroll") for (int n = 0; n < 2; ++n) _Pragma("unroll") for (int k = 0; k < 2; ++k) dst[n][k] = *(const PG8_LAS bf16x8*)(lds + PG8_SB(b, h) + boff + n * 2048 + k * 1024); } while (0)
#define PG8_MMA(ai, bj, At, Bt) do { __builtin_amdgcn_s_setprio(1); _Pragma("unroll") for (int m = 0; m < 4; ++m) _Pragma("unroll") for (int n = 0; n < 2; ++n) _Pragma("unroll") for (int k = 0; k < 2; ++k) \
        acc[ai][bj][m][n] = __builtin_amdgcn_mfma_f32_16x16x32_bf16(Bt[n][k], At[m][k], acc[ai][bj][m][n], 0, 0, 0); __builtin_amdgcn_s_setprio(0); } while (0)
#define PG8_WAIT_V(n) asm volatile("s_waitcnt vmcnt(" #n ")" ::: "memory")
#define PG8_WAIT_L(n) asm volatile("s_waitcnt lgkmcnt(" #n ")" ::: "memory")
#define PG8_BAR __builtin_amdgcn_s_barrier()
#define PG8_SCHED __builtin_amdgcn_sched_barrier(0)
    Unit cur, nxt; int ui = 0;
    if (!S.next(0, cur)) return;
    f32x4 acc[2][2][4][2];
#pragma unroll
    for (int a = 0; a < 2; ++a)
#pragma unroll
        for (int b = 0; b < 2; ++b)
#pragma unroll
            for (int m = 0; m < 4; ++m)
#pragma unroll
                for (int n = 0; n < 2; ++n) acc[a][b][m][n] = (f32x4){0.f, 0.f, 0.f, 0.f};
    bf16x8 At[4][2], B0[2][2], B1[2][2];
    const char* cA = (const char*)g.A + (size_t)cur.pm * tstepA; const char* cB = (const char*)g.Bt + (size_t)cur.pn * tstepB;
    S.a_ready(cur);
    if constexpr (SP2) {
        PG8_STAGE(PG8_SB(0, 0), cB, voffB); PG8_STAGE(PG8_SB(0, 1), cB + hstepB, voffB); PG8_STAGE(PG8_SA(0, 0), cA, voffA); PG8_STAGE(PG8_SA(0, 1), cA + hstepA, voffA);
        if (wr == 1) PG8_BAR;
        PG8_WAIT_V(2); PG8_BAR;
        PG8_STAGE(PG8_SB(1, 0), cB + kstep, voffB); PG8_STAGE(PG8_SA(1, 0), cA + kstep, voffA); PG8_STAGE(PG8_SB(1, 1), cB + hstepB + kstep, voffB);
        PG8_WAIT_V(6); PG8_BAR;
    } else {
        PG8_STAGE(PG8_SB(0, 0), cB, voffB); PG8_STAGE(PG8_SA(0, 0), cA, voffA); PG8_STAGE(PG8_SB(0, 1), cB + hstepB, voffB); PG8_STAGE(PG8_SA(0, 1), cA + hstepA, voffA);
        if (wr == 1) PG8_BAR;
        PG8_WAIT_V(4); PG8_BAR;
        PG8_STAGE(PG8_SB(1, 0), cB + kstep, voffB); PG8_STAGE(PG8_SA(1, 0), cA + kstep, voffA); PG8_STAGE(PG8_SB(1, 1), cB + hstepB + kstep, voffB);
        PG8_WAIT_V(6); PG8_BAR;
    }
    for (;;) {
        const bool has_next = S.next(ui + 1, nxt);
        const char* nA = has_next ? (const char*)g.A + (size_t)nxt.pm * tstepA : cA; const char* nB = has_next ? (const char*)g.Bt + (size_t)nxt.pn * tstepB : cB;
#pragma unroll 1
        for (int t = 0; t < nt; t += 2) {
            const bool last = (t == nt - 2);
            const char* a1 = cA + (size_t)(t + 1) * kstep;
            const char* a2 = last ? nA : cA + (size_t)(t + 2) * kstep; const char* b2 = last ? nB : cB + (size_t)(t + 2) * kstep;
            const char* a3 = a2 + kstep; const char* b3 = b2 + kstep;
            if (last && has_next) S.a_ready(nxt);
            if constexpr (SP2) {
            PG8_LDB(B0, 0, 0); PG8_LDB(B1, 0, 1); PG8_SCHED; PG8_LDA(At, 0, 0); PG8_STAGE(PG8_SA(1, 1), a1 + hstepA, voffA);
            PG8_WAIT_V(8); PG8_WAIT_L(0); PG8_BAR; PG8_MMA(0, 0, At, B0); PG8_MMA(0, 1, At, B1); PG8_BAR; PG8_SCHED;
            PG8_LDA(At, 0, 1); PG8_STAGE(PG8_SB(0, 0), b2, voffB); PG8_STAGE(PG8_SB(0, 1), b2 + hstepB, voffB); PG8_STAGE(PG8_SA(0, 0), a2, voffA);
            PG8_WAIT_V(8); PG8_WAIT_L(0); PG8_BAR; PG8_MMA(1, 0, At, B0); PG8_MMA(1, 1, At, B1); PG8_BAR; PG8_SCHED;
            PG8_LDB(B0, 1, 0); PG8_LDB(B1, 1, 1); PG8_SCHED; PG8_LDA(At, 1, 0); PG8_STAGE(PG8_SA(0, 1), a2 + hstepA, voffA);
            PG8_WAIT_V(8); PG8_WAIT_L(0); PG8_BAR; PG8_MMA(0, 0, At, B0); PG8_MMA(0, 1, At, B1); PG8_BAR; PG8_SCHED;
            PG8_LDA(At, 1, 1); PG8_STAGE(PG8_SB(1, 0), b3, voffB); PG8_STAGE(PG8_SB(1, 1), b3 + hstepB, voffB); PG8_STAGE(PG8_SA(1, 0), a3, voffA);
            PG8_WAIT_V(8); PG8_WAIT_L(0); PG8_BAR; PG8_MMA(1, 0, At, B0); PG8_MMA(1, 1, At, B1); PG8_BAR; PG8_SCHED;
            } else {
            PG8_LDB(B0, 0, 0); PG8_SCHED; PG8_LDA(At, 0, 0); PG8_STAGE(PG8_SA(1, 1), a1 + hstepA, voffA);
            PG8_WAIT_L(8); PG8_BAR; PG8_WAIT_L(0); PG8_MMA(0, 0, At, B0); PG8_BAR; PG8_SCHED;
            PG8_LDB(B1, 0, 1); PG8_STAGE(PG8_SB(0, 0), b2, voffB);
            PG8_BAR; PG8_WAIT_L(0); PG8_MMA(0, 1, At, B1); PG8_BAR;
            PG8_LDA(At, 0, 1); PG8_STAGE(PG8_SA(0, 0), a2, voffA);
            PG8_BAR; PG8_WAIT_L(0); PG8_MMA(1, 0, At, B0); PG8_BAR; PG8_SCHED;
            PG8_STAGE(PG8_SB(0, 1), b2 + hstepB, voffB);
            PG8_WAIT_V(6); PG8_BAR; PG8_MMA(1, 1, At, B1); PG8_BAR;
            PG8_LDB(B0, 1, 0); PG8_SCHED; PG8_LDA(At, 1, 0); PG8_STAGE(PG8_SA(0, 1), a2 + hstepA, voffA);
            PG8_WAIT_L(8); PG8_BAR; PG8_WAIT_L(0); PG8_MMA(0, 0, At, B0); PG8_BAR; PG8_SCHED;
            PG8_LDB(B1, 1, 1); PG8_STAGE(PG8_SB(1, 0), b3, voffB);
            PG8_BAR; PG8_WAIT_L(0); PG8_MMA(0, 1, At, B1); PG8_BAR;
            PG8_LDA(At, 1, 1); PG8_STAGE(PG8_SA(1, 0), a3, voffA);
            PG8_BAR; PG8_WAIT_L(0); PG8_MMA(1, 0, At, B0); PG8_BAR; PG8_SCHED;
            PG8_STAGE(PG8_SB(1, 1), b3 + hstepB, voffB);
            PG8_WAIT_V(6); PG8_BAR; PG8_MMA(1, 1, At, B1); PG8_BAR;
            }
        }
        if constexpr (ALIGN_EPI) { if (wr == 0) PG8_BAR; }
        if constexpr (!Epi::AFTER_DRAIN) { E(acc, cur, wr, wc, fr, fq); S.done(cur); }
        if (!has_next) break;
#pragma unroll
        for (int a = 0; a < 2; ++a)
#pragma unroll
            for (int b = 0; b < 2; ++b)
#pragma unroll
                for (int m = 0; m < 4; ++m)
#pragma unroll
                    for (int n = 0; n < 2; ++n) acc[a][b][m][n] = (f32x4){0.f, 0.f, 0.f, 0.f};
        cur = nxt; cA = nA; cB = nB; ++ui;
        if constexpr (ALIGN_EPI) { if (wr == 1) PG8_BAR; }
    }
    PG8_WAIT_V(0);
    if constexpr (!ALIGN_EPI) { if (wr == 0) PG8_BAR; }
    PG8_BAR;
    if constexpr (Epi::AFTER_DRAIN) { E.fused(acc, cur, wr, wc, fr, fq, lds, wid, lane); S.done(cur); }
#undef PG8_SA
#undef PG8_SB
#undef PG8_STAGE
#undef PG8_LDA
#undef PG8_LDB
#undef PG8_MMA
#undef PG8_WAIT_V
#undef PG8_WAIT_L
#undef PG8_BAR
#undef PG8_SCHED
}
}
#ifndef PG8_SP2
#define PG8_SP2 true
#endif
#ifndef PG8_ALIGN
#define PG8_ALIGN true
#endif

constexpr int NWAVES = 8;
constexpr int RING_OFF = 0, RING_BYTES = 131072;
constexpr int LDSCTL_OFF = RING_BYTES, MISC_OFF = LDSCTL_OFF + 320;
constexpr int LDS_BYTES = 147456;
constexpr int CW_BAR = 4096;
constexpr size_t CTL_ZERO_BYTES = 64 * 1024;

constexpr size_t WO_WIN = WS_W;
constexpr size_t WO_WUQ = WO_WIN + (size_t)2560 * 1024 * 2;
constexpr size_t WO_WUKV = WO_WUQ + (size_t)768 * 384 * 2;
constexpr size_t WO_WO = WO_WUKV + (size_t)1024 * 256 * 2;
constexpr size_t WO_WXQ = WO_WO + (size_t)1024 * 1024 * 2;
constexpr size_t WO_WXKV = WO_WXQ + (size_t)1024 * 1024 * 2;
constexpr size_t WO_WXO = WO_WXKV + (size_t)2048 * 1024 * 2;
constexpr size_t WO_WPQ = WO_WXO + (size_t)1024 * 1024 * 2;
constexpr size_t WO_SK = WO_WPQ + (size_t)1024 * 1024 * 2;
constexpr size_t WO_END = WO_SK + (size_t)16 * 128 * 64 * 2;
static_assert(WO_END <= WS_UT, "weights region");
constexpr size_t PSS1_OFF = WS_RS;
constexpr size_t PSS4_OFF = PSS1_OFF + (size_t)12 * T_ * 4;
constexpr size_t PSS6_OFF = PSS4_OFF + (size_t)16 * T_ * 4;
static_assert(PSS6_OFF + (size_t)16 * T_ * 4 <= WS_RIDX, "pss region");

#define GAS __attribute__((address_space(1)))
#define LAS __attribute__((address_space(3)))
typedef unsigned v4u __attribute__((ext_vector_type(4)));
typedef float f32x4 __attribute__((ext_vector_type(4)));
typedef GAS unsigned gu32;
#define RLX_AGENT __ATOMIC_RELAXED, __HIP_MEMORY_SCOPE_AGENT
#define LDS_WAIT() asm volatile("s_waitcnt lgkmcnt(0)" ::: "memory")
#define VM_WAIT() asm volatile("s_waitcnt vmcnt(0)" ::: "memory")
__device__ __forceinline__ unsigned pk2(float lo, float hi) { return (unsigned)f2bf(lo) | ((unsigned)f2bf(hi) << 16); }

#define XB_TMO      128
#define XB_XCNT(j)  (256  + 64 * (j))
#define XB_XSUB(j)  (1280 + 64 * (j))
#define XB_XGEN(j)  (2304 + 64 * (j))
#define XB_TOP      3328
#define XB_TOPGEN   3392
#define XCD_BAR_WORDS 3456
#define XB_SPIN_CAP (1u << 18)
__device__ __forceinline__ unsigned xb_ld(unsigned* p)              { return __hip_atomic_load(p, __ATOMIC_RELAXED, __HIP_MEMORY_SCOPE_AGENT); }
__device__ __forceinline__ unsigned xb_add(unsigned* p, unsigned v) { return __hip_atomic_fetch_add(p, v, __ATOMIC_RELAXED, __HIP_MEMORY_SCOPE_AGENT); }
__device__ __forceinline__ unsigned xb_xcc_id() { return (unsigned)__builtin_amdgcn_s_getreg((3 << 11) | 20) & 0xFu; }
#define XB_SPIN(cond, bar) do { unsigned _sp = 0; while (cond) { __builtin_amdgcn_s_sleep(1); \
    if ((++_sp & 255u) == 0u) { if (xb_ld(&(bar)[XB_TMO])) break; if (_sp > XB_SPIN_CAP) { atomicAdd(&(bar)[XB_TMO], 1u); break; } } } } while (0)
struct XcdBarrier { unsigned* bar; unsigned x; volatile LAS unsigned* st; };
__device__ __forceinline__ XcdBarrier xcd_barrier_post(unsigned* bar, volatile LAS unsigned* st) {
    XcdBarrier b; b.bar = bar; b.x = xb_xcc_id(); b.st = st;
    if (threadIdx.x == 0) (void)xb_add(&bar[XB_XCNT(b.x)], 1u);
    return b;
}
__device__ __forceinline__ void xcd_barrier_complete(unsigned* bar, unsigned x, unsigned& nloc, unsigned& nx) {
    const unsigned G = gridDim.x * gridDim.y * gridDim.z;
    unsigned sum, cnt, mine, sp = 0u;
    for (;;) {
        sum = 0u; cnt = 0u; mine = 0u;
#pragma unroll
        for (unsigned j = 0; j < 16; ++j) { const unsigned c = xb_ld(&bar[XB_XCNT(j)]); sum += c; cnt += (c > 0u) ? 1u : 0u; mine = (j == x) ? c : mine; }
        if (sum == G) break;
        __builtin_amdgcn_s_sleep(1);
        if ((++sp & 255u) == 0u) { if (xb_ld(&bar[XB_TMO])) break; if (sp > XB_SPIN_CAP) { atomicAdd(&bar[XB_TMO], 1u); break; } }
    }
    nloc = mine > 0u ? mine : 1u; nx = cnt > 0u ? cnt : 1u;
}
__device__ __forceinline__ void xcd_barrier(const XcdBarrier& b) {
    asm volatile("s_waitcnt vmcnt(0)" ::: "memory");
    __syncthreads();
    if (threadIdx.x == 0) {
        unsigned* bar = b.bar;
        __builtin_amdgcn_s_waitcnt(0);
        unsigned nloc = b.st[0], nx = b.st[1];
        if (nloc == 0u) { xcd_barrier_complete(bar, b.x, nloc, nx); b.st[0] = nloc; b.st[1] = nx; }
        const unsigned old = xb_add(&bar[XB_XSUB(b.x)], 1u);
        const unsigned gen = old / nloc;
        if (old + 1u == (gen + 1u) * nloc) {
            __builtin_amdgcn_fence(__ATOMIC_RELEASE, "agent");
            asm volatile("s_waitcnt vmcnt(0)" ::: "memory");
            const unsigned og = xb_add(&bar[XB_TOP], 1u);
            const unsigned tg = og / nx;
            if (og + 1u == (tg + 1u) * nx) xb_add(&bar[XB_TOPGEN], 1u);
            else XB_SPIN(xb_ld(&bar[XB_TOPGEN]) == tg, bar);
            __builtin_amdgcn_fence(__ATOMIC_ACQUIRE, "agent");
            xb_add(&bar[XB_XGEN(b.x)], 1u);
            asm volatile("s_waitcnt vmcnt(0)" ::: "memory");
        } else {
            XB_SPIN(xb_ld(&bar[XB_XGEN(b.x)]) == gen, bar);
            __builtin_amdgcn_fence(__ATOMIC_ACQUIRE, "agent");
            asm volatile("s_waitcnt vmcnt(0)" ::: "memory");
        }
    }
    __syncthreads();
}

struct Args { const void* in[23]; float* out; unsigned char* ws; int ph_lo, ph_hi, bar_region, pad; };

struct Frame {
    LAS unsigned char* lds; int tid, lane, wave, G, gw, NGW;
    unsigned char* ws;
};

__device__ __forceinline__ int colmap(int which, int n) {
    if (which == 0) {
        if (n < 384) return n; if (n < 512) return -1; if (n < 768) return 384 + (n - 512); if (n < 800) return 640 + (n - 768); if (n < 1024) return -1; return 672 + (n - 1024);
    } else if (which == 1) {
        const int h = n / 96, p = n % 96; if (p < 64) return h * 96 + p; const int j = p - 64, i = j >> 1; return h * 96 + 64 + ((j & 1) ? 16 + i : i);
    } else if (which == 2) {
        if (n < 512) return (n >> 6) * 128 + (n & 63); const int q = n - 512; return (q >> 6) * 128 + 64 + (q & 63);
    }
    return n;
}
__device__ __forceinline__ void p0_transpose_item(const float* W, int ldw, const float* gk, int which, bf16_t* WT, int K, int Nd, LAS float* scr, int item, int lane) {
    const int nblk = Nd / 32, kb = item / nblk, nb = item % nblk, k0 = 64 * kb, n0 = 32 * nb;
    const int sc = colmap(which, n0 + (lane & 31));
    float tv[32], tg[32];
#pragma unroll
    for (int i = 0; i < 32; ++i) { const int kk = 2 * i + (lane >> 5); tv[i] = (sc >= 0) ? W[(size_t)(k0 + kk) * ldw + sc] : 0.f; tg[i] = gk ? gk[k0 + kk] : 1.f; }
#pragma unroll
    for (int i = 0; i < 32; ++i) { const int kk = 2 * i + (lane >> 5); scr[kk * 33 + (lane & 31)] = tv[i] * tg[i]; }
    LDS_WAIT(); asm volatile("" ::: "memory");
    const int c = lane & 7;
#pragma unroll
    for (int j = 0; j < 4; ++j) { const int n = (lane >> 3) + 8 * j; const LAS float* s = scr + (8 * c) * 33 + n;
        v4u o; o.x = pk2(s[0 * 33], s[1 * 33]); o.y = pk2(s[2 * 33], s[3 * 33]); o.z = pk2(s[4 * 33], s[5 * 33]); o.w = pk2(s[6 * 33], s[7 * 33]);
        *(GAS v4u*)(WT + (size_t)(n0 + n) * K + k0 + 8 * c) = o; }
    LDS_WAIT(); asm volatile("" ::: "memory");
}
__device__ __forceinline__ float wsum(float v) {
#pragma unroll
    for (int o = 1; o < 64; o <<= 1) v += __shfl_xor(v, o);
    return v;
}
__device__ __forceinline__ void rms_row_to_bf16(const float* xrow, const float* g, bf16_t* orow, int lane) {
    const GAS f32x4* xr = (const GAS f32x4*)xrow + lane; const GAS f32x4* gr = (const GAS f32x4*)g + lane;
    f32x4 v[4]; float s = 0.f;
#pragma unroll
    for (int j = 0; j < 4; ++j) { v[j] = xr[64 * j]; s += (v[j].x * v[j].x + v[j].y * v[j].y) + (v[j].z * v[j].z + v[j].w * v[j].w); }
    const float rstd = rsqrtf(wsum(s) * (1.f / 1024.f) + EPS_);
    GAS unsigned long long* o8 = (GAS unsigned long long*)orow + lane;
#pragma unroll
    for (int j = 0; j < 4; ++j) { const f32x4 gg = gr[64 * j]; o8[64 * j] = (unsigned long long)pk2(v[j].x * rstd * gg.x, v[j].y * rstd * gg.y) | ((unsigned long long)pk2(v[j].z * rstd * gg.z, v[j].w * rstd * gg.w) << 32); }
}

__device__ __forceinline__ void p0_prologue(Frame& F, const Args& a) {
    LAS float* scr = (LAS float*)(F.lds + RING_OFF + F.wave * 16384);
    unsigned char* ws = F.ws;
#pragma unroll 1
    for (int pass = 0; pass < 2; ++pass) {
    if (((F.wave & 1) == 0) == (pass == 0)) {
    constexpr int I_IN = 16 * 80, I_UQ = 6 * 24, I_UKV = 4 * 32, I_SQ = 16 * 32, I_XKV = 16 * 64;
    constexpr int NITEMS = I_IN + I_UQ + I_UKV + 4 * I_SQ + I_XKV;
    for (int it = F.gw; it < NITEMS; it += F.NGW) {
        int r = it;
        if (r < I_IN) { p0_transpose_item((const float*)a.in[4], 2208, nullptr, 0, (bf16_t*)(ws + WO_WIN), 1024, 2560, scr, r, F.lane); continue; } r -= I_IN;
        if (r < I_UQ) { p0_transpose_item((const float*)a.in[6], 768, (const float*)a.in[5], 1, (bf16_t*)(ws + WO_WUQ), 384, 768, scr, r, F.lane); continue; } r -= I_UQ;
        if (r < I_UKV) { p0_transpose_item((const float*)a.in[8], 1024, (const float*)a.in[7], 2, (bf16_t*)(ws + WO_WUKV), 256, 1024, scr, r, F.lane); continue; } r -= I_UKV;
        if (r < I_SQ) { p0_transpose_item((const float*)a.in[11], 1024, (const float*)a.in[10], 3, (bf16_t*)(ws + WO_WO), 1024, 1024, scr, r, F.lane); continue; } r -= I_SQ;
        if (r < I_SQ) { p0_transpose_item((const float*)a.in[14], 1024, (const float*)a.in[12], 3, (bf16_t*)(ws + WO_WXQ), 1024, 1024, scr, r, F.lane); continue; } r -= I_SQ;
        if (r < I_XKV) { p0_transpose_item((const float*)a.in[15], 2048, nullptr, 3, (bf16_t*)(ws + WO_WXKV), 1024, 2048, scr, r, F.lane); continue; } r -= I_XKV;
        if (r < I_SQ) { p0_transpose_item((const float*)a.in[16], 1024, nullptr, 3, (bf16_t*)(ws + WO_WXO), 1024, 1024, scr, r, F.lane); continue; } r -= I_SQ;
        p0_transpose_item((const float*)a.in[18], 1024, (const float*)a.in[17], 3, (bf16_t*)(ws + WO_WPQ), 1024, 1024, scr, r, F.lane);
    }
    const int mpw = (T_ + TM_ + F.NGW - 1) / F.NGW;
    for (int m = F.gw * mpw; m < (F.gw + 1) * mpw && m < T_ + TM_; ++m) {
        if (m < T_) rms_row_to_bf16((const float*)a.in[0] + (size_t)m * 1024, (const float*)a.in[3], (bf16_t*)(ws + WS_RA) + (size_t)m * 1024, F.lane);
        else rms_row_to_bf16((const float*)a.in[1] + (size_t)(m - T_) * 1024, (const float*)a.in[13], (bf16_t*)(ws + WS_MEMN) + (size_t)(m - T_) * 1024, F.lane);
    }
    } else {
    { const float* U = (const float*)a.in[20]; const float* V = (const float*)a.in[21]; const float* gf = (const float*)a.in[17];
      unsigned char* UT8 = ws + WS_UT; unsigned char* VT8 = ws + WS_VT; float* SU = (float*)(ws + WS_SCL); float* SV = SU + 16384;
      f32x4 g4[4];
#pragma unroll
      for (int q = 0; q < 4; ++q) g4[q] = *(const f32x4*)(gf + q * 256 + F.lane * 4);
      const int rpw = (2 * 16384 + F.NGW - 1) / F.NGW;
      for (int r = F.gw * rpw; r < (F.gw + 1) * rpw && r < 2 * 16384; ++r) {
          const bool isu = r < 16384; const int e = isu ? r : r - 16384;
          const float* src = (isu ? U : V) + (size_t)e * 1024 + F.lane * 4;
          f32x4 v[4]; float am = 0.f;
#pragma unroll
          for (int q = 0; q < 4; ++q) { v[q] = *(const f32x4*)(src + q * 256); if (isu) v[q] = v[q] * g4[q];
              am = fmaxf(am, fmaxf(fmaxf(fabsf(v[q].x), fabsf(v[q].y)), fmaxf(fabsf(v[q].z), fabsf(v[q].w)))); }
#pragma unroll
          for (int o = 1; o < 64; o <<= 1) am = fmaxf(am, __shfl_xor(am, o));
          const float sc = am > 0.f ? am * (1.f / 6.f) : 1.f, inv = 1.f / sc;
          unsigned short* dst = (unsigned short*)((isu ? UT8 : VT8) + (size_t)e * 512) + F.lane;
#pragma unroll
          for (int q = 0; q < 4; ++q) { unsigned w_ = 0; w_ = __builtin_amdgcn_cvt_scalef32_pk_fp4_f32(w_, v[q].x * inv, v[q].y * inv, 1.0f, 0); w_ = __builtin_amdgcn_cvt_scalef32_pk_fp4_f32(w_, v[q].z * inv, v[q].w * inv, 1.0f, 1);
              dst[q * 64] = (unsigned short)(w_ & 0xffffu); }
          if (F.lane == 0) (isu ? SU : SV)[e] = sc;
      } }
    }
    }
    { const float* SKf = (const float*)a.in[19]; bf16_t* SKb = (bf16_t*)(ws + WO_SK);
      for (int i = F.gw * 64 + F.lane; i < 16 * 128 * 64 / 2; i += F.NGW * 64) ((unsigned*)SKb)[i] = pk2(SKf[2 * i], SKf[2 * i + 1]); }
    { const int* pos = (const int*)a.in[2]; float* COS = (float*)(ws + WS_COS); float* SIN = (float*)(ws + WS_SIN);
      for (int i = F.gw * 64 + F.lane; i < T_ * 16; i += F.NGW * 64) { const int t = i >> 4, f = i & 15; const float inv = powf(10000.f, -(float)(2 * f) / 32.f); const float ang = (float)pos[t] * inv; COS[i] = cosf(ang); SIN[i] = sinf(ang); } }
}

__device__ __forceinline__ void p2_conv_job(Frame& F, const Args& a) {
    const bf16_t* PROJ = (const bf16_t*)(F.ws + WS_RB); bf16_t* Y = (bf16_t*)(F.ws + WS_RA); bf16_t* Kb = (bf16_t*)a.out + (size_t)T_ * 768;
    const float* cw = (const float*)a.in[9]; const float* COS = (const float*)(F.ws + WS_COS); const float* SIN = (const float*)(F.ws + WS_SIN);
    int lane = __builtin_amdgcn_mbcnt_hi(~0u, __builtin_amdgcn_mbcnt_lo(~0u, 0u)); asm volatile("" : "+v"(lane));
    const int ch0 = lane * 8;
    f32x4 w0[3], w1[3];
#pragma unroll
    for (int k = 0; k < 3; ++k) { w0[k] = *(const f32x4*)(cw + k * 512 + ch0); w1[k] = *(const f32x4*)(cw + k * 512 + ch0 + 4); }
    for (int t = F.gw; t < T_; t += F.NGW) {
        const int s = t & (S_ - 1);
        const bf16_t* p = PROJ + (size_t)t * PJ;
        const v4u gb = *(const v4u*)(p + 1024 + ch0);
        f32x4 z0 = (f32x4){0.f, 0.f, 0.f, 0.f}, z1 = z0;
#pragma unroll
        for (int k = 0; k < 3; ++k) { const int dt = 2 - k;
            if (s - dt >= 0) { const bf16_t* q = p - (size_t)dt * PJ; const v4u gc = *(const v4u*)(q + 1536 + ch0), hx = *(const v4u*)(q + 2048 + ch0);
                z0 += w0[k] * (f32x4){pg8::bflo(gc.x) * pg8::bflo(hx.x), pg8::bfhi(gc.x) * pg8::bfhi(hx.x), pg8::bflo(gc.y) * pg8::bflo(hx.y), pg8::bfhi(gc.y) * pg8::bfhi(hx.y)};
                z1 += w1[k] * (f32x4){pg8::bflo(gc.z) * pg8::bflo(hx.z), pg8::bfhi(gc.z) * pg8::bfhi(hx.z), pg8::bflo(gc.w) * pg8::bflo(hx.w), pg8::bfhi(gc.w) * pg8::bfhi(hx.w)}; } }
        const f32x4 y0 = z0 * (f32x4){pg8::bflo(gb.x), pg8::bfhi(gb.x), pg8::bflo(gb.y), pg8::bfhi(gb.y)}, y1 = z1 * (f32x4){pg8::bflo(gb.z), pg8::bfhi(gb.z), pg8::bflo(gb.w), pg8::bfhi(gb.w)};
        float ss = (y0[0] * y0[0] + y0[1] * y0[1]) + (y0[2] * y0[2] + y0[3] * y0[3]) + (y1[0] * y1[0] + y1[1] * y1[1]) + (y1[2] * y1[2] + y1[3] * y1[3]);
        ss += __shfl_xor(ss, 1); ss += __shfl_xor(ss, 2); ss += __shfl_xor(ss, 4);
        const float r = rsqrtf(ss * (1.f / 64.f) + EPS_);
        v4u o; o.x = pk2(y0[0] * r, y0[1] * r); o.y = pk2(y0[2] * r, y0[3] * r); o.z = pk2(y1[0] * r, y1[1] * r); o.w = pk2(y1[2] * r, y1[3] * r);
        *(v4u*)(Y + (size_t)t * 1024 + 512 + ch0) = o;
        if (lane < 16) { const float c = COS[t * 16 + lane], sn = SIN[t * 16 + lane]; const float t1 = bf2f(p[768 + lane]), t2 = bf2f(p[768 + 16 + lane]);
            const unsigned w = pk2(t1 * c - t2 * sn, t2 * c + t1 * sn);
#pragma unroll
            for (int h = 0; h < 8; ++h) *(unsigned*)(Kb + (size_t)t * 768 + h * 96 + 64 + 2 * lane) = w; }
    }
}

typedef __bf16 bf16x2_t __attribute__((ext_vector_type(2)));
typedef float f32x2 __attribute__((ext_vector_type(2)));
__device__ __forceinline__ float dot2bf(unsigned a, unsigned b, float c) { return __builtin_amdgcn_fdot2_f32_bf16(__builtin_bit_cast(bf16x2_t, a), __builtin_bit_cast(bf16x2_t, b), c, false); }
template <int CTRL> __device__ __forceinline__ float dppf(float x) { return __builtin_bit_cast(float, __builtin_amdgcn_mov_dpp(__builtin_bit_cast(int, x), CTRL, 0xf, 0xf, true)); }
__device__ __forceinline__ float gelu_fast(float x) {
    const float u = 0.7978845608028654f * (x + 0.044715f * x * x * x);
    return x / (1.f + __expf(-2.f * u));
}
__device__ __forceinline__ float reduce32(float (&p)[32], int lane) {
#pragma unroll
    for (int j = 0; j < 16; ++j) { auto r = __builtin_amdgcn_permlane32_swap(__float_as_uint(p[j]), __float_as_uint(p[j + 16]), false, false); p[j] = __uint_as_float(r[0]) + __uint_as_float(r[1]); }
#pragma unroll
    for (int j = 0; j < 8; ++j) { auto r = __builtin_amdgcn_permlane16_swap(__float_as_uint(p[j]), __float_as_uint(p[j + 8]), false, false); p[j] = __uint_as_float(r[0]) + __uint_as_float(r[1]); }
    const bool b3 = (lane & 8) != 0, b2 = (lane & 4) != 0, b1 = (lane & 2) != 0;
#pragma unroll
    for (int j = 0; j < 4; ++j) { const float keep = b3 ? p[j + 4] : p[j], send = b3 ? p[j] : p[j + 4]; p[j] = keep + dppf<0x128>(send); }
#pragma unroll
    for (int j = 0; j < 2; ++j) { const float keep = b2 ? p[j + 2] : p[j], send = b2 ? p[j] : p[j + 2]; p[j] = keep + dppf<0x141>(send); }
    { const float keep = b1 ? p[1] : p[0], send = b1 ? p[0] : p[1]; p[0] = keep + dppf<0x4E>(send); }
    return p[0] + dppf<0xB1>(p[0]);
}
__device__ __forceinline__ f32x2 fp8lo(unsigned w) { return __builtin_amdgcn_cvt_pk_f32_fp8((int)w, false); }
__device__ __forceinline__ f32x2 fp8hi(unsigned w) { return __builtin_amdgcn_cvt_pk_f32_fp8((int)w, true); }
__device__ __forceinline__ float dot16(const v4u w, const f32x2 (&x)[8]) {
    f32x2 s = fp8lo(w.x) * x[0]; s += fp8hi(w.x) * x[1]; s += fp8lo(w.y) * x[2]; s += fp8hi(w.y) * x[3];
    s += fp8lo(w.z) * x[4]; s += fp8hi(w.z) * x[5]; s += fp8lo(w.w) * x[6]; s += fp8hi(w.w) * x[7];
    return s.x + s.y;
}
__device__ __forceinline__ void axpy16(f32x2 (&acc)[8], float as, const v4u w) {
    const f32x2 a2 = (f32x2){as, as};
    acc[0] += a2 * fp8lo(w.x); acc[1] += a2 * fp8hi(w.x); acc[2] += a2 * fp8lo(w.y); acc[3] += a2 * fp8hi(w.y);
    acc[4] += a2 * fp8lo(w.z); acc[5] += a2 * fp8hi(w.z); acc[6] += a2 * fp8lo(w.w); acc[7] += a2 * fp8hi(w.w);
}
constexpr size_t WS_RSTD2 = 105 * MiB + 512 * 1024;
constexpr size_t WS_ACT = 40 * MiB;
template <int CTRL> __device__ __forceinline__ int dppi(int x) { return __builtin_amdgcn_mov_dpp(x, CTRL, 0xf, 0xf, true); }
__device__ __forceinline__ int reduce32i(int (&p)[32], int lane) {
#pragma unroll
    for (int j = 0; j < 16; ++j) { auto r = __builtin_amdgcn_permlane32_swap((unsigned)p[j], (unsigned)p[j + 16], false, false); p[j] = (int)(r[0] + r[1]); }
#pragma unroll
    for (int j = 0; j < 8; ++j) { auto r = __builtin_amdgcn_permlane16_swap((unsigned)p[j], (unsigned)p[j + 8], false, false); p[j] = (int)(r[0] + r[1]); }
    const bool b3 = (lane & 8) != 0, b2 = (lane & 4) != 0, b1 = (lane & 2) != 0;
#pragma unroll
    for (int j = 0; j < 4; ++j) { const int keep = b3 ? p[j + 4] : p[j], send = b3 ? p[j] : p[j + 4]; p[j] = keep + dppi<0x128>(send); }
#pragma unroll
    for (int j = 0; j < 2; ++j) { const int keep = b2 ? p[j + 2] : p[j], send = b2 ? p[j] : p[j + 2]; p[j] = keep + dppi<0x141>(send); }
    { const int keep = b1 ? p[1] : p[0], send = b1 ? p[0] : p[1]; p[0] = keep + dppi<0x4E>(send); }
    return p[0] + dppi<0xB1>(p[0]);
}
__device__ __forceinline__ int dot16i(const v4u w, const v4u x) {
    return __builtin_amdgcn_sdot4((int)w.w, (int)x.w, __builtin_amdgcn_sdot4((int)w.z, (int)x.z, __builtin_amdgcn_sdot4((int)w.y, (int)x.y, __builtin_amdgcn_sdot4((int)w.x, (int)x.x, 0, false), false), false), false);
}
__device__ __forceinline__ float reduce16h(float (&p)[16], int lane) {
#pragma unroll
    for (int j = 0; j < 8; ++j) { auto r = __builtin_amdgcn_permlane16_swap(__float_as_uint(p[j]), __float_as_uint(p[j + 8]), false, false); p[j] = __uint_as_float(r[0]) + __uint_as_float(r[1]); }
    const bool b3 = (lane & 8) != 0, b2 = (lane & 4) != 0, b1 = (lane & 2) != 0;
#pragma unroll
    for (int j = 0; j < 4; ++j) { const float keep = b3 ? p[j + 4] : p[j], send = b3 ? p[j] : p[j + 4]; p[j] = keep + dppf<0x128>(send); }
#pragma unroll
    for (int j = 0; j < 2; ++j) { const float keep = b2 ? p[j + 2] : p[j], send = b2 ? p[j] : p[j + 2]; p[j] = keep + dppf<0x141>(send); }
    { const float keep = b1 ? p[1] : p[0], send = b1 ? p[0] : p[1]; p[0] = keep + dppf<0x4E>(send); }
    return p[0] + dppf<0xB1>(p[0]);
}
typedef int v8i_t __attribute__((ext_vector_type(8)));
typedef float v4f_t __attribute__((ext_vector_type(4)));
__device__ __forceinline__ void p_peer_u(Frame& F, const Args& a) {
    const bf16_t* H2 = (const bf16_t*)(F.ws + WS_RA); const float* parts = (const float*)(F.ws + PSS6_OFF);
    const unsigned char* UT4 = F.ws + WS_UT; const float* SU = (const float*)(F.ws + WS_SCL); const float* SV = SU + 16384;
    float* ACT = (float*)(F.ws + WS_ACT); int* RI = (int*)(F.ws + WS_RIDX); const float* RG = (const float*)(F.ws + WS_RGATE);
    int lane = __builtin_amdgcn_mbcnt_hi(~0u, __builtin_amdgcn_mbcnt_lo(~0u, 0u)); asm volatile("" : "+v"(lane));
    LAS unsigned char* wb = F.lds + RING_OFF + F.wave * 17408;
    LAS int* fpl = (LAS int*)wb; LAS unsigned char* xw = wb + 512; LAS int* li = (LAS int*)(wb + 512 + 8192); LAS float* lg = (LAS float*)(wb + 512 + 8192 + 4096); LAS float* ls = (LAS float*)(wb + 512 + 8192 + 8192);
    const int xoff = 32 * ((lane & 7) + 8 * (lane >> 5)) + 16 * ((lane >> 4) & 1);
    const int coff = ((lane & 7) + 8 * (lane >> 4)) * 16; const int bsel = (lane & 8) ? 128 : 0;
    const int slot = 2 * ((lane >> 1) & 15) + (lane >> 5), sub = slot & 15; const bool second = slot >= 16;
    const bool dvalid = ((lane & 15) >> 2) == (lane >> 4), dr1 = (lane & 1) != 0, dr2 = (lane & 2) != 0;
#pragma unroll 1
    for (int base = F.gw; base < T_; base += 8 * F.NGW) {
      int i0a[8], i1a[8]; float g0a[8], g1a[8], spa[8]; v4u ha[8][2];
#pragma unroll
      for (int k = 0; k < 8; ++k) { const int t_ = base + k * F.NGW, tc = t_ < T_ ? t_ : base;
          i0a[k] = RI[(size_t)tc * 128 + lane]; i1a[k] = RI[(size_t)tc * 128 + 64 + lane]; g0a[k] = RG[(size_t)tc * 128 + lane]; g1a[k] = RG[(size_t)tc * 128 + 64 + lane];
          spa[k] = (lane < 16) ? parts[(size_t)lane * T_ + tc] : 0.f;
          ha[k][0] = *(const v4u*)(H2 + (size_t)tc * 1024 + lane * 16); ha[k][1] = *(const v4u*)(H2 + (size_t)tc * 1024 + lane * 16 + 8); }
#define PU_PRE(k) do { const int t = base + (k) * F.NGW; const bool tv = t < T_; \
          const int i0 = tv ? i0a[k] : 0, i1 = tv ? i1a[k] : 0; const float g0 = tv ? g0a[k] : 0.f, g1 = tv ? g1a[k] : 0.f; \
          int pos0 = -1, pos1 = -1, ov0 = 0, ov1 = 0, ovf = 0, fre = 0; \
          _Pragma("unroll") for (int q = 0; q < 8; ++q) { \
              const bool m0 = (i0 >> 11) == q, m1 = (i1 >> 11) == q; \
              const unsigned long long b0 = __ballot(m0), b1 = __ballot(m1); \
              const int c0 = __popcll(b0), c1 = __popcll(b1), nq = c0 + c1; \
              const int r0 = (int)__builtin_amdgcn_mbcnt_hi((unsigned)(b0 >> 32), __builtin_amdgcn_mbcnt_lo((unsigned)b0, 0u)); \
              const int r1 = c0 + (int)__builtin_amdgcn_mbcnt_hi((unsigned)(b1 >> 32), __builtin_amdgcn_mbcnt_lo((unsigned)b1, 0u)); \
              if (m0) { if (r0 < 16) pos0 = 16 * q + r0; else ov0 = ovf + (r0 - 16); } \
              if (m1) { if (r1 < 16) pos1 = 16 * q + r1; else ov1 = ovf + (r1 - 16); } \
              const int fq = nq < 16 ? 16 - nq : 0; \
              if (lane < fq) fpl[fre + lane] = 16 * q + nq + lane; \
              ovf += nq > 16 ? nq - 16 : 0; fre += fq; } \
          const float sp = wsum(spa[k]); \
          const v4u h = ha[k][0], g = ha[k][1]; \
          float am = fmaxf(fmaxf(fmaxf(fabsf(pg8::bflo(h.x)), fabsf(pg8::bfhi(h.x))), fmaxf(fabsf(pg8::bflo(h.y)), fabsf(pg8::bfhi(h.y)))), fmaxf(fmaxf(fabsf(pg8::bflo(h.z)), fabsf(pg8::bfhi(h.z))), fmaxf(fabsf(pg8::bflo(h.w)), fabsf(pg8::bfhi(h.w))))); \
          am = fmaxf(am, fmaxf(fmaxf(fmaxf(fabsf(pg8::bflo(g.x)), fabsf(pg8::bfhi(g.x))), fmaxf(fabsf(pg8::bflo(g.y)), fabsf(pg8::bfhi(g.y)))), fmaxf(fmaxf(fabsf(pg8::bflo(g.z)), fabsf(pg8::bfhi(g.z))), fmaxf(fabsf(pg8::bflo(g.w)), fabsf(pg8::bfhi(g.w)))))); \
          am = wave_max(am); \
          const float qs = am > 0.f ? 440.f / am : 0.f; v4u xq; \
          { int w = 0; w = __builtin_amdgcn_cvt_pk_fp8_f32(pg8::bflo(h.x) * qs, pg8::bfhi(h.x) * qs, w, false); w = __builtin_amdgcn_cvt_pk_fp8_f32(pg8::bflo(h.y) * qs, pg8::bfhi(h.y) * qs, w, true); xq.x = (unsigned)w; } \
          { int w = 0; w = __builtin_amdgcn_cvt_pk_fp8_f32(pg8::bflo(h.z) * qs, pg8::bfhi(h.z) * qs, w, false); w = __builtin_amdgcn_cvt_pk_fp8_f32(pg8::bflo(h.w) * qs, pg8::bfhi(h.w) * qs, w, true); xq.y = (unsigned)w; } \
          { int w = 0; w = __builtin_amdgcn_cvt_pk_fp8_f32(pg8::bflo(g.x) * qs, pg8::bfhi(g.x) * qs, w, false); w = __builtin_amdgcn_cvt_pk_fp8_f32(pg8::bflo(g.y) * qs, pg8::bfhi(g.y) * qs, w, true); xq.z = (unsigned)w; } \
          { int w = 0; w = __builtin_amdgcn_cvt_pk_fp8_f32(pg8::bflo(g.z) * qs, pg8::bfhi(g.z) * qs, w, false); w = __builtin_amdgcn_cvt_pk_fp8_f32(pg8::bflo(g.w) * qs, pg8::bfhi(g.w) * qs, w, true); xq.w = (unsigned)w; } \
          *(LAS v4u*)(xw + (k) * 1024 + lane * 16) = xq; \
          asm volatile("s_waitcnt lgkmcnt(0)" ::: "memory"); \
          if (pos0 < 0) pos0 = fpl[ov0]; \
          if (pos1 < 0) pos1 = fpl[ov1]; \
          asm volatile("s_waitcnt lgkmcnt(0)" ::: "memory"); \
          li[(k) * 128 + pos0] = i0; li[(k) * 128 + pos1] = i1; lg[(k) * 128 + pos0] = g0; lg[(k) * 128 + pos1] = g1; \
          if (tv) { RI[(size_t)t * 128 + pos0] = i0; RI[(size_t)t * 128 + pos1] = i1; } \
          if (lane == 0) ls[k] = rsqrtf(sp * (1.f / 1024.f) + EPS_) * (am * (1.f / 440.f)); } while (0)
#define PU_B(d, kk) do { const v4u q0_ = *(const LAS v4u*)(xw + (kk) * 1024 + xoff), q1_ = *(const LAS v4u*)(xw + (kk) * 1024 + xoff + 512); \
        d = (v8i_t){(int)q0_.x, (int)q0_.y, (int)q0_.z, (int)q0_.w, (int)q1_.x, (int)q1_.y, (int)q1_.z, (int)q1_.w}; } while (0)
#define PU_DIAG(D) ({ const float t01_ = dr1 ? (D).y : (D).x, t23_ = dr1 ? (D).w : (D).z; const float t_ = dr2 ? t23_ : t01_; dvalid ? t_ : 0.f; })
#define PU_MMA(m, B) do { const v8i_t a_ = (v8i_t){(int)bufs[m].x, (int)bufs[m].y, (int)bufs[m].z, (int)bufs[m].w, 0, 0, 0, 0}; const v4f_t z_ = (v4f_t){0.f, 0.f, 0.f, 0.f}; \
        const v4f_t d_ = __builtin_amdgcn_mfma_scale_f32_16x16x128_f8f6f4(a_, B, z_, 4, 0, 0, 0, 0, 0); p[m] = PU_DIAG(d_); } while (0)
#define PU_BA(pp, j) \
        const int kk_ = 2 * (j) + (second ? 1 : 0); const int tt = base + kk_ * F.NGW; \
        const int idxv = li[kk_ * 128 + (pp) * 16 + sub]; const float gatev = lg[kk_ * 128 + (pp) * 16 + sub]; const float rstd = ls[kk_]; \
        v4u bufs[16]; \
        _Pragma("unroll") for (int m = 0; m < 16; ++m) { const int e_ = __builtin_amdgcn_ds_bpermute(8 * m + bsel, idxv); bufs[m] = *(const v4u*)(UT4 + (size_t)e_ * 512 + coff); } \
        const float su = SU[idxv], sv = SV[idxv];
#define PU_BB(pp, j) do { \
        v8i_t BA, BB; PU_B(BA, 2 * (j)); PU_B(BB, 2 * (j) + 1); \
        float p[16]; \
        _Pragma("unroll") for (int m = 0; m < 8; ++m) PU_MMA(m, BA); \
        _Pragma("unroll") for (int m = 8; m < 16; ++m) PU_MMA(m, BB); \
        const float dt = reduce16h(p, lane); \
        if ((lane & 1) == 0 && tt < T_) ACT[(size_t)tt * 128 + (pp) * 16 + sub] = gelu_fast(dt * su * rstd) * gatev * sv; } while (0)
      PU_PRE(0); PU_PRE(1);
      { PU_BA(0, 0); PU_PRE(2); PU_PRE(3); PU_BB(0, 0); }
      { PU_BA(0, 1); PU_PRE(4); PU_PRE(5); PU_BB(0, 1); }
      { PU_BA(0, 2); PU_PRE(6); PU_PRE(7); PU_BB(0, 2); }
      { PU_BA(0, 3); PU_BB(0, 3); }
#pragma unroll 1
      for (int n = 4; n < 32; ++n) { const int pp = n >> 2, j = n & 3; PU_BA(pp, j); PU_BB(pp, j); }
#undef PU_PRE
#undef PU_B
#undef PU_DIAG
#undef PU_MMA
#undef PU_BA
#undef PU_BB
    }
}
typedef int v2i_t __attribute__((ext_vector_type(2)));
typedef unsigned v2u_t __attribute__((ext_vector_type(2)));
__device__ __forceinline__ void p_peer_v(Frame& F, const Args& a) {
    const bf16_t* H2 = (const bf16_t*)(F.ws + WS_RA); const unsigned char* VT4 = F.ws + WS_VT;
    const int* SE = (const int*)(F.ws + WS_RIDX); const float* ACT = (const float*)(F.ws + WS_ACT);
    const float* gfin = (const float*)a.in[22]; float* out = a.out;
    int lane = __builtin_amdgcn_mbcnt_hi(~0u, __builtin_amdgcn_mbcnt_lo(~0u, 0u)); asm volatile("" : "+v"(lane));
    const int lo = lane & 31; const bool up = lane >= 32; const int w = F.wave, wq = w & 3, g = lane >> 4;
    constexpr int PITCH = 520, SB = 128 * PITCH, A8_OFF = 2 * SB, SA_OFF = A8_OFF + 8192, TPITCH = 1040;
    static_assert(SA_OFF + 256 <= LDS_BYTES, "V phase LDS");
    LAS unsigned char* lds = F.lds;
    const int sub = lane & 15; const bool second = (lane & 16) != 0;
    LAS unsigned char* wptr = lds + (32 * (2 * (w >> 2) + (w & 1)) + 16 * ((w >> 1) & 1) + (up ? 8 : 0)) * PITCH + lo * 16;
    LAS unsigned char* rptr = lds + (64 * (g >> 1) + 16 * (g & 1) + (lane & 15)) * PITCH + 64 * w;
    const bool va0 = (lane & 15) == g, va1 = (lane & 15) == 4 + g, vb0 = (lane & 15) == 8 + g, vb1 = (lane & 15) == 12 + g;
#pragma unroll 1
    for (int k0 = 0; F.gw + k0 * F.NGW < T_; k0 += 8) {
        __syncthreads();
#pragma unroll 1
        for (int k = 0; k < 8; ++k) { const int t = F.gw + (k0 + k) * F.NGW; const bool tv = t < T_; const int tc = tv ? t : F.gw;
            int lane = __builtin_amdgcn_mbcnt_hi(~0u, __builtin_amdgcn_mbcnt_lo(~0u, 0u)); asm volatile("" : "+v"(lane));
            const float a0 = tv ? ACT[(size_t)tc * 128 + lane] : 0.f, a1 = tv ? ACT[(size_t)tc * 128 + 64 + lane] : 0.f;
            const float am = wave_max(fmaxf(fabsf(a0), fabsf(a1))); const float qs = am > 0.f ? 240.f / am : 0.f;
            const int pk = __builtin_amdgcn_cvt_pk_fp8_f32(a0 * qs, a1 * qs, 0, false);
            LAS unsigned char* d8 = lds + A8_OFF + (w * 8 + k) * 128;
            d8[lane] = (unsigned char)(pk & 0xff); d8[64 + lane] = (unsigned char)((pk >> 8) & 0xff);
            if (lane == 0) ((LAS float*)(lds + SA_OFF))[w * 8 + k] = am * (1.f / 240.f); }
#define PV_IDX(r_) ({ int il_ = __builtin_amdgcn_mbcnt_hi(~0u, __builtin_amdgcn_mbcnt_lo(~0u, 0u)); asm volatile("" : "+v"(il_)); \
        const int rr_ = (r_) < 32 ? (r_) : 31; const int t_ = F.gw + (k0 + 2 * (sg0 + ((rr_ >> 1) & 1)) + (rr_ & 1)) * F.NGW; const int tc_ = t_ < T_ ? t_ : F.gw; SE[(size_t)tc_ * 128 + (rr_ >> 2) * 16 + (il_ & 15)]; })
#define PV_ROWS(BUF, IDX) do { _Pragma("unroll") for (int i = 0; i < 8; ++i) { const int e_ = __builtin_amdgcn_ds_bpermute(4 * (i + (up ? 8 : 0)), IDX); BUF[i] = *(const v4u*)(VT4 + (size_t)e_ * 512 + lo * 16); } } while (0)
#define PV_ROUND(ACC, BUF, rr_, c_) do { const int r_ = (rr_); if (r_ < 32) { const int p_ = r_ >> 2; constexpr int stg_ = (c_) & 1, hh_ = (c_) & 1; const int sg_ = sg0 + ((c_) >> 1); \
            _Pragma("unroll") for (int i = 0; i < 8; ++i) { *(LAS v2u_t*)(wptr + stg_ * SB + i * PITCH) = (v2u_t){BUF[i].x, BUF[i].y}; *(LAS v2u_t*)(wptr + stg_ * SB + i * PITCH + 8) = (v2u_t){BUF[i].z, BUF[i].w}; } \
            if (r_ + 3 < 32) { const int idc_ = idx1; PV_ROWS(BUF, idc_); } \
            idx1 = idx2; idx2 = PV_IDX(r_ + 5); \
            asm volatile("s_waitcnt lgkmcnt(0)" ::: "memory"); __builtin_amdgcn_s_barrier(); \
            { const v4u q1_ = *(const LAS v4u*)(lds + A8_OFF + (g * 8 + 2 * sg_ + hh_) * 128 + p_ * 16); \
              const v4u q2_ = *(const LAS v4u*)(lds + A8_OFF + ((4 + g) * 8 + 2 * sg_ + hh_) * 128 + p_ * 16); \
              const bool s1_ = hh_ ? vb0 : va0, s2_ = hh_ ? vb1 : va1; \
              const v8i_t A_ = (v8i_t){s1_ ? (int)q1_.x : 0, s1_ ? (int)q1_.y : 0, s1_ ? (int)q1_.z : 0, s1_ ? (int)q1_.w : 0, s2_ ? (int)q2_.x : 0, s2_ ? (int)q2_.y : 0, s2_ ? (int)q2_.z : 0, s2_ ? (int)q2_.w : 0}; \
              _Pragma("unroll") for (int n = 0; n < 8; ++n) { \
                  const v2i_t r0_ = __builtin_amdgcn_ds_read_tr4_b64_v2i32((LAS v2i_t*)(rptr + stg_ * SB + 8 * n)); \
                  const v2i_t r1_ = __builtin_amdgcn_ds_read_tr4_b64_v2i32((LAS v2i_t*)(rptr + stg_ * SB + 8 * n + 32 * PITCH)); \
                  const v8i_t B_ = (v8i_t){r0_.x, r0_.y, r1_.x, r1_.y, 0, 0, 0, 0}; \
                  ACC[n] = __builtin_amdgcn_mfma_scale_f32_16x16x128_f8f6f4(A_, B_, ACC[n], 0, 4, 0, 0, 0, 0); } } } } while (0)
#define PV_FINSET(ACC, sg_) do { \
            int fl_ = __builtin_amdgcn_mbcnt_hi(~0u, __builtin_amdgcn_mbcnt_lo(~0u, 0u)); asm volatile("" : "+v"(fl_)); const int fg_ = fl_ >> 4, fj_ = fl_ & 15;     \
            LAS float* tile_ = (LAS float*)(F.lds + ((sg_) & 1) * SB); const LAS float* sa_ = (const LAS float*)(F.lds + SA_OFF); \
            _Pragma("unroll") for (int r = 0; r < 4; ++r) { const int m_ = 4 * fg_ + r; const float sc_ = sa_[(m_ & 7) * 8 + 2 * (sg_) + (m_ >> 3)]; \
                _Pragma("unroll") for (int n = 0; n < 8; ++n) tile_[m_ * TPITCH + 128 * F.wave + 16 * n + fj_] = ACC[n][r] * sc_; } \
            __syncthreads(); \
            _Pragma("unroll 1") for (int kk = 0; kk < 2; ++kk) { const int t_ = F.gw + (k0 + 2 * (sg_) + kk) * F.NGW; \
                if (t_ < T_) { const LAS f32x4* row_ = (const LAS f32x4*)(tile_ + (8 * kk + F.wave) * TPITCH + fl_ * 16); \
                    const v4u h0 = *(const v4u*)(H2 + (size_t)t_ * 1024 + fl_ * 16), h1 = *(const v4u*)(H2 + (size_t)t_ * 1024 + fl_ * 16 + 8); \
                    f32x4 v0 = row_[0], v1 = row_[1], v2 = row_[2], v3 = row_[3]; \
                    v0 += (f32x4){pg8::bflo(h0.x), pg8::bfhi(h0.x), pg8::bflo(h0.y), pg8::bfhi(h0.y)}; v1 += (f32x4){pg8::bflo(h0.z), pg8::bfhi(h0.z), pg8::bflo(h0.w), pg8::bfhi(h0.w)}; \
                    v2 += (f32x4){pg8::bflo(h1.x), pg8::bfhi(h1.x), pg8::bflo(h1.y), pg8::bfhi(h1.y)}; v3 += (f32x4){pg8::bflo(h1.z), pg8::bfhi(h1.z), pg8::bflo(h1.w), pg8::bfhi(h1.w)}; \
                    float ss = (v0.x * v0.x + v0.y * v0.y) + (v0.z * v0.z + v0.w * v0.w) + (v1.x * v1.x + v1.y * v1.y) + (v1.z * v1.z + v1.w * v1.w) \
                             + (v2.x * v2.x + v2.y * v2.y) + (v2.z * v2.z + v2.w * v2.w) + (v3.x * v3.x + v3.y * v3.y) + (v3.z * v3.z + v3.w * v3.w); \
                    ss = wsum(ss); const float rr = rsqrtf(ss * (1.f / 1024.f) + EPS_); float* o_ = out + (size_t)t_ * 1024 + fl_ * 16; \
                    const f32x4 g0 = *(const f32x4*)(gfin + fl_ * 16), g1 = *(const f32x4*)(gfin + fl_ * 16 + 4), g2 = *(const f32x4*)(gfin + fl_ * 16 + 8), g3 = *(const f32x4*)(gfin + fl_ * 16 + 12); \
                    *(f32x4*)(o_) = v0 * rr * g0; *(f32x4*)(o_ + 4) = v1 * rr * g1; *(f32x4*)(o_ + 8) = v2 * rr * g2; *(f32x4*)(o_ + 12) = v3 * rr * g3; } } } while (0)
#pragma unroll 1
        for (int sg0 = 0; sg0 < 4; sg0 += 2) {
            v4f_t accA[8], accB[8];
#pragma unroll
            for (int n = 0; n < 8; ++n) { accA[n] = (v4f_t){0.f, 0.f, 0.f, 0.f}; accB[n] = accA[n]; }
            v4u bf0[8], bf1[8], bf2[8]; int idx1, idx2;
            { const int i0 = PV_IDX(0), i1 = PV_IDX(1), i2 = PV_IDX(2); idx1 = PV_IDX(3); idx2 = PV_IDX(4);
              PV_ROWS(bf0, i0); PV_ROWS(bf1, i1); PV_ROWS(bf2, i2); }
            __syncthreads();
#pragma unroll 1
            for (int rb = 0; rb < 36; rb += 12) {
                PV_ROUND(accA, bf0, rb + 0, 0); PV_ROUND(accA, bf1, rb + 1, 1); PV_ROUND(accB, bf2, rb + 2, 2); PV_ROUND(accB, bf0, rb + 3, 3);
                PV_ROUND(accA, bf1, rb + 4, 0); PV_ROUND(accA, bf2, rb + 5, 1); PV_ROUND(accB, bf0, rb + 6, 2); PV_ROUND(accB, bf1, rb + 7, 3);
                PV_ROUND(accA, bf2, rb + 8, 0); PV_ROUND(accA, bf0, rb + 9, 1); PV_ROUND(accB, bf1, rb + 10, 2); PV_ROUND(accB, bf2, rb + 11, 3); }
            asm volatile("s_waitcnt lgkmcnt(0)" ::: "memory"); __builtin_amdgcn_s_barrier();
            PV_FINSET(accA, sg0); PV_FINSET(accB, sg0 + 1);
        }
#undef PV_IDX
#undef PV_ROWS
#undef PV_ROUND
#undef PV_FINSET
    }
}

namespace mla {
typedef short bf16x8 __attribute__((ext_vector_type(8)));
typedef short s16x4 __attribute__((ext_vector_type(4)));
typedef float f32x16 __attribute__((ext_vector_type(16)));
typedef unsigned u32x4 __attribute__((ext_vector_type(4)));
constexpr int KSLOT = 12288, VSLOT = 8192;
constexpr int L_K = 0, L_V = 2 * KSLOT, L_WS = L_V + 2 * VSLOT, L_ST = L_WS + 8 * 256, L_END = L_ST + 8 * 8192;
__device__ __forceinline__ int crow(int r, int hi) { return (r & 3) + 8 * (r >> 2) + 4 * hi; }
__device__ __forceinline__ unsigned cvtpk(float lo, float hi) { typedef float f2 __attribute__((ext_vector_type(2))); typedef __bf16 b2 __attribute__((ext_vector_type(2))); f2 v = {lo, hi}; b2 b = __builtin_convertvector(v, b2); return __builtin_bit_cast(unsigned, b); }
__device__ __forceinline__ s16x4 vtr(const LAS unsigned char* p) { typedef short v4i16_t __attribute__((ext_vector_type(4))); return __builtin_bit_cast(s16x4, __builtin_amdgcn_ds_read_tr16_b64_v4i16((LAS v4i16_t*)p)); }

template <int THRL>
__device__ __forceinline__ void unit(int b, int h, int qb, const bf16_t* Q, const bf16_t* K, const bf16_t* V, bf16_t* Y, LAS unsigned char* lds, int wid, int lane) {
    const int r32 = lane & 31, hi = lane >> 5;
    const long rowbase = (long)b * S_; const int q0 = qb * 256;
    const bf16_t* Qw = Q + (size_t)(rowbase + q0 + wid * 32 + r32) * 768 + h * 96 + hi * 8;
    bf16x8 qr[6];
#pragma unroll
    for (int d0 = 0; d0 < 6; ++d0) qr[d0] = *(const bf16x8*)(Qw + d0 * 16);
    const bf16_t* Kh = K + (size_t)rowbase * 768 + h * 96; const bf16_t* Vh = V + (size_t)rowbase * 512 + h * 64;
    const bf16_t* ksrc0 = Kh + (size_t)lane * 768 + wid * 8;
    const bf16_t* vsrc = Vh + (size_t)(16 * (wid & 3) + (lane >> 2)) * 512 + (wid >> 2) * 32 + (lane & 3) * 8;
    const int NT = (q0 + 256) / 64;
#define MLA_DMA(t, slot) do { \
        __builtin_amdgcn_global_load_lds((const unsigned*)(ksrc0 + (size_t)(t) * 64 * 768), (LAS unsigned*)(lds + L_K + (slot) * KSLOT + wid * 1024), 16, 0, 0); \
        if (wid < 4) __builtin_amdgcn_global_load_lds((const unsigned*)(ksrc0 + (size_t)(t) * 64 * 768 + 64), (LAS unsigned*)(lds + L_K + (slot) * KSLOT + (wid + 8) * 1024), 16, 0, 0); \
        __builtin_amdgcn_global_load_lds((const unsigned*)(vsrc + (size_t)(t) * 64 * 512), (LAS unsigned*)(lds + L_V + (slot) * VSLOT + wid * 1024), 16, 0, 0); } while (0)
    LAS float* wsf = (LAS float*)(lds + L_WS) + wid * 64;
    float m = -INFINITY, l_reg = 0.f;
    f32x16 o0 = f32x16{}, o1 = f32x16{};
    const int qrel = wid * 32 + r32;
    MLA_DMA(0, 0);
#pragma unroll 1
    for (int t = 0; t < NT; ++t) {
        asm volatile("s_waitcnt vmcnt(0)" ::: "memory");
        __builtin_amdgcn_s_barrier();
        asm volatile("" ::: "memory");
        if (t + 1 < NT) MLA_DMA(t + 1, (t + 1) & 1);
        const int jb = t - (NT - 4);
        if (jb >= 0 && 64 * jb > 32 * wid + 31) continue;
        const LAS unsigned char* kb = lds + L_K + (t & 1) * KSLOT + hi * 1024 + r32 * 16;
        f32x16 p0 = f32x16{}, p1 = f32x16{};
#pragma unroll
        for (int d0 = 0; d0 < 6; ++d0) {
            const bf16x8 a0 = *(const LAS bf16x8*)(kb + d0 * 2048), a1 = *(const LAS bf16x8*)(kb + d0 * 2048 + 512);
            p0 = __builtin_amdgcn_mfma_f32_32x32x16_bf16(a0, qr[d0], p0, 0, 0, 0);
            p1 = __builtin_amdgcn_mfma_f32_32x32x16_bf16(a1, qr[d0], p1, 0, 0, 0);
        }
        if (jb >= 0) { const int kbase = 64 * jb + 4 * hi;
#pragma unroll
            for (int r = 0; r < 16; ++r) { const int kv = kbase + (r & 3) + 8 * (r >> 2); if (kv > qrel) p0[r] = -INFINITY; if (kv + 32 > qrel) p1[r] = -INFINITY; } }
        float rm = fmaxf(p0[0], p1[0]);
#pragma unroll
        for (int r = 1; r < 16; ++r) rm = fmaxf(rm, fmaxf(p0[r], p1[r]));
        { auto rr = __builtin_amdgcn_permlane32_swap(__float_as_uint(rm), __float_as_uint(rm), false, false); rm = fmaxf(__uint_as_float(rr[0]), __uint_as_float(rr[1])); }
        if (__any(rm > m + (float)THRL)) {
            const float mn = fmaxf(m, rm); const float f = __builtin_amdgcn_exp2f(m - mn); m = mn; l_reg *= f;
            if (hi == 0) wsf[r32] = f;
            asm volatile("s_waitcnt lgkmcnt(0)" ::: "memory");
#pragma unroll
            for (int r = 0; r < 16; ++r) { const float fr_ = wsf[crow(r, hi)]; o0[r] *= fr_; o1[r] *= fr_; }
        }
        float sacc = 0.f;
#pragma unroll
        for (int r = 0; r < 16; ++r) { p0[r] = __builtin_amdgcn_exp2f(p0[r] - m); p1[r] = __builtin_amdgcn_exp2f(p1[r] - m); sacc += p0[r] + p1[r]; }
        l_reg += sacc;
        u32x4 pw[4];
#pragma unroll
        for (int s = 0; s < 2; ++s) {
            pw[s] = (u32x4){cvtpk(p0[8 * s], p0[8 * s + 1]), cvtpk(p0[8 * s + 2], p0[8 * s + 3]), cvtpk(p0[8 * s + 4], p0[8 * s + 5]), cvtpk(p0[8 * s + 6], p0[8 * s + 7])};
            pw[2 + s] = (u32x4){cvtpk(p1[8 * s], p1[8 * s + 1]), cvtpk(p1[8 * s + 2], p1[8 * s + 3]), cvtpk(p1[8 * s + 4], p1[8 * s + 5]), cvtpk(p1[8 * s + 6], p1[8 * s + 7])};
        }
        const LAS unsigned char* vb = lds + L_V + (t & 1) * VSLOT + ((lane >> 4) & 1) * 32 + (lane & 3) * 8 + (4 * hi + ((lane & 15) >> 2)) * 64;
#pragma unroll
        for (int s = 0; s < 4; ++s) {
            const s16x4 lo0 = vtr(vb + s * 1024), hi0 = vtr(vb + s * 1024 + 512), lo1 = vtr(vb + 4096 + s * 1024), hi1 = vtr(vb + 4096 + s * 1024 + 512);
            const bf16x8 pa = __builtin_bit_cast(bf16x8, pw[s]);
            o0 = __builtin_amdgcn_mfma_f32_32x32x16_bf16(pa, (bf16x8){lo0[0], lo0[1], lo0[2], lo0[3], hi0[0], hi0[1], hi0[2], hi0[3]}, o0, 0, 0, 0);
            o1 = __builtin_amdgcn_mfma_f32_32x32x16_bf16(pa, (bf16x8){lo1[0], lo1[1], lo1[2], lo1[3], hi1[0], hi1[1], hi1[2], hi1[3]}, o1, 0, 0, 0);
        }
    }
#undef MLA_DMA
    { auto rr = __builtin_amdgcn_permlane32_swap(__float_as_uint(l_reg), __float_as_uint(l_reg), false, false); l_reg = __uint_as_float(rr[0]) + __uint_as_float(rr[1]); }
    if (hi == 0) wsf[32 + r32] = l_reg;
    asm volatile("s_waitcnt lgkmcnt(0)" ::: "memory");
    LAS float* stg = (LAS float*)(lds + L_ST + wid * 8192);
#pragma unroll
    for (int r = 0; r < 16; ++r) { const int orow = crow(r, hi); const float rl = __builtin_amdgcn_rcpf(wsf[32 + orow]); stg[orow * 64 + r32] = o0[r] * rl; stg[orow * 64 + 32 + r32] = o1[r] * rl; }
    asm volatile("s_waitcnt lgkmcnt(0)" ::: "memory");
    bf16_t* Yw = Y + (size_t)(rowbase + q0 + wid * 32) * 1024 + h * 64;
#pragma unroll
    for (int i = 0; i < 4; ++i) {
        const int row = i * 8 + (lane >> 3), ch = lane & 7;
        const f32x4 a = *(const LAS f32x4*)(stg + row * 64 + ch * 8), c = *(const LAS f32x4*)(stg + row * 64 + ch * 8 + 4);
        float ss = (a[0] * a[0] + a[1] * a[1]) + (a[2] * a[2] + a[3] * a[3]) + (c[0] * c[0] + c[1] * c[1]) + (c[2] * c[2] + c[3] * c[3]);
        ss += __shfl_xor(ss, 1); ss += __shfl_xor(ss, 2); ss += __shfl_xor(ss, 4);
        const float rs = rsqrtf(ss * (1.f / 64.f) + EPS_);
        u32x4 w; w.x = cvtpk(a[0] * rs, a[1] * rs); w.y = cvtpk(a[2] * rs, a[3] * rs); w.z = cvtpk(c[0] * rs, c[1] * rs); w.w = cvtpk(c[2] * rs, c[3] * rs);
        *(u32x4*)(Yw + (size_t)row * 1024 + ch * 8) = w;
    }
    asm volatile("s_waitcnt lgkmcnt(0)" ::: "memory");
    __builtin_amdgcn_s_barrier();
    asm volatile("" ::: "memory");
}
}

namespace rt {
typedef short bf16x8 __attribute__((ext_vector_type(8)));
typedef float f32x16 __attribute__((ext_vector_type(16)));
__device__ __forceinline__ int mono(float f) { const int b = __float_as_int(f); return b ^ ((b >> 31) & 0x7fffffff); }
__device__ __forceinline__ float unmono(int k) { return __int_as_float(k ^ ((k >> 31) & 0x7fffffff)); }
template <int N> __device__ __forceinline__ void bitonic_sort_desc(int (&k)[N]) {
#pragma unroll
    for (int size = 2; size <= N; size <<= 1)
#pragma unroll
        for (int stride = size >> 1; stride > 0; stride >>= 1)
#pragma unroll
            for (int i = 0; i < N; ++i) { const int j = i ^ stride;
                if (j > i) { const int mx = max(k[i], k[j]), mn = min(k[i], k[j]); if ((i & size) == 0) { k[i] = mx; k[j] = mn; } else { k[i] = mn; k[j] = mx; } } }
}
__device__ __forceinline__ void bitonic_merge_desc16(int (&k)[16]) {
#pragma unroll
    for (int stride = 8; stride > 0; stride >>= 1)
#pragma unroll
        for (int i = 0; i < 16; ++i) { const int j = i ^ stride; if (j > i) { const int mx = max(k[i], k[j]), mn = min(k[i], k[j]); k[i] = mx; k[j] = mn; } }
}
__device__ __forceinline__ void merge_top16(int (&a)[16], const int (&b)[16]) {
#pragma unroll
    for (int i = 0; i < 16; ++i) a[i] = max(a[i], b[15 - i]);
    bitonic_merge_desc16(a);
}
__device__ __forceinline__ void cross_merge16(int (&a)[16], int hi) {
    int pnr[16];
#pragma unroll
    for (int i = 0; i < 16; ++i) { auto r = __builtin_amdgcn_permlane32_swap((unsigned)a[i], (unsigned)a[i], false, false); pnr[i] = hi ? (int)r[0] : (int)r[1]; }
#pragma unroll
    for (int i = 0; i < 16; ++i) a[i] = max(a[i], pnr[15 - i]);
    bitonic_merge_desc16(a);
}
__device__ constexpr int A0[25] = {0,0,0,0,0,0,0,0, 1,1,1,1, 2,2, 3,3, 4, 5,6,7, 2, 8,10,12,14};
__device__ constexpr int B0[25] = {0,1,2,3,4,5,6,7, 0,1,2,3, 0,1, 0,1, 0, 0,0,0, 4, 0,0,0,0};
__device__ constexpr int A1[25] = {0,0,0,0,0,0,0,0, 1,1,1,1, 2,2, 3,3, 4, 5,6,7, 4, 9,11,13,15};
__device__ constexpr int B1[25] = {8,9,10,11,12,13,14,15, 4,5,6,7, 2,3, 2,3, 1, 1,1,1, 2, 0,0,0,0};

__device__ __forceinline__ void top16_set(const bf16_t* qrow  , const LAS unsigned char* skset, int r32, int hi, int (&T)[16]) {
    bf16x8 qf[4];
#pragma unroll
    for (int s2 = 0; s2 < 4; ++s2) qf[s2] = *(const bf16x8*)(qrow + 16 * s2);
    int k[4][16];
#pragma unroll
    for (int kb = 0; kb < 4; ++kb) {
        f32x16 sc = f32x16{};
#pragma unroll
        for (int s2 = 0; s2 < 4; ++s2) { const bf16x8 a = *(const LAS bf16x8*)(skset + (2 * s2 + hi) * 2048 + (kb * 32 + r32) * 16); sc = __builtin_amdgcn_mfma_f32_32x32x16_bf16(a, qf[s2], sc, 0, 0, 0); }
#pragma unroll
        for (int r = 0; r < 16; ++r) k[kb][r] = ((mono(sc[r]) & ~0x7f) | (hi << 2)) | (kb * 32 + (r & 3) + 8 * (r >> 2));
        bitonic_sort_desc<16>(k[kb]);
    }
    merge_top16(k[0], k[1]); merge_top16(k[2], k[3]); merge_top16(k[0], k[2]);
#pragma unroll
    for (int i = 0; i < 16; ++i) T[i] = k[0][i];
    cross_merge16(T, hi);
}

__device__ __forceinline__ void route_unit(int pm, int pn, const bf16_t* QP, const bf16_t* SKb, int* RIDX, float* RGATE, LAS unsigned char* lds, int wid, int lane) {
    const int r32 = lane & 31, hi = lane >> 5;
    for (int pc = wid; pc < 64; pc += 8) {
        const int set = pc >> 4, ch = (pc >> 1) & 7, hf = pc & 1;
        const bf16_t* src = SKb + ((size_t)((2 * pn + (set >> 1)) * 2 + (set & 1)) * 128 + 64 * hf + lane) * 64 + ch * 8;
        __builtin_amdgcn_global_load_lds((const unsigned*)src, (LAS unsigned*)(lds + set * 16384 + ch * 2048 + hf * 1024), 16, 0, 0);
    }
    asm volatile("s_waitcnt vmcnt(0)" ::: "memory"); __builtin_amdgcn_s_barrier(); asm volatile("" ::: "memory");
    const int t = pm * 256 + wid * 32 + r32;
#pragma unroll 1
    for (int hsel = 0; hsel < 2; ++hsel) {
        const int hh = 2 * pn + hsel;
        int T0[16], T1[16];
        const bf16_t* qrow = QP + (size_t)t * 1024 + hh * 128 + 8 * hi;
        top16_set(qrow, lds + (hsel * 2 + 0) * 16384, r32, hi, T0);
        top16_set(qrow + 64, lds + (hsel * 2 + 1) * 16384, r32, hi, T1);
        int ck[32], ok[25];
#pragma unroll
        for (int k2 = 0; k2 < 25; ++k2) { const int ka = hi ? T0[A1[k2]] : T0[A0[k2]], kb2 = hi ? T1[B1[k2]] : T1[B0[k2]];
            const float sm = unmono(ka & ~0x7f) + unmono(kb2 & ~0x7f); ok[k2] = ((mono(sm) & ~0x3f) | hi) | (2 * k2); ck[k2] = ok[k2]; }
#pragma unroll
        for (int k2 = 25; k2 < 32; ++k2) ck[k2] = (int)0x80000000;
        bitonic_sort_desc<32>(ck);
        int c16[16];
#pragma unroll
        for (int i = 0; i < 16; ++i) c16[i] = ck[i];
        cross_merge16(c16, hi);
        const int K16 = c16[15];
        const float smax = unmono(T0[0] & ~0x7f) + unmono(T1[0] & ~0x7f);
        float tot = 0.f; int cnt = 0;
#pragma unroll
        for (int k2 = 0; k2 < 25; ++k2) { if (ok[k2] >= K16) { tot += __builtin_amdgcn_exp2f((unmono(ok[k2] & ~0x3f) - smax) * LOG2E); cnt += 1; } }
        float tot_all; int cnt_lo;
        { auto r = __builtin_amdgcn_permlane32_swap(__float_as_uint(tot), __float_as_uint(tot), false, false); tot_all = __uint_as_float(r[0]) + __uint_as_float(r[1]); }
        { auto r = __builtin_amdgcn_permlane32_swap((unsigned)cnt, (unsigned)cnt, false, false); cnt_lo = hi ? (int)r[0] : cnt; }
        const float inv = 1.f / tot_all;
        int pos = hi ? cnt_lo : 0;
        int* ri = RIDX + (size_t)t * 128 + hh * 16; float* rg = RGATE + (size_t)t * 128 + hh * 16;
#pragma unroll
        for (int k2 = 0; k2 < 25; ++k2) {
            if (ok[k2] >= K16) {
                const int ea = hi ? (T0[A1[k2]] & 0x7f) : (T0[A0[k2]] & 0x7f), eb = hi ? (T1[B1[k2]] & 0x7f) : (T1[B0[k2]] & 0x7f);
                ri[pos] = ea * 128 + eb; rg[pos] = __builtin_amdgcn_exp2f((unmono(ok[k2] & ~0x3f) - smax) * LOG2E) * inv; pos += 1;
            }
        }
    }
    asm volatile("s_waitcnt vmcnt(0) lgkmcnt(0)" ::: "memory"); __builtin_amdgcn_s_barrier(); asm volatile("" ::: "memory");
}
}

#ifndef REP_LIST
#define REP_LIST {1, 1, 1, 1, 1, 1, 1, 1, 1, 1, 1, 1, 1, 1}
#endif
__device__ constexpr int REP[14] = REP_LIST;
__global__ void __launch_bounds__(NWAVES * 64, 2) mk_fwd(Args args) {
    extern __shared__ __attribute__((aligned(16))) unsigned char lds[];
    Frame F;
    F.lds = (LAS unsigned char*)lds; F.tid = threadIdx.x; F.lane = F.tid & 63; F.wave = __builtin_amdgcn_readfirstlane(F.tid >> 6);
    F.G = gridDim.x; F.gw = blockIdx.x * NWAVES + F.wave; F.NGW = F.G * NWAVES; F.ws = args.ws;
    volatile LAS unsigned* MISC = (volatile LAS unsigned*)(F.lds + MISC_OFF);
    for (int u = F.tid; u < (LDS_BYTES - LDSCTL_OFF) / 4; u += NWAVES * 64) ((LAS unsigned*)(F.lds + LDSCTL_OFF))[u] = 0u;
    __syncthreads();
    unsigned* ctl = (unsigned*)(args.ws + WS_CTL);
    XcdBarrier bar = xcd_barrier_post(ctl + CW_BAR + args.bar_region * XCD_BAR_WORDS, MISC + 8);
    const int lo = args.ph_lo, hi = args.ph_hi;
#define IN(k) (lo <= (k) && (k) < hi)
#define NEXTP(k) ((k) == 5 ? 7 : (k) == 8 ? 10 : (k) + 1)
#define BOTH(k) (IN(k) && IN(NEXTP(k)))
    unsigned char* ws = args.ws;
    bf16_t* Qb = (bf16_t*)args.out; bf16_t* Kb = Qb + (size_t)T_ * 768; bf16_t* Vb = Kb + (size_t)T_ * 768;

    if (IN(0)) for (int rep_ = 0; rep_ < REP[0]; ++rep_) { p0_prologue(F, args); if (BOTH(0)) xcd_barrier(bar); }

    if (IN(1)) for (int rep_ = 0; rep_ < REP[1]; ++rep_) {
        { pg8::Gemm g{(const bf16_t*)(ws + WS_RA), (const bf16_t*)(ws + WO_WIN), 1024, 1024, T_, 2560, 1024};
          pg8::StaticOrder S; S.init(T_, 2560, F.G, (int)blockIdx.x);
          pg8::EpiGen<0, false, 0, true> E{(bf16_t*)(ws + WS_RB), PJ, nullptr, nullptr, 0, 0.f, 1.f, nullptr, 0, (float*)(ws + PSS1_OFF), 3, T_, nullptr, nullptr};
          pg8::gemm_phase<decltype(E), pg8::StaticOrder, PG8_ALIGN, PG8_SP2>(F.lds + RING_OFF, g, S, E, F.wave); }
        { pg8::Gemm g{(const bf16_t*)(ws + WS_MEMN), (const bf16_t*)(ws + WO_WXKV), 1024, 1024, TM_, 1024, 1024};
          pg8::StaticOrder S; S.init(TM_, 1024, F.G, (int)((blockIdx.x + F.G - 128) % F.G));
          pg8::EpiGen<0, false, 0, false> E{(bf16_t*)(ws + WS_KX), 1024, nullptr, nullptr, 0, 0.f, 1.f, nullptr, 0, nullptr, 0, TM_, nullptr, nullptr};
          pg8::gemm_phase<decltype(E), pg8::StaticOrder, PG8_ALIGN, PG8_SP2>(F.lds + RING_OFF, g, S, E, F.wave); }
        { pg8::Gemm g{(const bf16_t*)(ws + WO_WXKV) + (size_t)1024 * 1024, (const bf16_t*)(ws + WS_MEMN), 1024, 1024, 1024, TM_, 1024};
          pg8::StaticOrder S; S.init(1024, TM_, F.G, (int)((blockIdx.x + F.G - 160) % F.G));
          pg8::EpiGen<0, false, 0, false> E{(bf16_t*)(ws + WS_VXT), 2048, nullptr, nullptr, 0, 0.f, 1.f, nullptr, 0, nullptr, 0, 1024, nullptr, nullptr};
          pg8::gemm_phase<decltype(E), pg8::StaticOrder, PG8_ALIGN, PG8_SP2>(F.lds + RING_OFF, g, S, E, F.wave); }
        if (BOTH(1)) xcd_barrier(bar);
    }

    if (IN(2)) for (int rep_ = 0; rep_ < REP[2]; ++rep_) {
        { pg8::Gemm g{(const bf16_t*)(ws + WS_RB) + 512, (const bf16_t*)(ws + WO_WUKV), PJ, 256, T_, 1024, 256};
          pg8::StaticOrder S; S.init(T_, 1024, F.G, (int)blockIdx.x);
          pg8::EpiGen<2, true, 0, false> E{Kb, 768, Vb, (const float*)(ws + PSS1_OFF) + (size_t)8 * T_, 4, 1.f / 256.f, 1.f, nullptr, 0, nullptr, 0, T_, nullptr, nullptr};
          pg8::gemm_phase<decltype(E), pg8::StaticOrder, PG8_ALIGN, PG8_SP2>(F.lds + RING_OFF, g, S, E, F.wave); }
        { pg8::Gemm g{(const bf16_t*)(ws + WS_RB), (const bf16_t*)(ws + WO_WUQ), PJ, 384, T_, 768, 384};
          pg8::StaticOrder S; S.init(T_, 768, F.G, (int)((blockIdx.x + F.G - 64) % F.G));
          pg8::EpiGen<1, true, 0, false> E{Qb, 768, nullptr, (const float*)(ws + PSS1_OFF), 8, 1.f / 384.f, LOG2E * 0.10206207261596577f, nullptr, 0, nullptr, 0, T_, (const float*)(ws + WS_COS), (const float*)(ws + WS_SIN)};
          pg8::gemm_phase<decltype(E), pg8::StaticOrder, PG8_ALIGN, PG8_SP2>(F.lds + RING_OFF, g, S, E, F.wave); }
        p2_conv_job(F, args);
        if (BOTH(2)) xcd_barrier(bar);
    }

    if (IN(3)) for (int rep_ = 0; rep_ < REP[3]; ++rep_) {
        const int vcu = (F.G % 8 == 0) ? (int)((blockIdx.x % 8) * (F.G / 8) + blockIdx.x / 8) : (int)blockIdx.x;
        int lane = __builtin_amdgcn_mbcnt_hi(~0u, __builtin_amdgcn_mbcnt_lo(~0u, 0u)); asm volatile("" : "+v"(lane));
        for (int v = vcu; v < 256; v += F.G) {
            const int bh = v >> 2, sx = v & 3;
            mla::unit<8>(bh >> 3, bh & 7, 7 - sx, Qb, Kb, Vb, (bf16_t*)(ws + WS_RA), F.lds + RING_OFF, F.wave, lane);
            mla::unit<8>(bh >> 3, bh & 7, sx, Qb, Kb, Vb, (bf16_t*)(ws + WS_RA), F.lds + RING_OFF, F.wave, lane);
        }
        if (BOTH(3)) xcd_barrier(bar);
    }

    if (IN(4)) for (int rep_ = 0; rep_ < REP[4]; ++rep_) {
        pg8::Gemm g{(const bf16_t*)(ws + WS_RA), (const bf16_t*)(ws + WO_WO), 1024, 1024, T_, 1024, 1024};
        pg8::StaticOrder S; S.init(T_, 1024, F.G, (int)blockIdx.x);
        pg8::EpiGen<0, false, 1, true> E{(bf16_t*)(ws + WS_RB), 1024, nullptr, nullptr, 0, 0.f, 1.f, args.in[0], 1024, (float*)(ws + PSS4_OFF), 4, T_, nullptr, nullptr};
        pg8::gemm_phase<decltype(E), pg8::StaticOrder, PG8_ALIGN, PG8_SP2>(F.lds + RING_OFF, g, S, E, F.wave);
        if (BOTH(4)) xcd_barrier(bar);
    }

    if (IN(5)) for (int rep_ = 0; rep_ < REP[5]; ++rep_) {
        pg8::StaticOrder S0; S0.init(T_, 1024, F.G, (int)blockIdx.x);
        for (int ui = 0; ; ++ui) {
            pg8::Unit u; if (!S0.next(ui, u)) break;
            const int bb = u.pm >> 3, hh = u.pn;
            if (ui > 0) { __builtin_amdgcn_fence(__ATOMIC_ACQUIRE, "agent"); asm volatile("s_waitcnt vmcnt(0)" ::: "memory"); __syncthreads(); }
            bf16_t* QXt = (bf16_t*)(ws + WS_RA) + (size_t)u.pm * 256 * 1024 + hh * 256;
            bf16_t* PXt = (bf16_t*)(ws + WS_RD) + (size_t)blockIdx.x * 65536;
            { pg8::Gemm g{(const bf16_t*)(ws + WS_RB), (const bf16_t*)(ws + WO_WXQ), 1024, 1024, T_, 1024, 1024};
              pg8::FixedUnit S{u.pm, u.pn};
              pg8::EpiGen<0, true, 0, false> E{(bf16_t*)(ws + WS_RA), 1024, nullptr, (const float*)(ws + PSS4_OFF), 16, 1.f / 1024.f, LOG2E / 16.f, nullptr, 0, nullptr, 0, T_, nullptr, nullptr};
              pg8::gemm_phase<decltype(E), pg8::FixedUnit, false, PG8_SP2>(F.lds + RING_OFF, g, S, E, F.wave); }
            { pg8::Gemm g{QXt, (const bf16_t*)(ws + WS_KX) + (size_t)bb * 256 * 1024 + hh * 256, 1024, 1024, 256, 256, 256};
              pg8::SingleUnit S; pg8::EpiSoftmax E{PXt, 256};
              pg8::gemm_phase<pg8::EpiSoftmax, pg8::SingleUnit, false, PG8_SP2>(F.lds + RING_OFF, g, S, E, F.wave); }
            { pg8::Gemm g{PXt, (const bf16_t*)(ws + WS_VXT) + (size_t)hh * 256 * 2048 + bb * 256, 256, 2048, 256, 256, 256};
              pg8::SingleUnit S;
              pg8::EpiGen<0, false, 0, false> E{(bf16_t*)(ws + WS_RC) + (size_t)u.pm * 256 * 1024 + hh * 256, 1024, nullptr, nullptr, 0, 0.f, 1.f, nullptr, 0, nullptr, 0, T_, nullptr, nullptr};
              pg8::gemm_phase<decltype(E), pg8::SingleUnit, false, PG8_SP2>(F.lds + RING_OFF, g, S, E, F.wave); }
        }
        if (BOTH(5)) xcd_barrier(bar);
    }


    if (IN(7)) for (int rep_ = 0; rep_ < REP[7]; ++rep_) {
        pg8::Gemm g{(const bf16_t*)(ws + WS_RC), (const bf16_t*)(ws + WO_WXO), 1024, 1024, T_, 1024, 1024};
        pg8::StaticOrder S; S.init(T_, 1024, F.G, (int)blockIdx.x);
        pg8::EpiGen<0, false, 2, true> E{(bf16_t*)(ws + WS_RA), 1024, nullptr, nullptr, 0, 0.f, 1.f, (const void*)(ws + WS_RB), 1024, (float*)(ws + PSS6_OFF), 4, T_, nullptr, nullptr};
        pg8::gemm_phase<decltype(E), pg8::StaticOrder, PG8_ALIGN, PG8_SP2>(F.lds + RING_OFF, g, S, E, F.wave);
        if (BOTH(7)) xcd_barrier(bar);
    }

    if (IN(8)) for (int rep_ = 0; rep_ < REP[8]; ++rep_) {
        pg8::StaticOrder S0; S0.init(T_, 1024, F.G, (int)blockIdx.x);
        for (int ui = 0; ; ++ui) {
            pg8::Unit u; if (!S0.next(ui, u)) break;
            { pg8::Gemm g{(const bf16_t*)(ws + WS_RA), (const bf16_t*)(ws + WO_WPQ), 1024, 1024, T_, 1024, 1024};
              pg8::FixedUnit S{u.pm, u.pn};
              pg8::EpiGen<0, true, 0, false> E{(bf16_t*)(ws + WS_RC), 1024, nullptr, (const float*)(ws + PSS6_OFF), 16, 1.f / 1024.f, 1.f, nullptr, 0, nullptr, 0, T_, nullptr, nullptr};
              pg8::gemm_phase<decltype(E), pg8::FixedUnit, false, PG8_SP2>(F.lds + RING_OFF, g, S, E, F.wave); }
            int lane = __builtin_amdgcn_mbcnt_hi(~0u, __builtin_amdgcn_mbcnt_lo(~0u, 0u)); asm volatile("" : "+v"(lane));
            rt::route_unit(u.pm, u.pn, (const bf16_t*)(ws + WS_RC), (const bf16_t*)(ws + WO_SK), (int*)(ws + WS_RIDX), (float*)(ws + WS_RGATE), F.lds + RING_OFF, F.wave, lane);
        }
        if (BOTH(8)) xcd_barrier(bar);
    }


    if (IN(10)) for (int rep_ = 0; rep_ < REP[10]; ++rep_) { p_peer_u(F, args); if (BOTH(10)) xcd_barrier(bar); }
    if (IN(11)) for (int rep_ = 0; rep_ < REP[11]; ++rep_) { p_peer_v(F, args); }
#undef IN
#undef BOTH
}

extern "C" void kernel_launch(void* const* d_in, const int* in_sizes, int n_in, void* d_out, int out_size, void* d_ws, size_t ws_size, hipStream_t stream) {
    const float* x = (const float*)d_in[0];
    const float* g_out = (const float*)d_in[10]; const float* w_o = (const float*)d_in[11];
    const float* g_x = (const float*)d_in[12]; const float* w_xq = (const float*)d_in[14];
    const float* w_xo = (const float*)d_in[16]; const float* g_ffn = (const float*)d_in[17];
    const float* w_pq = (const float*)d_in[18]; const float* sub_keys = (const float*)d_in[19]; const float* u_exp = (const float*)d_in[20];
    const float* v_exp = (const float*)d_in[21]; const float* g_final = (const float*)d_in[22];
    float* out = (float*)d_out; unsigned char* ws = (unsigned char*)d_ws;
    if (ws_size < WS_END || n_in != 23) return;
    static int grid = 0;
    if (grid == 0) {
        int dev = 0, cus = 0;
        if (hipGetDevice(&dev) != hipSuccess || hipDeviceGetAttribute(&cus, hipDeviceAttributeMultiprocessorCount, dev) != hipSuccess) { grid = -1; return; }
        if (hipFuncSetAttribute((const void*)mk_fwd, hipFuncAttributeMaxDynamicSharedMemorySize, LDS_BYTES) != hipSuccess) { grid = -1; return; }
        grid = cus;
    }
    if (grid < 0) return;
    bf16_t* KX = (bf16_t*)(ws + WS_KX); bf16_t* VXT = (bf16_t*)(ws + WS_VXT);
    float* RS1 = (float*)(ws + WS_RIDX) - 2 * T_; float* RS2 = RS1 + T_;
    int* RIDX = (int*)(ws + WS_RIDX); float* RGATE = (float*)(ws + WS_RGATE);
    bf16_t* Y = (bf16_t*)(ws + WS_RA); bf16_t* QX = Y; bf16_t* H2 = Y;
    bf16_t* H1 = (bf16_t*)(ws + WS_RB);
    bf16_t* OX = (bf16_t*)(ws + WS_RC); bf16_t* QP = OX;
    bf16_t* Q = (bf16_t*)d_out; bf16_t* K = Q + (size_t)T_ * 768; bf16_t* V = K + (size_t)T_ * 768;

    hipMemsetAsync(ws + WS_CTL, 0, CTL_ZERO_BYTES, stream);
    Args a; memset(&a, 0, sizeof a);
    for (int i = 0; i < 23; ++i) a.in[i] = d_in[i];
    a.out = out; a.ws = ws;
    a.ph_lo = 0; a.ph_hi = 12; a.bar_region = 0;
    hipLaunchKernelGGL(mk_fwd, dim3(grid), dim3(NWAVES * 64), LDS_BYTES, stream, a);
}
```

```cpp
#include <hip/hip_runtime.h>
#include <stdint.h>
#include <math.h>
#include <string.h>

typedef unsigned short bf16_t;
constexpr int T_ = 16384, D_ = 1024, B_ = 8, S_ = 2048, ML_ = 256, TM_ = 2048;
constexpr int PJ = 2560;
constexpr float EPS_ = 1e-6f;
constexpr float LOG2E = 1.4426950408889634f;

constexpr size_t MiB = 1u << 20;
constexpr size_t WS_CTL = 0;
constexpr size_t WS_COS = 2 * MiB, WS_SIN = 3 * MiB;
constexpr size_t WS_W = 4 * MiB;
constexpr size_t WS_UT = 24 * MiB, WS_VT = 56 * MiB;
constexpr size_t WS_MEMN = 88 * MiB, WS_KX = 92 * MiB, WS_VXT = 96 * MiB;
constexpr size_t WS_RS = 100 * MiB;
constexpr size_t WS_SCL = 105 * MiB;
constexpr size_t WS_RIDX = 106 * MiB, WS_RGATE = 114 * MiB;
constexpr size_t WS_RA = 122 * MiB;
constexpr size_t WS_RB = 154 * MiB;
constexpr size_t WS_RC = 186 * MiB;
constexpr size_t WS_RD = 218 * MiB;
constexpr size_t WS_BS = 32 * MiB;
constexpr size_t WS_BO = 64 * MiB;
constexpr size_t WS_WXQN = 80 * MiB;
constexpr size_t WS_END = 256 * MiB;

__device__ __forceinline__ float bf2f(bf16_t b) { return __uint_as_float(((unsigned)b) << 16); }
__device__ __forceinline__ bf16_t f2bf(float f) { unsigned u = __float_as_uint(f); return (bf16_t)((u + 0x7fffu + ((u >> 16) & 1u)) >> 16); }
__device__ __forceinline__ unsigned q8pack(float f0, float f1, float f2, float f3, float qs) {
    const unsigned a0 = __float_as_uint(fmaf(f0, qs, 12582912.f)), a1 = __float_as_uint(fmaf(f1, qs, 12582912.f)), a2 = __float_as_uint(fmaf(f2, qs, 12582912.f)), a3 = __float_as_uint(fmaf(f3, qs, 12582912.f));
    return __builtin_amdgcn_perm(a1, a0, 0x0c0c0400u) | __builtin_amdgcn_perm(a3, a2, 0x04000c0cu);
}
__device__ __forceinline__ float wave_sum(float v) {
#pragma unroll
    for (int o = 1; o < 64; o <<= 1) v += __shfl_xor(v, o);
    return v;
}
__device__ __forceinline__ float wave_max(float v) {
#pragma unroll
    for (int o = 1; o < 64; o <<= 1) v = fmaxf(v, __shfl_xor(v, o));
    return v;
}

namespace pg8 {
#define PG8_LAS __attribute__((address_space(3)))
typedef short bf16x8 __attribute__((ext_vector_type(8)));
typedef float f32x4 __attribute__((ext_vector_type(4)));
typedef unsigned u32x4 __attribute__((ext_vector_type(4)));
constexpr int BM = 256, BK = 64, HALF = 128, HTB = HALF * BK * 2  , STAGE_BYTES = 8 * HTB, NXCD = 8, WGM = 8;

__host__ __device__ __forceinline__ int lds_byte(int r, int c) { const int st = (r >> 4) * 2 + (c >> 5), rr = r & 15, cc = c & 31, ob = rr * 64 + cc * 2; return st * 1024 + (ob ^ (((ob >> 9) & 1) << 5)); }
__host__ __device__ __forceinline__ void stage_rc(int b, int& R, int& C) { const int st = b / 1024, sb = b % 1024, swz = sb ^ (((sb >> 9) & 1) << 5); R = (st >> 1) * 16 + swz / 64; C = (st & 1) * 32 + (swz % 64) / 2; }
__host__ __device__ __forceinline__ int perm32(int rho) { const int n = rho >> 4, i = rho & 15; return 8 * (i >> 2) + 4 * n + (i & 3); }

struct Unit { int pm, pn; };
struct Gemm { const bf16_t* A; const bf16_t* Bt; int lda, ldb, M, N, K; long bbatch; };

struct StaticOrder {
    int nM, nN, nwg, G, c, fx, fpm, fpn;
    __host__ __device__ __forceinline__ void init(int M, int N, int G_, int c_) { nM = M / BM; nN = N / BM; nwg = nM * nN; G = G_; c = c_; fx = 0; fpm = 0; fpn = 0; }
    __host__ __device__ __forceinline__ void fix(bool valid, int pm, int pn) { fx = valid ? 1 : 2; fpm = pm; fpn = pn; }
    __host__ __device__ __forceinline__ bool next(int i, Unit& u) const {
        if (fx) { if (fx == 2 || i > 0) return false; u.pm = fpm; u.pn = fpn; return true; }
        const long L = (long)i * G + c; if (L >= nwg) return false;
        int wgid = (int)L; { const int q = nwg / NXCD, r = nwg % NXCD, xcd = wgid % NXCD, off = wgid / NXCD; wgid = (xcd < r ? xcd * (q + 1) : r * (q + 1) + (xcd - r) * q) + off; }
        const int nig = WGM * nN, gid = wgid / nig, fm = gid * WGM, gsz = (nM - fm) < WGM ? (nM - fm) : WGM;
        u.pm = fm + ((wgid % nig) % gsz); u.pn = (wgid % nig) / gsz; return true;
    }
    __device__ __forceinline__ void a_ready(const Unit&) const {}
    __device__ __forceinline__ void done(const Unit&) const {}
};

__device__ __forceinline__ unsigned cvt_pk_bf16(float lo, float hi) { unsigned r; asm volatile("v_cvt_pk_bf16_f32 %0, %1, %2" : "=v"(r) : "v"(lo), "v"(hi)); return r; }
__device__ __forceinline__ float bflo(unsigned w) { return __uint_as_float(w << 16); }
__device__ __forceinline__ float bfhi(unsigned w) { return __uint_as_float(w & 0xffff0000u); }

template <int MODE, bool RSCALE, int RES  , bool PSS>
struct EpiGen {
    static constexpr bool PERM = true, AFTER_DRAIN = false;
    bf16_t* O; int ldc; bf16_t* O2;
    const float* parts; int nparts; float inv_dim; float cscale;
    const void* R; int ldr;
    float* pss; int pss_tiles; int rows_total;
    const float* COS; const float* SIN;
    __device__ __forceinline__ void operator()(const f32x4 (&acc)[2][2][4][2], const Unit& u, int wr, int wc, int fr, int fq) const {
        { int ln = __builtin_amdgcn_mbcnt_hi(~0u, __builtin_amdgcn_mbcnt_lo(~0u, 0u)); asm volatile("" : "+v"(ln)); fr = ln & 15; fq = ln >> 4; }
        const int row0 = u.pm * BM + wr * 64 + fr;
        const int colb = u.pn * BM + wc * 32 + 8 * fq;
#pragma unroll
        for (int ai = 0; ai < 2; ++ai) {
            float psum[4]; f32x4 rf[4][2][2]; u32x4 rw[4][2];
#pragma unroll
            for (int m = 0; m < 4; ++m) {
                const int row = row0 + ai * HALF + m * 16;
                if (RSCALE) { float s = 0.f;
#pragma unroll
                    for (int i = 0; i < 4; ++i) { const int p = fq + 4 * i; const float pv = parts[(size_t)(p < nparts ? p : fq) * rows_total + row]; s += (p < nparts) ? pv : 0.f; }
                    psum[m] = s; }
#pragma unroll
                for (int bj = 0; bj < 2; ++bj) { const int col = colb + bj * HALF;
                    if (RES == 1) { const float* r = (const float*)R + (size_t)row * ldr + col; rf[m][bj][0] = __builtin_nontemporal_load((const f32x4*)r); rf[m][bj][1] = __builtin_nontemporal_load((const f32x4*)(r + 4)); }
                    if (RES == 2) rw[m][bj] = __builtin_nontemporal_load((const u32x4*)((const bf16_t*)R + (size_t)row * ldr + col)); }
            }
#pragma unroll
            for (int m = 0; m < 4; ++m) {
                const int row = row0 + ai * HALF + m * 16;
                float rs = cscale;
                if (RSCALE) { float s = psum[m]; s += __shfl_xor(s, 16); s += __shfl_xor(s, 32); rs *= rsqrtf(s * inv_dim + 1e-6f); }
                float ss = 0.f;
#pragma unroll
                for (int bj = 0; bj < 2; ++bj) {
                    const int col = colb + bj * HALF;
                    f32x4 v0 = acc[ai][bj][m][0] * rs, v1 = acc[ai][bj][m][1] * rs;
                    if (RES == 1) { v0 += rf[m][bj][0]; v1 += rf[m][bj][1]; }
                    if (RES == 2) { const u32x4 w = rw[m][bj];
                        v0 += (f32x4){bflo(w.x), bfhi(w.x), bflo(w.y), bfhi(w.y)}; v1 += (f32x4){bflo(w.z), bfhi(w.z), bflo(w.w), bfhi(w.w)}; }
                    if (PSS) ss += (v0[0] * v0[0] + v0[1] * v0[1]) + (v0[2] * v0[2] + v0[3] * v0[3]) + (v1[0] * v1[0] + v1[1] * v1[1]) + (v1[2] * v1[2] + v1[3] * v1[3]);
                    bf16_t* dst;
                    if (MODE == 1) {
                        const int pr = col % 96;
                        if (pr >= 64) { const int i0 = (pr - 64) >> 1; const f32x4 c = *(const f32x4*)(COS + (size_t)row * 16 + i0), s = *(const f32x4*)(SIN + (size_t)row * 16 + i0);
                            const f32x4 a0 = v0, a1 = v1;
                            v0[0] = a0[0] * c[0] - a0[1] * s[0]; v0[1] = a0[1] * c[0] + a0[0] * s[0]; v0[2] = a0[2] * c[1] - a0[3] * s[1]; v0[3] = a0[3] * c[1] + a0[2] * s[1];
                            v1[0] = a1[0] * c[2] - a1[1] * s[2]; v1[1] = a1[1] * c[2] + a1[0] * s[2]; v1[2] = a1[2] * c[3] - a1[3] * s[3]; v1[3] = a1[3] * c[3] + a1[2] * s[3]; }
                        dst = O + (size_t)row * 768 + col;
                    } else if (MODE == 2) {
                        if (col < 512) dst = O + (size_t)row * 768 + (col >> 6) * 96 + (col & 63); else dst = O2 + (size_t)row * 512 + (col - 512);
                    } else if (MODE == 3) { dst = O + ((size_t)(col >> 8) * 1024 + row) * 1024 + ldc + (col & 255);
                    } else dst = O + (size_t)row * ldc + col;
                    u32x4 w; w.x = cvt_pk_bf16(v0[0], v0[1]); w.y = cvt_pk_bf16(v0[2], v0[3]); w.z = cvt_pk_bf16(v1[0], v1[1]); w.w = cvt_pk_bf16(v1[2], v1[3]);
                    *(u32x4*)dst = w;
                }
                if (PSS) { if (u.pn < pss_tiles) { ss += __shfl_xor(ss, 16); ss += __shfl_xor(ss, 32); if (fq == 0) pss[(size_t)(u.pn * 4 + wc) * rows_total + row] = ss; } }
            }
            asm volatile("" ::: "memory");
        }
    }
};

struct SingleUnit {
    __device__ __forceinline__ bool next(int i, Unit& u) const { if (i > 0) return false; u.pm = 0; u.pn = 0; return true; }
    __device__ __forceinline__ void a_ready(const Unit&) const {}
    __device__ __forceinline__ void done(const Unit&) const {}
};
struct FixedUnit {
    int pm, pn;
    __device__ __forceinline__ bool next(int i, Unit& u) const { if (i > 0) return false; u.pm = pm; u.pn = pn; return true; }
    __device__ __forceinline__ void a_ready(const Unit&) const {}
    __device__ __forceinline__ void done(const Unit&) const {}
};

struct EpiSoftmax {
    static constexpr bool PERM = true, AFTER_DRAIN = true;
    bf16_t* O; int ldc;
    const float* parts; int nparts; float inv_dim; float cscale; int rows_total;
    __device__ __forceinline__ void fused(f32x4 (&acc)[2][2][4][2], const Unit& u, int wr, int wc, int fr, int fq, PG8_LAS unsigned char* lds, int wid, int lane) const {
        PG8_LAS float* PM = (PG8_LAS float*)lds;
        PG8_LAS float* PS = (PG8_LAS float*)(lds + 4096);
        { float ps_[2][4];
#pragma unroll
          for (int ai = 0; ai < 2; ++ai)
#pragma unroll
            for (int m = 0; m < 4; ++m) { const int grow = u.pm * BM + ai * HALF + wr * 64 + m * 16 + fr; float s_ = 0.f;
#pragma unroll
                for (int i = 0; i < 4; ++i) { const int p = fq + 4 * i; const float pv = parts[(size_t)(p < nparts ? p : fq) * rows_total + grow]; s_ += (p < nparts) ? pv : 0.f; }
                ps_[ai][m] = s_; }
#pragma unroll
          for (int ai = 0; ai < 2; ++ai)
#pragma unroll
            for (int m = 0; m < 4; ++m) { float s_ = ps_[ai][m]; s_ += __shfl_xor(s_, 16); s_ += __shfl_xor(s_, 32); const float rs = cscale * rsqrtf(s_ * inv_dim + 1e-6f);
#pragma unroll
                for (int bj = 0; bj < 2; ++bj)
#pragma unroll
                    for (int n = 0; n < 2; ++n) acc[ai][bj][m][n] = acc[ai][bj][m][n] * rs; } }
#pragma unroll
        for (int ai = 0; ai < 2; ++ai)
#pragma unroll
            for (int m = 0; m < 4; ++m) {
                const int row = ai * HALF + wr * 64 + m * 16 + fr;
                float mx = -INFINITY;
#pragma unroll
                for (int bj = 0; bj < 2; ++bj)
#pragma unroll
                    for (int n = 0; n < 2; ++n) { const f32x4 v = acc[ai][bj][m][n]; mx = fmaxf(mx, fmaxf(fmaxf(v[0], v[1]), fmaxf(v[2], v[3]))); }
                mx = fmaxf(mx, __shfl_xor(mx, 16)); mx = fmaxf(mx, __shfl_xor(mx, 32));
                if (fq == 0) PM[row * 4 + wc] = mx;
            }
        asm volatile("s_waitcnt lgkmcnt(0)" ::: "memory"); __builtin_amdgcn_s_barrier(); asm volatile("" ::: "memory");
#pragma unroll
        for (int ai = 0; ai < 2; ++ai)
#pragma unroll
            for (int m = 0; m < 4; ++m) {
                const int row = ai * HALF + wr * 64 + m * 16 + fr;
                const f32x4 pm = *(const PG8_LAS f32x4*)(PM + row * 4);
                const float mrow = fmaxf(fmaxf(pm[0], pm[1]), fmaxf(pm[2], pm[3]));
                float sm = 0.f;
#pragma unroll
                for (int bj = 0; bj < 2; ++bj)
#pragma unroll
                    for (int n = 0; n < 2; ++n) { f32x4 v = acc[ai][bj][m][n];
                        v[0] = __builtin_amdgcn_exp2f(v[0] - mrow); v[1] = __builtin_amdgcn_exp2f(v[1] - mrow); v[2] = __builtin_amdgcn_exp2f(v[2] - mrow); v[3] = __builtin_amdgcn_exp2f(v[3] - mrow);
                        sm += (v[0] + v[1]) + (v[2] + v[3]); acc[ai][bj][m][n] = v; }
                sm += __shfl_xor(sm, 16); sm += __shfl_xor(sm, 32);
                if (fq == 0) PS[row * 4 + wc] = sm;
            }
        asm volatile("s_waitcnt lgkmcnt(0)" ::: "memory"); __builtin_amdgcn_s_barrier(); asm volatile("" ::: "memory");
#pragma unroll
        for (int ai = 0; ai < 2; ++ai)
#pragma unroll
            for (int m = 0; m < 4; ++m) {
                const int row = ai * HALF + wr * 64 + m * 16 + fr;
                const f32x4 ps = *(const PG8_LAS f32x4*)(PS + row * 4);
                const float inv = 1.f / ((ps[0] + ps[1]) + (ps[2] + ps[3]));
#pragma unroll
                for (int bj = 0; bj < 2; ++bj) {
                    const f32x4 v0 = acc[ai][bj][m][0] * inv, v1 = acc[ai][bj][m][1] * inv;
                    u32x4 w; w.x = cvt_pk_bf16(v0[0], v0[1]); w.y = cvt_pk_bf16(v0[2], v0[3]); w.z = cvt_pk_bf16(v1[0], v1[1]); w.w = cvt_pk_bf16(v1[2], v1[3]);
                    *(u32x4*)(O + (size_t)row * ldc + bj * HALF + wc * 32 + 8 * fq) = w;
                }
            }
        asm volatile("s_waitcnt vmcnt(0) lgkmcnt(0)" ::: "memory"); __builtin_amdgcn_s_barrier(); asm volatile("" ::: "memory");
    }
};

template <class Epi, class Sched, bool ALIGN_EPI = false, bool SP2 = false>
__device__ __forceinline__ void gemm_phase(PG8_LAS unsigned char* lds, const Gemm g, const Sched& S, const Epi& E, const int wid_in  ) {
    int lane_ = __builtin_amdgcn_mbcnt_hi(~0u, __builtin_amdgcn_mbcnt_lo(~0u, 0u)); asm volatile("" : "+v"(lane_));
    const int wid = wid_in, lane = lane_, tid = wid * 64 + lane, wr = wid >> 2, wc = wid & 3, fr = lane & 15, fq = lane >> 4;
    const int K = g.K, nt = K / BK;
    unsigned voffA[2], voffB[2];
#pragma unroll
    for (int i = 0; i < 2; ++i) { int R, C; stage_rc(tid * 16 + i * 8192, R, C); const int Rb = Epi::PERM ? ((R & ~31) + perm32(R & 31)) : R;
        voffA[i] = (unsigned)(R * g.lda + C) * 2u; voffB[i] = (unsigned)(Rb * g.ldb + C) * 2u; }
    const size_t kstep = (size_t)(BK * 2);
    const size_t hstepA = (size_t)HALF * g.lda * 2, hstepB = (size_t)HALF * g.ldb * 2;
    const size_t tstepA = 2 * hstepA, tstepB = 2 * hstepB;
    const unsigned ldsw = (unsigned)wid * 1024u;
    const int aoff = lds_byte(wr * 64 + fr, fq * 8), boff = lds_byte(wc * 32 + fr, fq * 8);
#define PG8_SA(b, h) (((b) * 2 + (h)) * HTB)
#define PG8_SB(b, h) ((4 + (b) * 2 + (h)) * HTB)
#define PG8_STAGE(bufoff, gbase, voff) do { _Pragma("unroll") for (int _i = 0; _i < 2; ++_i) \
        __builtin_amdgcn_global_load_lds((const unsigned*)((const char*)(gbase) + (voff)[_i]), (PG8_LAS unsigned*)(lds + (bufoff) + ldsw + _i * 8192), 16, 0, 0); } while (0)
#define PG8_LDA(dst, b, h) do { _Pragma("unroll") for (int m = 0; m < 4; ++m) _Pragma("unroll") for (int k = 0; k < 2; ++k) dst[m][k] = *(const PG8_LAS bf16x8*)(lds + PG8_SA(b, h) + aoff + m * 2048 + k * 1024); } while (0)
#define PG8_LDB(dst, b, h) do { _Pragma("unroll") for (int n = 0; n < 2; ++n) _Pragma("unroll") for (int k = 0; k < 2; ++k) dst[n][k] = *(const PG8_LAS bf16x8*)(lds + PG8_SB(b, h) + boff + n * 2048 + k * 1024); } while (0)
#define PG8_MMA(ai, bj, At, Bt) do { __builtin_amdgcn_s_setprio(3); _Pragma("unroll") for (int m = 0; m < 4; ++m) _Pragma("unroll") for (int n = 0; n < 2; ++n) _Pragma("unroll") for (int k = 0; k < 2; ++k) \
        acc[ai][bj][m][n] = __builtin_amdgcn_mfma_f32_16x16x32_bf16(Bt[n][k], At[m][k], acc[ai][bj][m][n], 0, 0, 0); __builtin_amdgcn_s_setprio(0); } while (0)
#define PG8_WAIT_V(n) asm volatile("s_waitcnt vmcnt(" #n ")" ::: "memory")
#define PG8_WAIT_L(n) asm volatile("s_waitcnt lgkmcnt(" #n ")" ::: "memory")
#define PG8_BAR __builtin_amdgcn_s_barrier()
#define PG8_SCHED __builtin_amdgcn_sched_barrier(0)
    Unit cur, nxt; int ui = 0;
    if (!S.next(0, cur)) return;
    f32x4 acc[2][2][4][2];
#pragma unroll
    for (int a = 0; a < 2; ++a)
#pragma unroll
        for (int b = 0; b < 2; ++b)
#pragma unroll
            for (int m = 0; m < 4; ++m)
#pragma unroll
                for (int n = 0; n < 2; ++n) acc[a][b][m][n] = (f32x4){0.f, 0.f, 0.f, 0.f};
    bf16x8 At[4][2], B0[2][2], B1[2][2];
    const char* cA = (const char*)g.A + (size_t)cur.pm * tstepA; const char* cB = (const char*)g.Bt + (size_t)cur.pn * tstepB + (size_t)(cur.pm >> 3) * g.bbatch;
    S.a_ready(cur);
    if constexpr (SP2) {
        PG8_STAGE(PG8_SB(0, 0), cB, voffB); PG8_STAGE(PG8_SB(0, 1), cB + hstepB, voffB); PG8_STAGE(PG8_SA(0, 0), cA, voffA); PG8_STAGE(PG8_SA(0, 1), cA + hstepA, voffA);
        if (wr == 1) PG8_BAR;
        PG8_WAIT_V(2); PG8_BAR;
        PG8_STAGE(PG8_SB(1, 0), cB + kstep, voffB); PG8_STAGE(PG8_SA(1, 0), cA + kstep, voffA); PG8_STAGE(PG8_SB(1, 1), cB + hstepB + kstep, voffB);
        PG8_WAIT_V(6); PG8_BAR;
    } else {
        PG8_STAGE(PG8_SB(0, 0), cB, voffB); PG8_STAGE(PG8_SA(0, 0), cA, voffA); PG8_STAGE(PG8_SB(0, 1), cB + hstepB, voffB); PG8_STAGE(PG8_SA(0, 1), cA + hstepA, voffA);
        if (wr == 1) PG8_BAR;
        PG8_WAIT_V(4); PG8_BAR;
        PG8_STAGE(PG8_SB(1, 0), cB + kstep, voffB); PG8_STAGE(PG8_SA(1, 0), cA + kstep, voffA); PG8_STAGE(PG8_SB(1, 1), cB + hstepB + kstep, voffB);
        PG8_WAIT_V(6); PG8_BAR;
    }
    for (;;) {
        const bool has_next = S.next(ui + 1, nxt);
        const char* nA = has_next ? (const char*)g.A + (size_t)nxt.pm * tstepA : cA; const char* nB = has_next ? (const char*)g.Bt + (size_t)nxt.pn * tstepB + (size_t)(nxt.pm >> 3) * g.bbatch : cB;
#pragma unroll 1
        for (int t = 0; t < nt; t += 2) {
            const bool last = (t == nt - 2);
            const char* a1 = cA + (size_t)(t + 1) * kstep;
            const char* a2 = last ? nA : cA + (size_t)(t + 2) * kstep; const char* b2 = last ? nB : cB + (size_t)(t + 2) * kstep;
            const char* a3 = a2 + kstep; const char* b3 = b2 + kstep;
            if (last && has_next) S.a_ready(nxt);
            if constexpr (SP2) {
            PG8_LDB(B0, 0, 0); PG8_LDB(B1, 0, 1); PG8_SCHED; PG8_LDA(At, 0, 0); PG8_STAGE(PG8_SA(1, 1), a1 + hstepA, voffA);
            PG8_WAIT_V(8); PG8_WAIT_L(0); PG8_BAR; PG8_MMA(0, 0, At, B0); PG8_MMA(0, 1, At, B1); PG8_BAR; PG8_SCHED;
            PG8_LDA(At, 0, 1); PG8_STAGE(PG8_SB(0, 0), b2, voffB); PG8_STAGE(PG8_SB(0, 1), b2 + hstepB, voffB); PG8_STAGE(PG8_SA(0, 0), a2, voffA);
            PG8_WAIT_V(8); PG8_WAIT_L(0); PG8_BAR; PG8_MMA(1, 0, At, B0); PG8_MMA(1, 1, At, B1); PG8_BAR; PG8_SCHED;
            PG8_LDB(B0, 1, 0); PG8_LDB(B1, 1, 1); PG8_SCHED; PG8_LDA(At, 1, 0); PG8_STAGE(PG8_SA(0, 1), a2 + hstepA, voffA);
            PG8_WAIT_V(8); PG8_WAIT_L(0); PG8_BAR; PG8_MMA(0, 0, At, B0); PG8_MMA(0, 1, At, B1); PG8_BAR; PG8_SCHED;
            PG8_LDA(At, 1, 1); PG8_STAGE(PG8_SB(1, 0), b3, voffB); PG8_STAGE(PG8_SB(1, 1), b3 + hstepB, voffB); PG8_STAGE(PG8_SA(1, 0), a3, voffA);
            PG8_WAIT_V(8); PG8_WAIT_L(0); PG8_BAR; PG8_MMA(1, 0, At, B0); PG8_MMA(1, 1, At, B1); PG8_BAR; PG8_SCHED;
            } else {
            PG8_LDB(B0, 0, 0); PG8_SCHED; PG8_LDA(At, 0, 0); PG8_STAGE(PG8_SA(1, 1), a1 + hstepA, voffA);
            PG8_WAIT_L(8); PG8_BAR; PG8_WAIT_L(0); PG8_MMA(0, 0, At, B0); PG8_BAR; PG8_SCHED;
            PG8_LDB(B1, 0, 1); PG8_STAGE(PG8_SB(0, 0), b2, voffB);
            PG8_BAR; PG8_WAIT_L(0); PG8_MMA(0, 1, At, B1); PG8_BAR;
            PG8_LDA(At, 0, 1); PG8_STAGE(PG8_SA(0, 0), a2, voffA);
            PG8_BAR; PG8_WAIT_L(0); PG8_MMA(1, 0, At, B0); PG8_BAR; PG8_SCHED;
            PG8_STAGE(PG8_SB(0, 1), b2 + hstepB, voffB);
            PG8_WAIT_V(6); PG8_BAR; PG8_MMA(1, 1, At, B1); PG8_BAR;
            PG8_LDB(B0, 1, 0); PG8_SCHED; PG8_LDA(At, 1, 0); PG8_STAGE(PG8_SA(0, 1), a2 + hstepA, voffA);
            PG8_WAIT_L(8); PG8_BAR; PG8_WAIT_L(0); PG8_MMA(0, 0, At, B0); PG8_BAR; PG8_SCHED;
            PG8_LDB(B1, 1, 1); PG8_STAGE(PG8_SB(1, 0), b3, voffB);
            PG8_BAR; PG8_WAIT_L(0); PG8_MMA(0, 1, At, B1); PG8_BAR;
            PG8_LDA(At, 1, 1); PG8_STAGE(PG8_SA(1, 0), a3, voffA);
            PG8_BAR; PG8_WAIT_L(0); PG8_MMA(1, 0, At, B0); PG8_BAR; PG8_SCHED;
            PG8_STAGE(PG8_SB(1, 1), b3 + hstepB, voffB);
            PG8_WAIT_V(6); PG8_BAR; PG8_MMA(1, 1, At, B1); PG8_BAR;
            }
        }
        if constexpr (ALIGN_EPI) { if (wr == 0) PG8_BAR; }
        if constexpr (!Epi::AFTER_DRAIN) { E(acc, cur, wr, wc, fr, fq); S.done(cur); }
        if (!has_next) break;
#pragma unroll
        for (int a = 0; a < 2; ++a)
#pragma unroll
            for (int b = 0; b < 2; ++b)
#pragma unroll
                for (int m = 0; m < 4; ++m)
#pragma unroll
                    for (int n = 0; n < 2; ++n) acc[a][b][m][n] = (f32x4){0.f, 0.f, 0.f, 0.f};
        cur = nxt; cA = nA; cB = nB; ++ui;
        if constexpr (ALIGN_EPI) { if (wr == 1) PG8_BAR; }
    }
    PG8_WAIT_V(0);
    if constexpr (!ALIGN_EPI) { if (wr == 0) PG8_BAR; }
    PG8_BAR;
    if constexpr (Epi::AFTER_DRAIN) { E.fused(acc, cur, wr, wc, fr, fq, lds, wid, lane); S.done(cur); }
#undef PG8_SA
#undef PG8_SB
#undef PG8_STAGE
#undef PG8_LDA
#undef PG8_LDB
#undef PG8_MMA
#undef PG8_WAIT_V
#undef PG8_WAIT_L
#undef PG8_BAR
#undef PG8_SCHED
}
}
#ifndef PG8_SP2
#define PG8_SP2 true
#endif
#ifndef PG8_ALIGN
#define PG8_ALIGN true
#endif

constexpr int NWAVES = 8;
constexpr int RING_OFF = 0, RING_BYTES = 131072;
constexpr int LDSCTL_OFF = RING_BYTES, MISC_OFF = LDSCTL_OFF + 320;
constexpr int LDS_BYTES = 147456;
constexpr int CW_BAR = 4096;
constexpr size_t CTL_ZERO_BYTES = 64 * 1024;

constexpr size_t WO_WIN = WS_W;
constexpr size_t WO_WUQ = WO_WIN + (size_t)2560 * 1024 * 2;
constexpr size_t WO_WUKV = WO_WUQ + (size_t)768 * 384 * 2;
constexpr size_t WO_WO = WO_WUKV + (size_t)1024 * 256 * 2;
constexpr size_t WO_WXQ = WO_WO + (size_t)1024 * 1024 * 2;
constexpr size_t WO_WXKV = WO_WXQ + (size_t)1024 * 1024 * 2;
constexpr size_t WO_WXO = WO_WXKV + (size_t)2048 * 1024 * 2;
constexpr size_t WO_WPQ = WO_WXO + (size_t)1024 * 1024 * 2;
constexpr size_t WO_SK = WO_WPQ + (size_t)1024 * 1024 * 2;
constexpr size_t WO_END = WO_SK + (size_t)16 * 128 * 64 * 2;
static_assert(WO_END <= WS_UT, "weights region");
constexpr size_t PSS1_OFF = WS_RS;
constexpr size_t PSS4_OFF = PSS1_OFF + (size_t)12 * T_ * 4;
constexpr size_t PSS6_OFF = PSS4_OFF + (size_t)16 * T_ * 4;
static_assert(PSS6_OFF + (size_t)16 * T_ * 4 <= WS_RIDX, "pss region");

#define GAS __attribute__((address_space(1)))
#define LAS __attribute__((address_space(3)))
typedef unsigned v4u __attribute__((ext_vector_type(4)));
typedef float f32x4 __attribute__((ext_vector_type(4)));
typedef GAS unsigned gu32;
#define RLX_AGENT __ATOMIC_RELAXED, __HIP_MEMORY_SCOPE_AGENT
#define LDS_WAIT() asm volatile("s_waitcnt lgkmcnt(0)" ::: "memory")
#define VM_WAIT() asm volatile("s_waitcnt vmcnt(0)" ::: "memory")
__device__ __forceinline__ unsigned pk2(float lo, float hi) { return (unsigned)f2bf(lo) | ((unsigned)f2bf(hi) << 16); }

#define XB_TMO      128
#define XB_XCNT(j)  (256  + 64 * (j))
#define XB_XSUB(j)  (1280 + 64 * (j))
#define XB_XGEN(j)  (2304 + 64 * (j))
#define XB_TOP      3328
#define XB_TOPGEN   3392
#define XCD_BAR_WORDS 3456
#define XB_SPIN_CAP (1u << 18)
__device__ __forceinline__ unsigned xb_ld(unsigned* p)              { return __hip_atomic_load(p, __ATOMIC_RELAXED, __HIP_MEMORY_SCOPE_AGENT); }
__device__ __forceinline__ unsigned xb_add(unsigned* p, unsigned v) { return __hip_atomic_fetch_add(p, v, __ATOMIC_RELAXED, __HIP_MEMORY_SCOPE_AGENT); }
__device__ __forceinline__ unsigned xb_xcc_id() { return (unsigned)__builtin_amdgcn_s_getreg((3 << 11) | 20) & 0xFu; }
#define XB_SPIN(cond, bar) do { unsigned _sp = 0; while (cond) { __builtin_amdgcn_s_sleep(1); \
    if ((++_sp & 255u) == 0u) { if (xb_ld(&(bar)[XB_TMO])) break; if (_sp > XB_SPIN_CAP) { atomicAdd(&(bar)[XB_TMO], 1u); break; } } } } while (0)
struct XcdBarrier { unsigned* bar; unsigned x; volatile LAS unsigned* st; };
__device__ __forceinline__ XcdBarrier xcd_barrier_post(unsigned* bar, volatile LAS unsigned* st) {
    XcdBarrier b; b.bar = bar; b.x = xb_xcc_id(); b.st = st;
    if (threadIdx.x == 0) (void)xb_add(&bar[XB_XCNT(b.x)], 1u);
    return b;
}
__device__ __forceinline__ void xcd_barrier_complete(unsigned* bar, unsigned x, unsigned& nloc, unsigned& nx) {
    const unsigned G = gridDim.x * gridDim.y * gridDim.z;
    unsigned sum, cnt, mine, sp = 0u;
    for (;;) {
        sum = 0u; cnt = 0u; mine = 0u;
#pragma unroll
        for (unsigned j = 0; j < 16; ++j) { const unsigned c = xb_ld(&bar[XB_XCNT(j)]); sum += c; cnt += (c > 0u) ? 1u : 0u; mine = (j == x) ? c : mine; }
        if (sum == G) break;
        __builtin_amdgcn_s_sleep(1);
        if ((++sp & 255u) == 0u) { if (xb_ld(&bar[XB_TMO])) break; if (sp > XB_SPIN_CAP) { atomicAdd(&bar[XB_TMO], 1u); break; } }
    }
    nloc = mine > 0u ? mine : 1u; nx = cnt > 0u ? cnt : 1u;
}
__device__ __forceinline__ void xcd_barrier(const XcdBarrier& b) {
    asm volatile("s_waitcnt vmcnt(0)" ::: "memory");
    __syncthreads();
    if (threadIdx.x == 0) {
        unsigned* bar = b.bar;
        __builtin_amdgcn_s_waitcnt(0);
        unsigned nloc = b.st[0], nx = b.st[1];
        if (nloc == 0u) { xcd_barrier_complete(bar, b.x, nloc, nx); b.st[0] = nloc; b.st[1] = nx; }
        const unsigned old = xb_add(&bar[XB_XSUB(b.x)], 1u);
        const unsigned gen = old / nloc;
        if (old + 1u == (gen + 1u) * nloc) {
            __builtin_amdgcn_fence(__ATOMIC_RELEASE, "agent");
            asm volatile("s_waitcnt vmcnt(0)" ::: "memory");
            const unsigned og = xb_add(&bar[XB_TOP], 1u);
            const unsigned tg = og / nx;
            if (og + 1u == (tg + 1u) * nx) xb_add(&bar[XB_TOPGEN], 1u);
            else XB_SPIN(xb_ld(&bar[XB_TOPGEN]) == tg, bar);
            __builtin_amdgcn_fence(__ATOMIC_ACQUIRE, "agent");
            xb_add(&bar[XB_XGEN(b.x)], 1u);
            asm volatile("s_waitcnt vmcnt(0)" ::: "memory");
        } else {
            XB_SPIN(xb_ld(&bar[XB_XGEN(b.x)]) == gen, bar);
            __builtin_amdgcn_fence(__ATOMIC_ACQUIRE, "agent");
            asm volatile("s_waitcnt vmcnt(0)" ::: "memory");
        }
    }
    __syncthreads();
}
constexpr int CW_XID = 0, CW_SUBX = 256, CW_SUBX1 = 384, CW_DONE3 = 512, CW_DONE2 = 528, CW_DONEW = 544, CW_SUBX2 = 640, CW_SUBP = 8192;
static_assert(CW_SUBP >= CW_BAR + XCD_BAR_WORDS && (CW_SUBP + 4 * 1024) * 4 <= (int)CTL_ZERO_BYTES, "control words");
__device__ __forceinline__ void sub_barrier(unsigned* cnt, unsigned target, unsigned* bar) {
    asm volatile("s_waitcnt vmcnt(0)" ::: "memory");
    __syncthreads();
    if (threadIdx.x == 0) {
        __builtin_amdgcn_s_waitcnt(0);
        asm volatile("buffer_inv sc1" ::: "memory");
        (void)xb_add(cnt, 1u);
        XB_SPIN(xb_ld(cnt) < target, bar);
        asm volatile("s_waitcnt vmcnt(0)" ::: "memory");
    }
    __syncthreads();
}
__device__ __forceinline__ void wg_seam(unsigned* done, unsigned target, unsigned* bar) {
    asm volatile("s_waitcnt vmcnt(0)" ::: "memory");
    __syncthreads();
    if (threadIdx.x == 0) {
        asm volatile("buffer_inv sc1" ::: "memory");
        XB_SPIN(xb_ld(done) < target, bar);
        asm volatile("s_waitcnt vmcnt(0)" ::: "memory");
    }
    __syncthreads();
}

struct Args { const void* in[23]; float* out; unsigned char* ws; int ph_lo, ph_hi, bar_region, pad; };

struct Frame {
    LAS unsigned char* lds; int tid, lane, wave, G, gw, NGW, tb, ts, trend;
    unsigned char* ws;
};

__device__ __forceinline__ int colmap(int which, int n) {
    if (which == 0) {
        if (n < 384) return n; if (n < 512) return -1; if (n < 768) return 384 + (n - 512); if (n < 800) return 640 + (n - 768); if (n < 1024) return -1; return 672 + (n - 1024);
    } else if (which == 1) {
        const int h = n / 96, p = n % 96; if (p < 64) return h * 96 + p; const int j = p - 64, i = j >> 1; return h * 96 + 64 + ((j & 1) ? 16 + i : i);
    } else if (which == 2) {
        if (n < 512) return (n >> 6) * 128 + (n & 63); const int q = n - 512; return (q >> 6) * 128 + 64 + (q & 63);
    }
    return n;
}
__device__ __forceinline__ void p0_transpose_item(const float* W, int ldw, const float* gk, int which, bf16_t* WT, int K, int Nd, LAS float* scr, int item, int lane) {
    const int nblk = Nd / 32, kb = item / nblk, nb = item % nblk, k0 = 64 * kb, n0 = 32 * nb;
    const int sc = colmap(which, n0 + (lane & 31));
    float tv[32], tg[32];
#pragma unroll
    for (int i = 0; i < 32; ++i) { const int kk = 2 * i + (lane >> 5); tv[i] = (sc >= 0) ? __builtin_nontemporal_load(&W[(size_t)(k0 + kk) * ldw + sc]) : 0.f; tg[i] = gk ? gk[k0 + kk] : 1.f; }
#pragma unroll
    for (int i = 0; i < 32; ++i) { const int kk = 2 * i + (lane >> 5); scr[kk * 33 + (lane & 31)] = tv[i] * tg[i]; }
    LDS_WAIT(); asm volatile("" ::: "memory");
    const int c = lane & 7;
#pragma unroll
    for (int j = 0; j < 4; ++j) { const int n = (lane >> 3) + 8 * j; const LAS float* s = scr + (8 * c) * 33 + n;
        v4u o; o.x = pk2(s[0 * 33], s[1 * 33]); o.y = pk2(s[2 * 33], s[3 * 33]); o.z = pk2(s[4 * 33], s[5 * 33]); o.w = pk2(s[6 * 33], s[7 * 33]);
        *(GAS v4u*)(WT + (size_t)(n0 + n) * K + k0 + 8 * c) = o; }
    LDS_WAIT(); asm volatile("" ::: "memory");
}
__device__ __forceinline__ float wsum(float v) {
#pragma unroll
    for (int o = 1; o < 64; o <<= 1) v += __shfl_xor(v, o);
    return v;
}
__device__ __forceinline__ void rms_row_to_bf16(const float* xrow, const float* g, bf16_t* orow, int lane) {
    const GAS f32x4* xr = (const GAS f32x4*)xrow + lane; const GAS f32x4* gr = (const GAS f32x4*)g + lane;
    f32x4 v[4]; float s = 0.f;
#pragma unroll
    for (int j = 0; j < 4; ++j) { v[j] = xr[64 * j]; s += (v[j].x * v[j].x + v[j].y * v[j].y) + (v[j].z * v[j].z + v[j].w * v[j].w); }
    const float rstd = rsqrtf(wsum(s) * (1.f / 1024.f) + EPS_);
    GAS unsigned long long* o8 = (GAS unsigned long long*)orow + lane;
#pragma unroll
    for (int j = 0; j < 4; ++j) { const f32x4 gg = gr[64 * j]; o8[64 * j] = (unsigned long long)pk2(v[j].x * rstd * gg.x, v[j].y * rstd * gg.y) | ((unsigned long long)pk2(v[j].z * rstd * gg.z, v[j].w * rstd * gg.w) << 32); }
}

__device__ __forceinline__ void p0_table_rows(Frame& F, const Args& a, const int rfirst, const int rend, const int rstride) {
    { unsigned char* ws = F.ws; const float* U = (const float*)a.in[20]; const float* V = (const float*)a.in[21]; const float* gf = (const float*)a.in[17];
      unsigned char* UT8 = ws + WS_UT; unsigned char* VT8 = ws + WS_VT; float* SU = (float*)(ws + WS_SCL); float* SV = SU + 16384;
      f32x4 g4[4];
#pragma unroll
      for (int q = 0; q < 4; ++q) g4[q] = *(const f32x4*)(gf + q * 256 + F.lane * 4);
#define P0_TROW(dst, rr) do { const int rc_ = (rr) < rend ? (rr) : rfirst; const float* s_ = (rc_ < 16384 ? U + (size_t)rc_ * 1024 : V + (size_t)(rc_ - 16384) * 1024) + F.lane * 4; \
          _Pragma("unroll") for (int q = 0; q < 4; ++q) dst[q] = __builtin_nontemporal_load((const f32x4*)(s_ + q * 256)); } while (0)
      f32x4 n0[4], n1[4];
      P0_TROW(n0, rfirst); P0_TROW(n1, rfirst + rstride);
      for (int r = rfirst; r < rend; r += rstride) {
          const bool isu = r < 16384; const int e = isu ? r : r - 16384;
          f32x4 v[4]; float am = 0.f;
#pragma unroll
          for (int q = 0; q < 4; ++q) { v[q] = n0[q]; n0[q] = n1[q]; }
          P0_TROW(n1, r + 2 * rstride);
#pragma unroll
          for (int q = 0; q < 4; ++q) { if (isu) v[q] = v[q] * g4[q];
              am = fmaxf(am, fmaxf(fmaxf(fabsf(v[q].x), fabsf(v[q].y)), fmaxf(fabsf(v[q].z), fabsf(v[q].w)))); }
#pragma unroll
          for (int o = 1; o < 64; o <<= 1) am = fmaxf(am, __shfl_xor(am, o));
          const float sc = am > 0.f ? am * (1.f / 6.f) : 1.f, inv = 1.f / sc;
          unsigned short* dst = (unsigned short*)((isu ? UT8 : VT8) + (size_t)e * 512) + F.lane;
#pragma unroll
          for (int q = 0; q < 4; ++q) { unsigned w_ = 0; w_ = __builtin_amdgcn_cvt_scalef32_pk_fp4_f32(w_, v[q].x * inv, v[q].y * inv, 1.0f, 0); w_ = __builtin_amdgcn_cvt_scalef32_pk_fp4_f32(w_, v[q].z * inv, v[q].w * inv, 1.0f, 1);
              dst[q * 64] = (unsigned short)(w_ & 0xffffu); }
          if (F.lane == 0) (isu ? SU : SV)[e] = sc;
      } }
}

__device__ __forceinline__ void p0_prologue(Frame& F, const Args& a) {
    LAS float* scr = (LAS float*)(F.lds + RING_OFF + F.wave * 16384);
    unsigned char* ws = F.ws;
#pragma unroll 1
    for (int pass = 0; pass < 2; ++pass) {
    if (((F.wave & 1) == 0) == (pass == 0)) {
    constexpr int I_IN = 16 * 80, I_UQ = 6 * 24, I_UKV = 4 * 32, I_SQ = 16 * 32, I_XKV = 16 * 64;
    constexpr int NITEMS = I_IN + I_UQ + I_UKV + 4 * I_SQ + I_XKV;
    for (int it = F.gw; it < NITEMS; it += F.NGW) {
        int r = it;
        if (r < I_IN) { p0_transpose_item((const float*)a.in[4], 2208, nullptr, 0, (bf16_t*)(ws + WO_WIN), 1024, 2560, scr, r, F.lane); continue; } r -= I_IN;
        if (r < I_UQ) { p0_transpose_item((const float*)a.in[6], 768, (const float*)a.in[5], 1, (bf16_t*)(ws + WO_WUQ), 384, 768, scr, r, F.lane); continue; } r -= I_UQ;
        if (r < I_UKV) { p0_transpose_item((const float*)a.in[8], 1024, (const float*)a.in[7], 2, (bf16_t*)(ws + WO_WUKV), 256, 1024, scr, r, F.lane); continue; } r -= I_UKV;
        if (r < I_SQ) { p0_transpose_item((const float*)a.in[11], 1024, (const float*)a.in[10], 3, (bf16_t*)(ws + WO_WO), 1024, 1024, scr, r, F.lane); continue; } r -= I_SQ;
        if (r < I_SQ) { p0_transpose_item((const float*)a.in[14], 1024, (const float*)a.in[12], 3, (bf16_t*)(ws + WO_WXQ), 1024, 1024, scr, r, F.lane); continue; } r -= I_SQ;
        if (r < I_XKV) { p0_transpose_item((const float*)a.in[15], 2048, nullptr, 3, (bf16_t*)(ws + WO_WXKV), 1024, 2048, scr, r, F.lane); continue; } r -= I_XKV;
        if (r < I_SQ) { p0_transpose_item((const float*)a.in[16], 1024, nullptr, 3, (bf16_t*)(ws + WO_WXO), 1024, 1024, scr, r, F.lane); continue; } r -= I_SQ;
        p0_transpose_item((const float*)a.in[18], 1024, (const float*)a.in[17], 3, (bf16_t*)(ws + WO_WPQ), 1024, 1024, scr, r, F.lane);
    }
    { const float* X = (const float*)a.in[0]; const float* MEM = (const float*)a.in[1];
      const int mpw = (T_ + TM_ + F.NGW - 1) / F.NGW;
      const int m0 = F.gw * mpw, mend = ((F.gw + 1) * mpw < T_ + TM_) ? (F.gw + 1) * mpw : T_ + TM_;
#define P0_NROW(dst, mm) do { const int mc_ = (mm) < mend ? (mm) : (mend - 1 >= 0 ? mend - 1 : 0); const f32x4* s_ = (const f32x4*)(mc_ < T_ ? X + (size_t)mc_ * 1024 : MEM + (size_t)(mc_ - T_) * 1024) + F.lane; \
          _Pragma("unroll") for (int q = 0; q < 4; ++q) dst[q] = __builtin_nontemporal_load(s_ + 64 * q); } while (0)
      f32x4 gx[4], gm[4], n0[4], n1[4];
#pragma unroll
      for (int q = 0; q < 4; ++q) { gx[q] = ((const GAS f32x4*)a.in[3] + F.lane)[64 * q]; gm[q] = ((const GAS f32x4*)a.in[13] + F.lane)[64 * q]; }
      if (m0 < mend) { P0_NROW(n0, m0); P0_NROW(n1, m0 + 1); }
      for (int m = m0; m < mend; ++m) {
          f32x4 v[4]; float ss = 0.f;
#pragma unroll
          for (int q = 0; q < 4; ++q) { v[q] = n0[q]; n0[q] = n1[q]; }
          P0_NROW(n1, m + 2);
#pragma unroll
          for (int q = 0; q < 4; ++q) ss += (v[q].x * v[q].x + v[q].y * v[q].y) + (v[q].z * v[q].z + v[q].w * v[q].w);
          const float rstd = rsqrtf(wsum(ss) * (1.f / 1024.f) + EPS_);
          const bool isx = m < T_;
          GAS unsigned long long* o8 = (GAS unsigned long long*)(isx ? (bf16_t*)(ws + WS_RA) + (size_t)m * 1024 : (bf16_t*)(ws + WS_MEMN) + (size_t)(m - T_) * 1024) + F.lane;
          if (isx) {
#pragma unroll
              for (int q = 0; q < 4; ++q) o8[64 * q] = (unsigned long long)pk2(v[q].x * rstd * gx[q].x, v[q].y * rstd * gx[q].y) | ((unsigned long long)pk2(v[q].z * rstd * gx[q].z, v[q].w * rstd * gx[q].w) << 32);
          } else {
#pragma unroll
              for (int q = 0; q < 4; ++q) o8[64 * q] = (unsigned long long)pk2(v[q].x * rstd * gm[q].x, v[q].y * rstd * gm[q].y) | ((unsigned long long)pk2(v[q].z * rstd * gm[q].z, v[q].w * rstd * gm[q].w) << 32);
          }
      }
#undef P0_NROW
    }
    { const float* WQ = (const float*)a.in[14]; const float* gx_ = (const float*)a.in[12]; bf16_t* WN = (bf16_t*)(ws + WS_WXQN);
      for (int c = F.gw; c < 1024; c += F.NGW) { const float gc_ = gx_[c];
#pragma unroll
          for (int q = 0; q < 4; ++q) { const f32x4 v = __builtin_nontemporal_load((const f32x4*)(WQ + (size_t)c * 1024 + q * 256 + F.lane * 4));
              *(unsigned long long*)(WN + (size_t)c * 1024 + q * 256 + F.lane * 4) = (unsigned long long)pk2(v.x * gc_, v.y * gc_) | ((unsigned long long)pk2(v.z * gc_, v.w * gc_) << 32); } } }
    } else {
    p0_table_rows(F, a, F.gw, F.trend, F.NGW);
    }
    }
    { const float* SKf = (const float*)a.in[19]; bf16_t* SKb = (bf16_t*)(ws + WO_SK);
      for (int i = F.gw * 64 + F.lane; i < 16 * 128 * 64 / 2; i += F.NGW * 64) ((unsigned*)SKb)[i] = pk2(SKf[2 * i], SKf[2 * i + 1]); }
    { const int* pos = (const int*)a.in[2]; float* COS = (float*)(ws + WS_COS); float* SIN = (float*)(ws + WS_SIN);
      for (int i = F.gw * 64 + F.lane; i < T_ * 16; i += F.NGW * 64) { const int t = i >> 4, f = i & 15; const float inv = powf(10000.f, -(float)(2 * f) / 32.f); const float ang = (float)pos[t] * inv; COS[i] = cosf(ang); SIN[i] = sinf(ang); } }
}

__device__ __forceinline__ void p2_conv_job(Frame& F, const Args& a) {
    const bf16_t* PROJ = (const bf16_t*)(F.ws + WS_RB); bf16_t* Y = (bf16_t*)(F.ws + WS_RA); bf16_t* Kb = (bf16_t*)a.out + (size_t)T_ * 768;
    const float* cw = (const float*)a.in[9]; const float* COS = (const float*)(F.ws + WS_COS); const float* SIN = (const float*)(F.ws + WS_SIN);
    int lane = __builtin_amdgcn_mbcnt_hi(~0u, __builtin_amdgcn_mbcnt_lo(~0u, 0u)); asm volatile("" : "+v"(lane));
    const int ch0 = lane * 8;
    f32x4 w0[3], w1[3];
#pragma unroll
    for (int k = 0; k < 3; ++k) { w0[k] = *(const f32x4*)(cw + k * 512 + ch0); w1[k] = *(const f32x4*)(cw + k * 512 + ch0 + 4); }
    for (int t0 = F.tb, it_ = F.gw; it_ < T_; it_ += 4 * F.NGW, t0 += 4 * F.ts) {
        v4u gb[4], gc[4][3], hx[4][3]; float cs[4], sn[4], k1[4], k2[4];
#pragma unroll
        for (int j = 0; j < 4; ++j) { const int t = t0 + j * F.ts, tc = t < T_ ? t : t0; const int s = tc & (S_ - 1); const bf16_t* p = PROJ + (size_t)tc * PJ;
            gb[j] = *(const v4u*)(p + 1024 + ch0);
#pragma unroll
            for (int k = 0; k < 3; ++k) { const int dt = (2 - k) <= s ? (2 - k) : 0; const bf16_t* q = p - (size_t)dt * PJ; gc[j][k] = *(const v4u*)(q + 1536 + ch0); hx[j][k] = *(const v4u*)(q + 2048 + ch0); }
            const int l16 = lane & 15; cs[j] = COS[tc * 16 + l16]; sn[j] = SIN[tc * 16 + l16]; k1[j] = bf2f(p[768 + l16]); k2[j] = bf2f(p[768 + 16 + l16]); }
#pragma unroll
        for (int j = 0; j < 4; ++j) { const int t = t0 + j * F.ts; if (t < T_) { const int s = t & (S_ - 1);
            f32x4 z0 = (f32x4){0.f, 0.f, 0.f, 0.f}, z1 = z0;
#pragma unroll
            for (int k = 0; k < 3; ++k) { const int dt = 2 - k;
                if (s - dt >= 0) { const v4u g_ = gc[j][k], h_ = hx[j][k];
                    z0 += w0[k] * (f32x4){pg8::bflo(g_.x) * pg8::bflo(h_.x), pg8::bfhi(g_.x) * pg8::bfhi(h_.x), pg8::bflo(g_.y) * pg8::bflo(h_.y), pg8::bfhi(g_.y) * pg8::bfhi(h_.y)};
                    z1 += w1[k] * (f32x4){pg8::bflo(g_.z) * pg8::bflo(h_.z), pg8::bfhi(g_.z) * pg8::bfhi(h_.z), pg8::bflo(g_.w) * pg8::bflo(h_.w), pg8::bfhi(g_.w) * pg8::bfhi(h_.w)}; } }
            const v4u gbv = gb[j];
            const f32x4 y0 = z0 * (f32x4){pg8::bflo(gbv.x), pg8::bfhi(gbv.x), pg8::bflo(gbv.y), pg8::bfhi(gbv.y)}, y1 = z1 * (f32x4){pg8::bflo(gbv.z), pg8::bfhi(gbv.z), pg8::bflo(gbv.w), pg8::bfhi(gbv.w)};
            float ss = (y0[0] * y0[0] + y0[1] * y0[1]) + (y0[2] * y0[2] + y0[3] * y0[3]) + (y1[0] * y1[0] + y1[1] * y1[1]) + (y1[2] * y1[2] + y1[3] * y1[3]);
            ss += __shfl_xor(ss, 1); ss += __shfl_xor(ss, 2); ss += __shfl_xor(ss, 4);
            const float r = rsqrtf(ss * (1.f / 64.f) + EPS_);
            v4u o; o.x = pk2(y0[0] * r, y0[1] * r); o.y = pk2(y0[2] * r, y0[3] * r); o.z = pk2(y1[0] * r, y1[1] * r); o.w = pk2(y1[2] * r, y1[3] * r);
            *(v4u*)(Y + (size_t)t * 1024 + 512 + ch0) = o;
            if (lane < 16) { const unsigned w = pk2(k1[j] * cs[j] - k2[j] * sn[j], k2[j] * cs[j] + k1[j] * sn[j]);
#pragma unroll
                for (int h = 0; h < 8; ++h) *(unsigned*)(Kb + (size_t)t * 768 + h * 96 + 64 + 2 * lane) = w; } } }
    }
}

typedef __bf16 bf16x2_t __attribute__((ext_vector_type(2)));
typedef float f32x2 __attribute__((ext_vector_type(2)));
__device__ __forceinline__ float dot2bf(unsigned a, unsigned b, float c) { return __builtin_amdgcn_fdot2_f32_bf16(__builtin_bit_cast(bf16x2_t, a), __builtin_bit_cast(bf16x2_t, b), c, false); }
template <int CTRL> __device__ __forceinline__ float dppf(float x) { return __builtin_bit_cast(float, __builtin_amdgcn_mov_dpp(__builtin_bit_cast(int, x), CTRL, 0xf, 0xf, true)); }
__device__ __forceinline__ float gelu_fast(float x) {
    const float u = 0.7978845608028654f * (x + 0.044715f * x * x * x);
    return x / (1.f + __expf(-2.f * u));
}
__device__ __forceinline__ float reduce32(float (&p)[32], int lane) {
#pragma unroll
    for (int j = 0; j < 16; ++j) { auto r = __builtin_amdgcn_permlane32_swap(__float_as_uint(p[j]), __float_as_uint(p[j + 16]), false, false); p[j] = __uint_as_float(r[0]) + __uint_as_float(r[1]); }
#pragma unroll
    for (int j = 0; j < 8; ++j) { auto r = __builtin_amdgcn_permlane16_swap(__float_as_uint(p[j]), __float_as_uint(p[j + 8]), false, false); p[j] = __uint_as_float(r[0]) + __uint_as_float(r[1]); }
    const bool b3 = (lane & 8) != 0, b2 = (lane & 4) != 0, b1 = (lane & 2) != 0;
#pragma unroll
    for (int j = 0; j < 4; ++j) { const float keep = b3 ? p[j + 4] : p[j], send = b3 ? p[j] : p[j + 4]; p[j] = keep + dppf<0x128>(send); }
#pragma unroll
    for (int j = 0; j < 2; ++j) { const float keep = b2 ? p[j + 2] : p[j], send = b2 ? p[j] : p[j + 2]; p[j] = keep + dppf<0x141>(send); }
    { const float keep = b1 ? p[1] : p[0], send = b1 ? p[0] : p[1]; p[0] = keep + dppf<0x4E>(send); }
    return p[0] + dppf<0xB1>(p[0]);
}
__device__ __forceinline__ f32x2 fp8lo(unsigned w) { return __builtin_amdgcn_cvt_pk_f32_fp8((int)w, false); }
__device__ __forceinline__ f32x2 fp8hi(unsigned w) { return __builtin_amdgcn_cvt_pk_f32_fp8((int)w, true); }
__device__ __forceinline__ float dot16(const v4u w, const f32x2 (&x)[8]) {
    f32x2 s = fp8lo(w.x) * x[0]; s += fp8hi(w.x) * x[1]; s += fp8lo(w.y) * x[2]; s += fp8hi(w.y) * x[3];
    s += fp8lo(w.z) * x[4]; s += fp8hi(w.z) * x[5]; s += fp8lo(w.w) * x[6]; s += fp8hi(w.w) * x[7];
    return s.x + s.y;
}
__device__ __forceinline__ void axpy16(f32x2 (&acc)[8], float as, const v4u w) {
    const f32x2 a2 = (f32x2){as, as};
    acc[0] += a2 * fp8lo(w.x); acc[1] += a2 * fp8hi(w.x); acc[2] += a2 * fp8lo(w.y); acc[3] += a2 * fp8hi(w.y);
    acc[4] += a2 * fp8lo(w.z); acc[5] += a2 * fp8hi(w.z); acc[6] += a2 * fp8lo(w.w); acc[7] += a2 * fp8hi(w.w);
}
constexpr size_t WS_RSTD2 = 105 * MiB + 512 * 1024;
constexpr size_t WS_ACT = 240 * MiB;
template <int CTRL> __device__ __forceinline__ int dppi(int x) { return __builtin_amdgcn_mov_dpp(x, CTRL, 0xf, 0xf, true); }
__device__ __forceinline__ int reduce32i(int (&p)[32], int lane) {
#pragma unroll
    for (int j = 0; j < 16; ++j) { auto r = __builtin_amdgcn_permlane32_swap((unsigned)p[j], (unsigned)p[j + 16], false, false); p[j] = (int)(r[0] + r[1]); }
#pragma unroll
    for (int j = 0; j < 8; ++j) { auto r = __builtin_amdgcn_permlane16_swap((unsigned)p[j], (unsigned)p[j + 8], false, false); p[j] = (int)(r[0] + r[1]); }
    const bool b3 = (lane & 8) != 0, b2 = (lane & 4) != 0, b1 = (lane & 2) != 0;
#pragma unroll
    for (int j = 0; j < 4; ++j) { const int keep = b3 ? p[j + 4] : p[j], send = b3 ? p[j] : p[j + 4]; p[j] = keep + dppi<0x128>(send); }
#pragma unroll
    for (int j = 0; j < 2; ++j) { const int keep = b2 ? p[j + 2] : p[j], send = b2 ? p[j] : p[j + 2]; p[j] = keep + dppi<0x141>(send); }
    { const int keep = b1 ? p[1] : p[0], send = b1 ? p[0] : p[1]; p[0] = keep + dppi<0x4E>(send); }
    return p[0] + dppi<0xB1>(p[0]);
}
__device__ __forceinline__ int dot16i(const v4u w, const v4u x) {
    return __builtin_amdgcn_sdot4((int)w.w, (int)x.w, __builtin_amdgcn_sdot4((int)w.z, (int)x.z, __builtin_amdgcn_sdot4((int)w.y, (int)x.y, __builtin_amdgcn_sdot4((int)w.x, (int)x.x, 0, false), false), false), false);
}
__device__ __forceinline__ float reduce16h(float (&p)[16], int lane) {
#pragma unroll
    for (int j = 0; j < 8; ++j) { auto r = __builtin_amdgcn_permlane16_swap(__float_as_uint(p[j]), __float_as_uint(p[j + 8]), false, false); p[j] = __uint_as_float(r[0]) + __uint_as_float(r[1]); }
    const bool b3 = (lane & 8) != 0, b2 = (lane & 4) != 0, b1 = (lane & 2) != 0;
#pragma unroll
    for (int j = 0; j < 4; ++j) { const float keep = b3 ? p[j + 4] : p[j], send = b3 ? p[j] : p[j + 4]; p[j] = keep + dppf<0x128>(send); }
#pragma unroll
    for (int j = 0; j < 2; ++j) { const float keep = b2 ? p[j + 2] : p[j], send = b2 ? p[j] : p[j + 2]; p[j] = keep + dppf<0x141>(send); }
    { const float keep = b1 ? p[1] : p[0], send = b1 ? p[0] : p[1]; p[0] = keep + dppf<0x4E>(send); }
    return p[0] + dppf<0xB1>(p[0]);
}
typedef int v8i_t __attribute__((ext_vector_type(8)));
typedef float v4f_t __attribute__((ext_vector_type(4)));
__device__ __forceinline__ void p_peer_u(Frame& F, const Args& a) {
    const bf16_t* H2 = (const bf16_t*)(F.ws + WS_RA); const float* parts = (const float*)(F.ws + PSS6_OFF);
    const unsigned char* UT4 = F.ws + WS_UT; const float* SU = (const float*)(F.ws + WS_SCL); const float* SV = SU + 16384;
    float* ACT = (float*)(F.ws + WS_ACT); int* RI = (int*)(F.ws + WS_RIDX); const float* RG = (const float*)(F.ws + WS_RGATE);
    int lane = __builtin_amdgcn_mbcnt_hi(~0u, __builtin_amdgcn_mbcnt_lo(~0u, 0u)); asm volatile("" : "+v"(lane));
    LAS unsigned char* wb = F.lds + RING_OFF + F.wave * 17408;
    LAS int* fpl = (LAS int*)wb; LAS unsigned char* xw = wb + 512; LAS int* li = (LAS int*)(wb + 512 + 8192); LAS float* lg = (LAS float*)(wb + 512 + 8192 + 4096); LAS float* ls = (LAS float*)(wb + 512 + 8192 + 8192);
    const int xoff = 32 * ((lane & 7) + 8 * (lane >> 5)) + 16 * ((lane >> 4) & 1);
    const int coff = ((lane & 7) + 8 * (lane >> 4)) * 16; const int bsel = (lane & 8) ? 128 : 0;
    const int slot = 2 * ((lane >> 1) & 15) + (lane >> 5), sub = slot & 15; const bool second = slot >= 16;
    const bool dvalid = ((lane & 15) >> 2) == (lane >> 4), dr1 = (lane & 1) != 0, dr2 = (lane & 2) != 0;
#pragma unroll 1
    for (int base = F.tb; base < T_; base += 8 * F.NGW) {
      int i0a[8], i1a[8]; float g0a[8], g1a[8], spa[8]; v4u ha[8][2];
#pragma unroll
      for (int k = 0; k < 8; ++k) { const int t_ = base + k * F.ts, tc = t_ < T_ ? t_ : base;
          i0a[k] = RI[(size_t)tc * 128 + lane]; i1a[k] = RI[(size_t)tc * 128 + 64 + lane]; g0a[k] = RG[(size_t)tc * 128 + lane]; g1a[k] = RG[(size_t)tc * 128 + 64 + lane];
          spa[k] = (lane < 16) ? parts[(size_t)lane * T_ + tc] : 0.f;
          ha[k][0] = *(const v4u*)(H2 + (size_t)tc * 1024 + lane * 16); ha[k][1] = *(const v4u*)(H2 + (size_t)tc * 1024 + lane * 16 + 8); }
#define PU_PRE(k) do { const int t = base + (k) * F.ts; const bool tv = t < T_; \
          const int i0 = tv ? i0a[k] : 0, i1 = tv ? i1a[k] : 0; const float g0 = tv ? g0a[k] : 0.f, g1 = tv ? g1a[k] : 0.f; \
          int pos0 = -1, pos1 = -1, ov0 = 0, ov1 = 0, ovf = 0, fre = 0; \
          _Pragma("unroll") for (int q = 0; q < 8; ++q) { \
              const bool m0 = (i0 >> 11) == q, m1 = (i1 >> 11) == q; \
              const unsigned long long b0 = __ballot(m0), b1 = __ballot(m1); \
              const int c0 = __popcll(b0), c1 = __popcll(b1), nq = c0 + c1; \
              const int r0 = (int)__builtin_amdgcn_mbcnt_hi((unsigned)(b0 >> 32), __builtin_amdgcn_mbcnt_lo((unsigned)b0, 0u)); \
              const int r1 = c0 + (int)__builtin_amdgcn_mbcnt_hi((unsigned)(b1 >> 32), __builtin_amdgcn_mbcnt_lo((unsigned)b1, 0u)); \
              if (m0) { if (r0 < 16) pos0 = 16 * q + r0; else ov0 = ovf + (r0 - 16); } \
              if (m1) { if (r1 < 16) pos1 = 16 * q + r1; else ov1 = ovf + (r1 - 16); } \
              const int fq = nq < 16 ? 16 - nq : 0; \
              if (lane < fq) fpl[fre + lane] = 16 * q + nq + lane; \
              ovf += nq > 16 ? nq - 16 : 0; fre += fq; } \
          const float sp = wsum(spa[k]); \
          const v4u h = ha[k][0], g = ha[k][1]; \
          float am = fmaxf(fmaxf(fmaxf(fabsf(pg8::bflo(h.x)), fabsf(pg8::bfhi(h.x))), fmaxf(fabsf(pg8::bflo(h.y)), fabsf(pg8::bfhi(h.y)))), fmaxf(fmaxf(fabsf(pg8::bflo(h.z)), fabsf(pg8::bfhi(h.z))), fmaxf(fabsf(pg8::bflo(h.w)), fabsf(pg8::bfhi(h.w))))); \
          am = fmaxf(am, fmaxf(fmaxf(fmaxf(fabsf(pg8::bflo(g.x)), fabsf(pg8::bfhi(g.x))), fmaxf(fabsf(pg8::bflo(g.y)), fabsf(pg8::bfhi(g.y)))), fmaxf(fmaxf(fabsf(pg8::bflo(g.z)), fabsf(pg8::bfhi(g.z))), fmaxf(fabsf(pg8::bflo(g.w)), fabsf(pg8::bfhi(g.w)))))); \
          am = wave_max(am); \
          const float qs = am > 0.f ? 440.f / am : 0.f; v4u xq; \
          { int w = 0; w = __builtin_amdgcn_cvt_pk_fp8_f32(pg8::bflo(h.x) * qs, pg8::bfhi(h.x) * qs, w, false); w = __builtin_amdgcn_cvt_pk_fp8_f32(pg8::bflo(h.y) * qs, pg8::bfhi(h.y) * qs, w, true); xq.x = (unsigned)w; } \
          { int w = 0; w = __builtin_amdgcn_cvt_pk_fp8_f32(pg8::bflo(h.z) * qs, pg8::bfhi(h.z) * qs, w, false); w = __builtin_amdgcn_cvt_pk_fp8_f32(pg8::bflo(h.w) * qs, pg8::bfhi(h.w) * qs, w, true); xq.y = (unsigned)w; } \
          { int w = 0; w = __builtin_amdgcn_cvt_pk_fp8_f32(pg8::bflo(g.x) * qs, pg8::bfhi(g.x) * qs, w, false); w = __builtin_amdgcn_cvt_pk_fp8_f32(pg8::bflo(g.y) * qs, pg8::bfhi(g.y) * qs, w, true); xq.z = (unsigned)w; } \
          { int w = 0; w = __builtin_amdgcn_cvt_pk_fp8_f32(pg8::bflo(g.z) * qs, pg8::bfhi(g.z) * qs, w, false); w = __builtin_amdgcn_cvt_pk_fp8_f32(pg8::bflo(g.w) * qs, pg8::bfhi(g.w) * qs, w, true); xq.w = (unsigned)w; } \
          *(LAS v4u*)(xw + (k) * 1024 + lane * 16) = xq; \
          asm volatile("s_waitcnt lgkmcnt(0)" ::: "memory"); \
          if (pos0 < 0) pos0 = fpl[ov0]; \
          if (pos1 < 0) pos1 = fpl[ov1]; \
          asm volatile("s_waitcnt lgkmcnt(0)" ::: "memory"); \
          li[(k) * 128 + pos0] = i0; li[(k) * 128 + pos1] = i1; lg[(k) * 128 + pos0] = g0; lg[(k) * 128 + pos1] = g1; \
          if (tv) { RI[(size_t)t * 128 + pos0] = i0; RI[(size_t)t * 128 + pos1] = i1; } \
          if (lane == 0) ls[k] = rsqrtf(sp * (1.f / 1024.f) + EPS_) * (am * (1.f / 440.f)); } while (0)
#define PU_B(d, kk) do { const v4u q0_ = *(const LAS v4u*)(xw + (kk) * 1024 + xoff), q1_ = *(const LAS v4u*)(xw + (kk) * 1024 + xoff + 512); \
        d = (v8i_t){(int)q0_.x, (int)q0_.y, (int)q0_.z, (int)q0_.w, (int)q1_.x, (int)q1_.y, (int)q1_.z, (int)q1_.w}; } while (0)
#define PU_DIAG(D) ({ const float t01_ = dr1 ? (D).y : (D).x, t23_ = dr1 ? (D).w : (D).z; const float t_ = dr2 ? t23_ : t01_; dvalid ? t_ : 0.f; })
#define PU_MMA(m, B) do { const v8i_t a_ = (v8i_t){(int)bufs[m].x, (int)bufs[m].y, (int)bufs[m].z, (int)bufs[m].w, 0, 0, 0, 0}; const v4f_t z_ = (v4f_t){0.f, 0.f, 0.f, 0.f}; \
        const v4f_t d_ = __builtin_amdgcn_mfma_scale_f32_16x16x128_f8f6f4(a_, B, z_, 4, 0, 0, 0, 0, 0); p[m] = PU_DIAG(d_); } while (0)
#define PU_BA(pp, j) \
        const int kk_ = 2 * (j) + (second ? 1 : 0); const int tt = base + kk_ * F.ts; \
        const int idxv = li[kk_ * 128 + (pp) * 16 + sub]; const float gatev = lg[kk_ * 128 + (pp) * 16 + sub]; const float rstd = ls[kk_]; \
        v4u bufs[16]; \
        _Pragma("unroll") for (int m = 0; m < 16; ++m) { const int e_ = __builtin_amdgcn_ds_bpermute(8 * m + bsel, idxv); bufs[m] = *(const v4u*)(UT4 + (size_t)e_ * 512 + coff); } \
        const float su = SU[idxv], sv = SV[idxv];
#define PU_BB(pp, j) do { \
        v8i_t BA, BB; PU_B(BA, 2 * (j)); PU_B(BB, 2 * (j) + 1); \
        float p[16]; \
        _Pragma("unroll") for (int m = 0; m < 8; ++m) PU_MMA(m, BA); \
        _Pragma("unroll") for (int m = 8; m < 16; ++m) PU_MMA(m, BB); \
        const float dt = reduce16h(p, lane); \
        if ((lane & 1) == 0 && tt < T_) ACT[(size_t)tt * 128 + (pp) * 16 + sub] = gelu_fast(dt * su * rstd) * gatev * sv; } while (0)
      PU_PRE(0); PU_PRE(1);
      { PU_BA(0, 0); PU_PRE(2); PU_PRE(3); PU_BB(0, 0); }
      { PU_BA(0, 1); PU_PRE(4); PU_PRE(5); PU_BB(0, 1); }
      { PU_BA(0, 2); PU_PRE(6); PU_PRE(7); PU_BB(0, 2); }
      { PU_BA(0, 3); PU_BB(0, 3); }
#pragma unroll 1
      for (int n = 4; n < 32; ++n) { const int pp = n >> 2, j = n & 3; PU_BA(pp, j); PU_BB(pp, j); }
#undef PU_PRE
#undef PU_B
#undef PU_DIAG
#undef PU_MMA
#undef PU_BA
#undef PU_BB
    }
}
typedef int v2i_t __attribute__((ext_vector_type(2)));
typedef unsigned v2u_t __attribute__((ext_vector_type(2)));
__device__ __forceinline__ void p_peer_v(Frame& F, const Args& a) {
    const bf16_t* H2 = (const bf16_t*)(F.ws + WS_RA); const unsigned char* VT4 = F.ws + WS_VT;
    const int* SE = (const int*)(F.ws + WS_RIDX); const float* ACT = (const float*)(F.ws + WS_ACT);
    const float* gfin = (const float*)a.in[22]; float* out = a.out;
    int lane = __builtin_amdgcn_mbcnt_hi(~0u, __builtin_amdgcn_mbcnt_lo(~0u, 0u)); asm volatile("" : "+v"(lane));
    const int w = F.wave, g = lane >> 4;
    constexpr int RP = 72, WST = 128 * RP, IDX_OFF = 8 * WST, SB = 128 * 520, A8_OFF = 2 * SB, SA_OFF = A8_OFF + 8192, TPITCH = 1040;
    static_assert(IDX_OFF + 64 * 128 * 4 <= A8_OFF && SB <= IDX_OFF && SA_OFF + 256 <= LDS_BYTES, "V phase LDS");
    LAS unsigned char* lds = F.lds;
    LAS unsigned char* stg = lds + w * WST;
    LAS int* idxl = (LAS int*)(lds + IDX_OFF);
    LAS unsigned char* wptr = stg + (lane >> 2) * RP + (lane & 3) * 16;
    LAS unsigned char* rptr = stg + (64 * (g >> 1) + 16 * (g & 1) + (lane & 15)) * RP;
    const unsigned char* vsl = VT4 + 64 * w + (lane & 3) * 16;
    const bool va0 = (lane & 15) == g, va1 = (lane & 15) == 4 + g, vb0 = (lane & 15) == 8 + g, vb1 = (lane & 15) == 12 + g;
#pragma unroll 1
    for (int k0 = 0; F.gw + k0 * F.NGW < T_; k0 += 8) {
        __syncthreads();
        { int lane = __builtin_amdgcn_mbcnt_hi(~0u, __builtin_amdgcn_mbcnt_lo(~0u, 0u)); asm volatile("" : "+v"(lane));
          float a0v[8], a1v[8]; int e0v[8], e1v[8];
#pragma unroll
          for (int k = 0; k < 8; ++k) { const int t = F.tb + (k0 + k) * F.ts; const bool tv = t < T_; const int tc = tv ? t : F.tb;
              const float x0 = ACT[(size_t)tc * 128 + lane], x1 = ACT[(size_t)tc * 128 + 64 + lane]; a0v[k] = tv ? x0 : 0.f; a1v[k] = tv ? x1 : 0.f;
              e0v[k] = SE[(size_t)tc * 128 + lane]; e1v[k] = SE[(size_t)tc * 128 + 64 + lane]; }
#pragma unroll
          for (int k = 0; k < 8; ++k) {
              const float am = wave_max(fmaxf(fabsf(a0v[k]), fabsf(a1v[k]))); const float qs = am > 0.f ? 240.f / am : 0.f;
              const int pk = __builtin_amdgcn_cvt_pk_fp8_f32(a0v[k] * qs, a1v[k] * qs, 0, false);
              LAS unsigned char* d8 = lds + A8_OFF + (w * 8 + k) * 128;
              d8[lane] = (unsigned char)(pk & 0xff); d8[64 + lane] = (unsigned char)((pk >> 8) & 0xff);
              idxl[(w * 8 + k) * 128 + lane] = e0v[k]; idxl[(w * 8 + k) * 128 + 64 + lane] = e1v[k];
              if (lane == 0) ((LAS float*)(lds + SA_OFF))[w * 8 + k] = am * (1.f / 240.f); } }
#define PV_ROWS(BUF, r_) do { const int rr_ = (r_); const int kt_ = 2 * (sg0 + ((rr_ >> 1) & 1)) + (rr_ & 1); const LAS int* ip_ = idxl + kt_ * 128 + (rr_ >> 2) * 16 + (lane >> 2); \
            _Pragma("unroll") for (int j = 0; j < 8; ++j) { const int e_ = ip_[j * 1024]; BUF[j] = *(const v4u*)(vsl + (size_t)e_ * 512); } } while (0)
#define PV_LAMB0(j) (32 * (2 * ((j) >> 2) + ((j) & 1)) + 16 * (((j) >> 1) & 1))
#define PV_ROUND(ACC, BUF, rr_, c_) do { const int r_ = (rr_); if (r_ < 32) { const int p_ = r_ >> 2; constexpr int hh_ = (c_) & 1; const int sg_ = sg0 + ((c_) >> 1); \
            _Pragma("unroll") for (int j = 0; j < 8; ++j) { *(LAS v2u_t*)(wptr + PV_LAMB0(j) * RP) = (v2u_t){BUF[j].x, BUF[j].y}; *(LAS v2u_t*)(wptr + PV_LAMB0(j) * RP + 8) = (v2u_t){BUF[j].z, BUF[j].w}; } \
            if (r_ + 3 < 32) PV_ROWS(BUF, r_ + 3); \
            { const v4u q1_ = *(const LAS v4u*)(lds + A8_OFF + (g * 8 + 2 * sg_ + hh_) * 128 + p_ * 16); \
              const v4u q2_ = *(const LAS v4u*)(lds + A8_OFF + ((4 + g) * 8 + 2 * sg_ + hh_) * 128 + p_ * 16); \
              const bool s1_ = hh_ ? vb0 : va0, s2_ = hh_ ? vb1 : va1; \
              const v8i_t A_ = (v8i_t){s1_ ? (int)q1_.x : 0, s1_ ? (int)q1_.y : 0, s1_ ? (int)q1_.z : 0, s1_ ? (int)q1_.w : 0, s2_ ? (int)q2_.x : 0, s2_ ? (int)q2_.y : 0, s2_ ? (int)q2_.z : 0, s2_ ? (int)q2_.w : 0}; \
              _Pragma("unroll") for (int n = 0; n < 8; ++n) { \
                  const v2i_t r0_ = __builtin_amdgcn_ds_read_tr4_b64_v2i32((LAS v2i_t*)(rptr + 8 * n)); \
                  const v2i_t r1_ = __builtin_amdgcn_ds_read_tr4_b64_v2i32((LAS v2i_t*)(rptr + 8 * n + 32 * RP)); \
                  const v8i_t B_ = (v8i_t){r0_.x, r0_.y, r1_.x, r1_.y, 0, 0, 0, 0}; \
                  ACC[n] = __builtin_amdgcn_mfma_scale_f32_16x16x128_f8f6f4(A_, B_, ACC[n], 0, 4, 0, 0, 0, 0); } } } } while (0)
#define PV_FINSET(ACC, sg_) do { \
            int fl_ = __builtin_amdgcn_mbcnt_hi(~0u, __builtin_amdgcn_mbcnt_lo(~0u, 0u)); asm volatile("" : "+v"(fl_)); const int fg_ = fl_ >> 4, fj_ = fl_ & 15;     \
            LAS float* tile_ = (LAS float*)(F.lds); const LAS float* sa_ = (const LAS float*)(F.lds + SA_OFF); \
            _Pragma("unroll") for (int r = 0; r < 4; ++r) { const int m_ = 4 * fg_ + r; const float sc_ = sa_[(m_ & 7) * 8 + 2 * (sg_) + (m_ >> 3)]; \
                _Pragma("unroll") for (int n = 0; n < 8; ++n) tile_[m_ * TPITCH + 128 * F.wave + 16 * n + fj_] = ACC[n][r] * sc_; } \
            v4u hh0_[2], hh1_[2]; \
            _Pragma("unroll") for (int kk = 0; kk < 2; ++kk) { const int t_ = F.tb + (k0 + 2 * (sg_) + kk) * F.ts; const int tc_ = t_ < T_ ? t_ : F.tb; \
                hh0_[kk] = *(const v4u*)(H2 + (size_t)tc_ * 1024 + fl_ * 16); hh1_[kk] = *(const v4u*)(H2 + (size_t)tc_ * 1024 + fl_ * 16 + 8); } \
            __syncthreads(); \
            _Pragma("unroll") for (int kk = 0; kk < 2; ++kk) { const int t_ = F.tb + (k0 + 2 * (sg_) + kk) * F.ts; \
                if (t_ < T_) { const LAS f32x4* row_ = (const LAS f32x4*)(tile_ + (8 * kk + F.wave) * TPITCH + fl_ * 16); \
                    const v4u h0 = hh0_[kk], h1 = hh1_[kk]; \
                    f32x4 v0 = row_[0], v1 = row_[1], v2 = row_[2], v3 = row_[3]; \
                    v0 += (f32x4){pg8::bflo(h0.x), pg8::bfhi(h0.x), pg8::bflo(h0.y), pg8::bfhi(h0.y)}; v1 += (f32x4){pg8::bflo(h0.z), pg8::bfhi(h0.z), pg8::bflo(h0.w), pg8::bfhi(h0.w)}; \
                    v2 += (f32x4){pg8::bflo(h1.x), pg8::bfhi(h1.x), pg8::bflo(h1.y), pg8::bfhi(h1.y)}; v3 += (f32x4){pg8::bflo(h1.z), pg8::bfhi(h1.z), pg8::bflo(h1.w), pg8::bfhi(h1.w)}; \
                    float ss = (v0.x * v0.x + v0.y * v0.y) + (v0.z * v0.z + v0.w * v0.w) + (v1.x * v1.x + v1.y * v1.y) + (v1.z * v1.z + v1.w * v1.w) \
                             + (v2.x * v2.x + v2.y * v2.y) + (v2.z * v2.z + v2.w * v2.w) + (v3.x * v3.x + v3.y * v3.y) + (v3.z * v3.z + v3.w * v3.w); \
                    ss = wsum(ss); const float rr = rsqrtf(ss * (1.f / 1024.f) + EPS_); float* o_ = out + (size_t)t_ * 1024 + fl_ * 16; \
                    const f32x4 g0 = *(const f32x4*)(gfin + fl_ * 16), g1 = *(const f32x4*)(gfin + fl_ * 16 + 4), g2 = *(const f32x4*)(gfin + fl_ * 16 + 8), g3 = *(const f32x4*)(gfin + fl_ * 16 + 12); \
                    *(f32x4*)(o_) = v0 * rr * g0; *(f32x4*)(o_ + 4) = v1 * rr * g1; *(f32x4*)(o_ + 8) = v2 * rr * g2; *(f32x4*)(o_ + 12) = v3 * rr * g3; } } } while (0)
#pragma unroll 1
        for (int sg0 = 0; sg0 < 4; sg0 += 2) {
            v4f_t accA[8], accB[8];
#pragma unroll
            for (int n = 0; n < 8; ++n) { accA[n] = (v4f_t){0.f, 0.f, 0.f, 0.f}; accB[n] = accA[n]; }
            v4u bf0[8], bf1[8], bf2[8];
            __syncthreads();
            PV_ROWS(bf0, 0); PV_ROWS(bf1, 1); PV_ROWS(bf2, 2);
#pragma unroll 1
            for (int rb = 0; rb < 36; rb += 12) {
                PV_ROUND(accA, bf0, rb + 0, 0); PV_ROUND(accA, bf1, rb + 1, 1); PV_ROUND(accB, bf2, rb + 2, 2); PV_ROUND(accB, bf0, rb + 3, 3);
                PV_ROUND(accA, bf1, rb + 4, 0); PV_ROUND(accA, bf2, rb + 5, 1); PV_ROUND(accB, bf0, rb + 6, 2); PV_ROUND(accB, bf1, rb + 7, 3);
                PV_ROUND(accA, bf2, rb + 8, 0); PV_ROUND(accA, bf0, rb + 9, 1); PV_ROUND(accB, bf1, rb + 10, 2); PV_ROUND(accB, bf2, rb + 11, 3); }
            asm volatile("s_waitcnt lgkmcnt(0)" ::: "memory"); __builtin_amdgcn_s_barrier();
            PV_FINSET(accA, sg0); __syncthreads(); PV_FINSET(accB, sg0 + 1);
        }
#undef PV_LAMB0
#undef PV_ROWS
#undef PV_ROUND
#undef PV_FINSET
    }
}

namespace mla {
typedef short bf16x8 __attribute__((ext_vector_type(8)));
typedef short s16x4 __attribute__((ext_vector_type(4)));
typedef float f32x16 __attribute__((ext_vector_type(16)));
typedef unsigned u32x4 __attribute__((ext_vector_type(4)));
constexpr int KSLOT = 12288, VSLOT = 8192;
constexpr int L_K = 0, L_V = 2 * KSLOT, L_WS = L_V + 2 * VSLOT, L_ST = L_WS + 8 * 256, L_END = L_ST + 8 * 8192;
__device__ __forceinline__ int crow(int r, int hi) { return (r & 3) + 8 * (r >> 2) + 4 * hi; }
__device__ __forceinline__ unsigned cvtpk(float lo, float hi) { typedef float f2 __attribute__((ext_vector_type(2))); typedef __bf16 b2 __attribute__((ext_vector_type(2))); f2 v = {lo, hi}; b2 b = __builtin_convertvector(v, b2); return __builtin_bit_cast(unsigned, b); }
__device__ __forceinline__ s16x4 vtr(const LAS unsigned char* p) { typedef short v4i16_t __attribute__((ext_vector_type(4))); return __builtin_bit_cast(s16x4, __builtin_amdgcn_ds_read_tr16_b64_v4i16((LAS v4i16_t*)p)); }

template <int THRL>
__device__ __forceinline__ void unit(int b, int h, int qb, const bf16_t* Q, const bf16_t* K, const bf16_t* V, bf16_t* Y, LAS unsigned char* lds, int wid, int lane) {
    const int r32 = lane & 31, hi = lane >> 5;
    const long rowbase = (long)b * S_; const int q0 = qb * 256;
    const bf16_t* Qw = Q + (size_t)(rowbase + q0 + wid * 32 + r32) * 768 + h * 96 + hi * 8;
    bf16x8 qr[6];
#pragma unroll
    for (int d0 = 0; d0 < 6; ++d0) qr[d0] = *(const bf16x8*)(Qw + d0 * 16);
    const bf16_t* Kh = K + (size_t)rowbase * 768 + h * 96; const bf16_t* Vh = V + (size_t)rowbase * 512 + h * 64;
    const bf16_t* ksrc0 = Kh + (size_t)lane * 768 + wid * 8;
    const bf16_t* vsrc = Vh + (size_t)(16 * (wid & 3) + (lane >> 2)) * 512 + (wid >> 2) * 32 + (lane & 3) * 8;
    const int NT = (q0 + 256) / 64;
#define MLA_DMA(t, slot) do { \
        __builtin_amdgcn_global_load_lds((const unsigned*)(ksrc0 + (size_t)(t) * 64 * 768), (LAS unsigned*)(lds + L_K + (slot) * KSLOT + wid * 1024), 16, 0, 0); \
        if (wid < 4) __builtin_amdgcn_global_load_lds((const unsigned*)(ksrc0 + (size_t)(t) * 64 * 768 + 64), (LAS unsigned*)(lds + L_K + (slot) * KSLOT + (wid + 8) * 1024), 16, 0, 0); \
        __builtin_amdgcn_global_load_lds((const unsigned*)(vsrc + (size_t)(t) * 64 * 512), (LAS unsigned*)(lds + L_V + (slot) * VSLOT + wid * 1024), 16, 0, 0); } while (0)
    LAS float* wsf = (LAS float*)(lds + L_WS) + wid * 64;
    float m = -INFINITY, l_reg = 0.f;
    f32x16 o0 = f32x16{}, o1 = f32x16{};
    const int qrel = wid * 32 + r32;
    MLA_DMA(0, 0);
#define MLA_MAX3(a_, b_, c_) ({ float r_; asm("v_max3_f32 %0, %1, %2, %3" : "=v"(r_) : "v"(a_), "v"(b_), "v"(c_)); r_; })
#define MLA_BODY(MASK) do { \
        asm volatile("s_waitcnt vmcnt(0)" ::: "memory"); \
        __builtin_amdgcn_s_barrier(); \
        asm volatile("" ::: "memory"); \
        if (t + 1 < NT) MLA_DMA(t + 1, (t + 1) & 1); \
        const int jb = t - (NT - 4); \
        if (MASK && 64 * jb > 32 * wid + 31) continue;                        \
        const LAS unsigned char* kb = lds + L_K + (t & 1) * KSLOT + hi * 1024 + r32 * 16; \
        const bool mfin = m > -INFINITY; const float mneg = mfin ? -m : 0.f; \
        f32x16 p0, p1; \
        _Pragma("unroll") for (int r = 0; r < 16; ++r) { p0[r] = mneg; p1[r] = mneg; } \
        __builtin_amdgcn_s_setprio(2); \
        _Pragma("unroll") for (int d0 = 0; d0 < 6; ++d0) { \
            const bf16x8 a0 = *(const LAS bf16x8*)(kb + d0 * 2048), a1 = *(const LAS bf16x8*)(kb + d0 * 2048 + 512); \
            p0 = __builtin_amdgcn_mfma_f32_32x32x16_bf16(a0, qr[d0], p0, 0, 0, 0); \
            p1 = __builtin_amdgcn_mfma_f32_32x32x16_bf16(a1, qr[d0], p1, 0, 0, 0); } \
        __builtin_amdgcn_s_setprio(0); \
        if (MASK) { const int kbase = 64 * jb + 4 * hi; \
            _Pragma("unroll") for (int r = 0; r < 16; ++r) { const int kv = kbase + (r & 3) + 8 * (r >> 2); if (kv > qrel) p0[r] = -INFINITY; if (kv + 32 > qrel) p1[r] = -INFINITY; } } \
        float rm = MLA_MAX3(p0[0], p1[0], p0[1]); rm = fmaxf(rm, p1[1]); \
        _Pragma("unroll") for (int r = 2; r < 16; ++r) rm = MLA_MAX3(rm, p0[r], p1[r]); \
        { auto rr = __builtin_amdgcn_permlane32_swap(__float_as_uint(rm), __float_as_uint(rm), false, false); rm = fmaxf(__uint_as_float(rr[0]), __uint_as_float(rr[1])); } \
        if (__any(!mfin || rm > (float)THRL)) {                                 \
            const float up_ = mfin ? fmaxf(rm, 0.f) : rm;                        \
            const float f = mfin ? __builtin_amdgcn_exp2f(-up_) : 0.f; m = (mfin ? m : 0.f) + up_; l_reg *= f; \
            if (hi == 0) wsf[r32] = f; \
            asm volatile("s_waitcnt lgkmcnt(0)" ::: "memory"); \
            _Pragma("unroll") for (int r = 0; r < 16; ++r) { const float fr_ = wsf[crow(r, hi)]; o0[r] *= fr_; o1[r] *= fr_; p0[r] -= up_; p1[r] -= up_; } \
        } \
        float sacc = 0.f; \
        _Pragma("unroll") for (int r = 0; r < 16; ++r) { p0[r] = __builtin_amdgcn_exp2f(p0[r]); p1[r] = __builtin_amdgcn_exp2f(p1[r]); sacc += p0[r] + p1[r]; } \
        l_reg += sacc; \
        u32x4 pw[4]; \
        _Pragma("unroll") for (int s = 0; s < 2; ++s) { \
            pw[s] = (u32x4){cvtpk(p0[8 * s], p0[8 * s + 1]), cvtpk(p0[8 * s + 2], p0[8 * s + 3]), cvtpk(p0[8 * s + 4], p0[8 * s + 5]), cvtpk(p0[8 * s + 6], p0[8 * s + 7])}; \
            pw[2 + s] = (u32x4){cvtpk(p1[8 * s], p1[8 * s + 1]), cvtpk(p1[8 * s + 2], p1[8 * s + 3]), cvtpk(p1[8 * s + 4], p1[8 * s + 5]), cvtpk(p1[8 * s + 6], p1[8 * s + 7])}; } \
        const LAS unsigned char* vb = lds + L_V + (t & 1) * VSLOT + ((lane >> 4) & 1) * 32 + (lane & 3) * 8 + (4 * hi + ((lane & 15) >> 2)) * 64; \
        __builtin_amdgcn_s_setprio(2); \
        _Pragma("unroll") for (int s = 0; s < 4; ++s) { \
            const s16x4 lo0 = vtr(vb + s * 1024), hi0 = vtr(vb + s * 1024 + 512), lo1 = vtr(vb + 4096 + s * 1024), hi1 = vtr(vb + 4096 + s * 1024 + 512); \
            const bf16x8 pa = __builtin_bit_cast(bf16x8, pw[s]); \
            o0 = __builtin_amdgcn_mfma_f32_32x32x16_bf16(pa, (bf16x8){lo0[0], lo0[1], lo0[2], lo0[3], hi0[0], hi0[1], hi0[2], hi0[3]}, o0, 0, 0, 0); \
            o1 = __builtin_amdgcn_mfma_f32_32x32x16_bf16(pa, (bf16x8){lo1[0], lo1[1], lo1[2], lo1[3], hi1[0], hi1[1], hi1[2], hi1[3]}, o1, 0, 0, 0); } \
        __builtin_amdgcn_s_setprio(0); } while (0)
    int t = 0;
#pragma unroll 1
    for (; t < NT - 4; ++t) { MLA_BODY(0); }
#pragma unroll 1
    for (; t < NT; ++t) { MLA_BODY(1); }
#undef MLA_BODY
#undef MLA_MAX3
#undef MLA_DMA
    { auto rr = __builtin_amdgcn_permlane32_swap(__float_as_uint(l_reg), __float_as_uint(l_reg), false, false); l_reg = __uint_as_float(rr[0]) + __uint_as_float(rr[1]); }
    if (hi == 0) wsf[32 + r32] = l_reg;
    asm volatile("s_waitcnt lgkmcnt(0)" ::: "memory");
    LAS float* stg = (LAS float*)(lds + L_ST + wid * 8192);
#pragma unroll
    for (int r = 0; r < 16; ++r) { const int orow = crow(r, hi); const float rl = __builtin_amdgcn_rcpf(wsf[32 + orow]); stg[orow * 64 + r32] = o0[r] * rl; stg[orow * 64 + 32 + r32] = o1[r] * rl; }
    asm volatile("s_waitcnt lgkmcnt(0)" ::: "memory");
    bf16_t* Yw = Y + (size_t)(rowbase + q0 + wid * 32) * 1024 + h * 64;
#pragma unroll
    for (int i = 0; i < 4; ++i) {
        const int row = i * 8 + (lane >> 3), ch = lane & 7;
        const f32x4 a = *(const LAS f32x4*)(stg + row * 64 + ch * 8), c = *(const LAS f32x4*)(stg + row * 64 + ch * 8 + 4);
        float ss = (a[0] * a[0] + a[1] * a[1]) + (a[2] * a[2] + a[3] * a[3]) + (c[0] * c[0] + c[1] * c[1]) + (c[2] * c[2] + c[3] * c[3]);
        ss += __shfl_xor(ss, 1); ss += __shfl_xor(ss, 2); ss += __shfl_xor(ss, 4);
        const float rs = rsqrtf(ss * (1.f / 64.f) + EPS_);
        u32x4 w; w.x = cvtpk(a[0] * rs, a[1] * rs); w.y = cvtpk(a[2] * rs, a[3] * rs); w.z = cvtpk(c[0] * rs, c[1] * rs); w.w = cvtpk(c[2] * rs, c[3] * rs);
        *(u32x4*)(Yw + (size_t)row * 1024 + ch * 8) = w;
    }
    asm volatile("s_waitcnt lgkmcnt(0)" ::: "memory");
    __builtin_amdgcn_s_barrier();
    asm volatile("" ::: "memory");
}
}

namespace rt {
typedef short bf16x8 __attribute__((ext_vector_type(8)));
typedef float f32x16 __attribute__((ext_vector_type(16)));
__device__ __forceinline__ int mono(float f) { const int b = __float_as_int(f); return b ^ ((b >> 31) & 0x7fffffff); }
__device__ __forceinline__ float unmono(int k) { return __int_as_float(k ^ ((k >> 31) & 0x7fffffff)); }
template <int N> __device__ __forceinline__ void bitonic_sort_desc(int (&k)[N]) {
#pragma unroll
    for (int size = 2; size <= N; size <<= 1)
#pragma unroll
        for (int stride = size >> 1; stride > 0; stride >>= 1)
#pragma unroll
            for (int i = 0; i < N; ++i) { const int j = i ^ stride;
                if (j > i) { const int mx = max(k[i], k[j]), mn = min(k[i], k[j]); if ((i & size) == 0) { k[i] = mx; k[j] = mn; } else { k[i] = mn; k[j] = mx; } } }
}
__device__ __forceinline__ void sort16_desc(int (&k)[16]) {
#define RT_CE(a_, b_) { const int mx_ = max(k[a_], k[b_]), mn_ = min(k[a_], k[b_]); k[a_] = mx_; k[b_] = mn_; }
    RT_CE(0, 13) RT_CE(1, 12) RT_CE(2, 15) RT_CE(3, 14) RT_CE(4, 8) RT_CE(5, 6) RT_CE(7, 11) RT_CE(9, 10)
    RT_CE(0, 5) RT_CE(1, 7) RT_CE(2, 9) RT_CE(3, 4) RT_CE(6, 13) RT_CE(8, 14) RT_CE(10, 15) RT_CE(11, 12)
    RT_CE(0, 1) RT_CE(2, 3) RT_CE(4, 5) RT_CE(6, 8) RT_CE(7, 9) RT_CE(10, 11) RT_CE(12, 13) RT_CE(14, 15)
    RT_CE(0, 2) RT_CE(1, 3) RT_CE(4, 10) RT_CE(5, 11) RT_CE(6, 7) RT_CE(8, 9) RT_CE(12, 14) RT_CE(13, 15)
    RT_CE(1, 2) RT_CE(3, 12) RT_CE(4, 6) RT_CE(5, 7) RT_CE(8, 10) RT_CE(9, 11) RT_CE(13, 14)
    RT_CE(1, 4) RT_CE(2, 6) RT_CE(5, 8) RT_CE(7, 10) RT_CE(9, 13) RT_CE(11, 14)
    RT_CE(2, 4) RT_CE(3, 6) RT_CE(9, 12) RT_CE(11, 13)
    RT_CE(3, 5) RT_CE(6, 8) RT_CE(7, 9) RT_CE(10, 12)
    RT_CE(3, 4) RT_CE(5, 6) RT_CE(7, 8) RT_CE(9, 10) RT_CE(11, 12)
    RT_CE(6, 7) RT_CE(8, 9)
#undef RT_CE
}
__device__ __forceinline__ void bitonic_merge_desc16(int (&k)[16]) {
#pragma unroll
    for (int stride = 8; stride > 0; stride >>= 1)
#pragma unroll
        for (int i = 0; i < 16; ++i) { const int j = i ^ stride; if (j > i) { const int mx = max(k[i], k[j]), mn = min(k[i], k[j]); k[i] = mx; k[j] = mn; } }
}
__device__ __forceinline__ void merge_top16(int (&a)[16], const int (&b)[16]) {
#pragma unroll
    for (int i = 0; i < 16; ++i) a[i] = max(a[i], b[15 - i]);
    bitonic_merge_desc16(a);
}
__device__ __forceinline__ void cross_merge16(int (&a)[16], int hi) {
    int pnr[16];
#pragma unroll
    for (int i = 0; i < 16; ++i) { auto r = __builtin_amdgcn_permlane32_swap((unsigned)a[i], (unsigned)a[i], false, false); pnr[i] = hi ? (int)r[0] : (int)r[1]; }
#pragma unroll
    for (int i = 0; i < 16; ++i) a[i] = max(a[i], pnr[15 - i]);
    bitonic_merge_desc16(a);
}
__device__ constexpr int A0[25] = {0,0,0,0,0,0,0,0, 1,1,1,1, 2,2, 3,3, 4, 5,6,7, 2, 8,10,12,14};
__device__ constexpr int B0[25] = {0,1,2,3,4,5,6,7, 0,1,2,3, 0,1, 0,1, 0, 0,0,0, 4, 0,0,0,0};
__device__ constexpr int A1[25] = {0,0,0,0,0,0,0,0, 1,1,1,1, 2,2, 3,3, 4, 5,6,7, 4, 9,11,13,15};
__device__ constexpr int B1[25] = {8,9,10,11,12,13,14,15, 4,5,6,7, 2,3, 2,3, 1, 1,1,1, 2, 0,0,0,0};

__device__ __forceinline__ void top16_set(const bf16_t* qrow  , const LAS unsigned char* skset, int r32, int hi, int (&T)[16]) {
    bf16x8 qf[4];
#pragma unroll
    for (int s2 = 0; s2 < 4; ++s2) qf[s2] = *(const bf16x8*)(qrow + 16 * s2);
    int k[4][16];
#pragma unroll
    for (int kb = 0; kb < 4; ++kb) {
        f32x16 sc = f32x16{};
#pragma unroll
        for (int s2 = 0; s2 < 4; ++s2) { const bf16x8 a = *(const LAS bf16x8*)(skset + (2 * s2 + hi) * 2048 + (kb * 32 + r32) * 16); sc = __builtin_amdgcn_mfma_f32_32x32x16_bf16(a, qf[s2], sc, 0, 0, 0); }
#pragma unroll
        for (int r = 0; r < 16; ++r) k[kb][r] = ((mono(sc[r]) & ~0x7f) | (hi << 2)) | (kb * 32 + (r & 3) + 8 * (r >> 2));
        sort16_desc(k[kb]);
    }
    merge_top16(k[0], k[1]); merge_top16(k[2], k[3]); merge_top16(k[0], k[2]);
#pragma unroll
    for (int i = 0; i < 16; ++i) T[i] = k[0][i];
    cross_merge16(T, hi);
}

__device__ __forceinline__ void route_unit(int pm, int pn, const bf16_t* QP, const bf16_t* SKb, int* RIDX, float* RGATE, LAS unsigned char* lds, int wid, int lane) {
    const int r32 = lane & 31, hi = lane >> 5;
    for (int pc = wid; pc < 64; pc += 8) {
        const int set = pc >> 4, ch = (pc >> 1) & 7, hf = pc & 1;
        const bf16_t* src = SKb + ((size_t)((2 * pn + (set >> 1)) * 2 + (set & 1)) * 128 + 64 * hf + lane) * 64 + ch * 8;
        __builtin_amdgcn_global_load_lds((const unsigned*)src, (LAS unsigned*)(lds + set * 16384 + ch * 2048 + hf * 1024), 16, 0, 0);
    }
    asm volatile("s_waitcnt vmcnt(0)" ::: "memory"); __builtin_amdgcn_s_barrier(); asm volatile("" ::: "memory");
    const int t = pm * 256 + wid * 32 + r32;
#pragma unroll 1
    for (int hsel = 0; hsel < 2; ++hsel) {
        const int hh = 2 * pn + hsel;
        int T0[16], T1[16];
        const bf16_t* qrow = QP + (size_t)t * 1024 + hh * 128 + 8 * hi;
        top16_set(qrow, lds + (hsel * 2 + 0) * 16384, r32, hi, T0);
        top16_set(qrow + 64, lds + (hsel * 2 + 1) * 16384, r32, hi, T1);
        int ck[32], ok[25];
#pragma unroll
        for (int k2 = 0; k2 < 25; ++k2) { int ta0_ = T0[A0[k2]], ta1_ = T0[A1[k2]], tb0_ = T1[B0[k2]], tb1_ = T1[B1[k2]];
            asm("" : "+v"(ta0_), "+v"(ta1_), "+v"(tb0_), "+v"(tb1_));
            const int ka = hi ? ta1_ : ta0_, kb2 = hi ? tb1_ : tb0_;
            const float sm = unmono(ka & ~0x7f) + unmono(kb2 & ~0x7f); ok[k2] = ((mono(sm) & ~0x3f) | hi) | (2 * k2); ck[k2] = ok[k2]; }
#pragma unroll
        for (int k2 = 25; k2 < 32; ++k2) ck[k2] = (int)0x80000000;
        bitonic_sort_desc<32>(ck);
        int c16[16];
#pragma unroll
        for (int i = 0; i < 16; ++i) c16[i] = ck[i];
        cross_merge16(c16, hi);
        const int K16 = c16[15];
        const float smax = unmono(T0[0] & ~0x7f) + unmono(T1[0] & ~0x7f);
        float tot = 0.f; int cnt = 0;
#pragma unroll
        for (int k2 = 0; k2 < 25; ++k2) { if (ok[k2] >= K16) { tot += __builtin_amdgcn_exp2f((unmono(ok[k2] & ~0x3f) - smax) * LOG2E); cnt += 1; } }
        float tot_all; int cnt_lo;
        { auto r = __builtin_amdgcn_permlane32_swap(__float_as_uint(tot), __float_as_uint(tot), false, false); tot_all = __uint_as_float(r[0]) + __uint_as_float(r[1]); }
        { auto r = __builtin_amdgcn_permlane32_swap((unsigned)cnt, (unsigned)cnt, false, false); cnt_lo = hi ? (int)r[0] : cnt; }
        const float inv = 1.f / tot_all;
        int pos = hi ? cnt_lo : 0;
        int* ri = RIDX + (size_t)t * 128 + hh * 16; float* rg = RGATE + (size_t)t * 128 + hh * 16;
#pragma unroll
        for (int k2 = 0; k2 < 25; ++k2) {
            if (ok[k2] >= K16) {
                int ta0_ = T0[A0[k2]], ta1_ = T0[A1[k2]], tb0_ = T1[B0[k2]], tb1_ = T1[B1[k2]];
                asm("" : "+v"(ta0_), "+v"(ta1_), "+v"(tb0_), "+v"(tb1_));
                const int ea = (hi ? ta1_ : ta0_) & 0x7f, eb = (hi ? tb1_ : tb0_) & 0x7f;
                ri[pos] = ea * 128 + eb; rg[pos] = __builtin_amdgcn_exp2f((unmono(ok[k2] & ~0x3f) - smax) * LOG2E) * inv; pos += 1;
            }
        }
    }
    asm volatile("s_waitcnt vmcnt(0) lgkmcnt(0)" ::: "memory"); __builtin_amdgcn_s_barrier(); asm volatile("" ::: "memory");
}
}

#ifndef REP_LIST
#define REP_LIST {1, 1, 1, 1, 1, 1, 1, 1, 1, 1, 1, 1, 1, 1}
#endif
__device__ constexpr int REP[14] = REP_LIST;
__global__ void __launch_bounds__(NWAVES * 64, 2) mk_fwd(Args args) {
    extern __shared__ __attribute__((aligned(16))) unsigned char lds[];
    Frame F;
    F.lds = (LAS unsigned char*)lds; F.tid = threadIdx.x; F.lane = F.tid & 63; F.wave = __builtin_amdgcn_readfirstlane(F.tid >> 6);
    F.G = gridDim.x; F.gw = blockIdx.x * NWAVES + F.wave; F.NGW = F.G * NWAVES; F.ws = args.ws; F.tb = F.gw; F.ts = F.NGW;
    const bool mv = (F.G == 256 && args.ph_lo == 0 && args.ph_hi == 12);
    F.trend = mv ? 26624 : 2 * 16384;
    volatile LAS unsigned* MISC = (volatile LAS unsigned*)(F.lds + MISC_OFF);
    for (int u = F.tid; u < (LDS_BYTES - LDSCTL_OFF) / 4; u += NWAVES * 64) ((LAS unsigned*)(F.lds + LDSCTL_OFF))[u] = 0u;
    __syncthreads();
    unsigned* ctl = (unsigned*)(args.ws + WS_CTL);
    XcdBarrier bar = xcd_barrier_post(ctl + CW_BAR + args.bar_region * XCD_BAR_WORDS, MISC + 8);
    const int lo = args.ph_lo, hi = args.ph_hi;
    if (F.tid == 0) __hip_atomic_store(ctl + CW_XID + blockIdx.x, bar.x + 1u, __ATOMIC_RELAXED, __HIP_MEMORY_SCOPE_AGENT);
    int grp = 0;
#define IN(k) (lo <= (k) && (k) < hi)
#define NEXTP(k) ((k) == 5 ? 7 : (k) == 8 ? 10 : (k) + 1)
#define BOTH(k) (IN(k) && IN(NEXTP(k)))
    unsigned char* ws = args.ws;
    bf16_t* Qb = (bf16_t*)args.out; bf16_t* Kb = Qb + (size_t)T_ * 768; bf16_t* Vb = Kb + (size_t)T_ * 768;

    if (IN(0)) for (int rep_ = 0; rep_ < REP[0]; ++rep_) { p0_prologue(F, args); if (BOTH(0)) xcd_barrier(bar); }
    int mypm = 0;
    if (lo == 0 && hi == 12 && F.G == 256) {
        const unsigned xa = xb_ld(ctl + CW_XID + (F.tid & 255)), xb = xb_ld(ctl + CW_XID + (F.tid & 7));
        grp = __syncthreads_and(xa == xb && xa != 0u);
        pg8::StaticOrder S; S.init(T_, 1024, F.G, (int)blockIdx.x); pg8::Unit u; S.next(0, u); mypm = u.pm;
        if (grp) { F.tb = 256 * u.pm + 64 * u.pn + F.wave; F.ts = 8; }
    }

    if (IN(1)) for (int rep_ = 0; rep_ < REP[1]; ++rep_) {
        { pg8::Gemm g{(const bf16_t*)(ws + WS_RA), (const bf16_t*)(ws + WO_WIN), 1024, 1024, T_, 2560, 1024};
          pg8::StaticOrder S; S.init(T_, 2560, F.G, (int)blockIdx.x);
          pg8::EpiGen<0, false, 0, true> E{(bf16_t*)(ws + WS_RB), PJ, nullptr, nullptr, 0, 0.f, 1.f, nullptr, 0, (float*)(ws + PSS1_OFF), 3, T_, nullptr, nullptr};
          pg8::gemm_phase<decltype(E), pg8::StaticOrder, PG8_ALIGN, PG8_SP2>(F.lds + RING_OFF, g, S, E, F.wave); }
        { pg8::Gemm g{(const bf16_t*)(ws + WS_MEMN), (const bf16_t*)(ws + WO_WXKV), 1024, 1024, TM_, 1024, 1024};
          pg8::StaticOrder S; S.init(TM_, 1024, F.G, (int)((blockIdx.x + F.G - 128) % F.G)); if (grp) S.fix(S.c < 32, S.c & 7, S.c >> 3);
          pg8::EpiGen<0, false, 0, false> E{(bf16_t*)(ws + WS_KX), 1024, nullptr, nullptr, 0, 0.f, 1.f, nullptr, 0, nullptr, 0, TM_, nullptr, nullptr};
          pg8::gemm_phase<decltype(E), pg8::StaticOrder, PG8_ALIGN, PG8_SP2>(F.lds + RING_OFF, g, S, E, F.wave); }
        { pg8::Gemm g{(const bf16_t*)(ws + WS_MEMN), (const bf16_t*)(ws + WO_WXKV) + (size_t)1024 * 1024, 1024, 1024, TM_, 1024, 1024};
          pg8::StaticOrder S; S.init(TM_, 1024, F.G, (int)((blockIdx.x + F.G - 160) % F.G)); if (grp) S.fix(S.c < 32, S.c & 7, S.c >> 3);
          pg8::EpiGen<0, false, 0, false> E{(bf16_t*)(ws + WS_VXT), 1024, nullptr, nullptr, 0, 0.f, 1.f, nullptr, 0, nullptr, 0, TM_, nullptr, nullptr};
          pg8::gemm_phase<decltype(E), pg8::StaticOrder, PG8_ALIGN, PG8_SP2>(F.lds + RING_OFF, g, S, E, F.wave); }
        if (mv && blockIdx.x >= 192) {
            p0_table_rows(F, args, 26624 + ((int)blockIdx.x - 192) * NWAVES + F.wave, 2 * 16384, 64 * NWAVES);
            asm volatile("s_waitcnt vmcnt(0)" ::: "memory"); __syncthreads();
            if (F.tid == 0) { __builtin_amdgcn_fence(__ATOMIC_RELEASE, "agent"); asm volatile("s_waitcnt vmcnt(0)" ::: "memory"); (void)xb_add(ctl + CW_DONEW, 1u); }
        }
        if (BOTH(1)) { if (grp) sub_barrier(ctl + CW_SUBX1 + 16 * (blockIdx.x & 7), F.G / 8, bar.bar); else xcd_barrier(bar); }
    }

    if (IN(2)) for (int rep_ = 0; rep_ < REP[2]; ++rep_) {
        { pg8::Gemm g{(const bf16_t*)(ws + WS_RB) + 512, (const bf16_t*)(ws + WO_WUKV), PJ, 256, T_, 1024, 256};
          pg8::StaticOrder S; S.init(T_, 1024, F.G, (int)blockIdx.x);
          pg8::EpiGen<2, true, 0, false> E{Kb, 768, Vb, (const float*)(ws + PSS1_OFF) + (size_t)8 * T_, 4, 1.f / 256.f, 1.f, nullptr, 0, nullptr, 0, T_, nullptr, nullptr};
          pg8::gemm_phase<decltype(E), pg8::StaticOrder, PG8_ALIGN, PG8_SP2>(F.lds + RING_OFF, g, S, E, F.wave); }
        { pg8::Gemm g{(const bf16_t*)(ws + WS_RB), (const bf16_t*)(ws + WO_WUQ), PJ, 384, T_, 768, 384};
          pg8::StaticOrder S; S.init(T_, 768, F.G, (int)((blockIdx.x + F.G - 64) % F.G));
          pg8::EpiGen<1, true, 0, false> E{Qb, 768, nullptr, (const float*)(ws + PSS1_OFF), 8, 1.f / 384.f, LOG2E * 0.10206207261596577f, nullptr, 0, nullptr, 0, T_, (const float*)(ws + WS_COS), (const float*)(ws + WS_SIN)};
          pg8::gemm_phase<decltype(E), pg8::StaticOrder, PG8_ALIGN, PG8_SP2>(F.lds + RING_OFF, g, S, E, F.wave); }
#pragma unroll 1
        for (int h = 0; h < 4; ++h) {
            { pg8::Gemm g{(const bf16_t*)(ws + WS_KX) + h * 256, (const bf16_t*)(ws + WS_WXQN) + h * 256, 1024, 1024, TM_, 1024, 256};
              pg8::StaticOrder S; S.init(TM_, 1024, F.G, (int)((blockIdx.x + F.G - 32 * h) % F.G)); if (grp) S.fix(S.c < 32, S.c & 7, S.c >> 3);
              pg8::EpiGen<0, false, 0, false> E{(bf16_t*)(ws + WS_BS) + (size_t)h * 2048 * 1024, 1024, nullptr, nullptr, 0, 0.f, 1.f, nullptr, 0, nullptr, 0, TM_, nullptr, nullptr};
              pg8::gemm_phase<decltype(E), pg8::StaticOrder, PG8_ALIGN, PG8_SP2>(F.lds + RING_OFF, g, S, E, F.wave); }
            { pg8::Gemm g{(const bf16_t*)(ws + WO_WXO) + h * 256, (const bf16_t*)(ws + WS_VXT) + h * 256, 1024, 1024, 1024, TM_, 256};
              pg8::StaticOrder S; S.init(1024, TM_, F.G, (int)((blockIdx.x + F.G - 128 - 32 * h) % F.G)); if (grp) S.fix(S.c < 32, S.c >> 3, S.c & 7);
              pg8::EpiGen<3, false, 0, false> E{(bf16_t*)(ws + WS_BO), h * 256, nullptr, nullptr, 0, 0.f, 1.f, nullptr, 0, nullptr, 0, 1024, nullptr, nullptr};
              pg8::gemm_phase<decltype(E), pg8::StaticOrder, PG8_ALIGN, PG8_SP2>(F.lds + RING_OFF, g, S, E, F.wave); }
        }
        p2_conv_job(F, args);
        if (BOTH(2)) { if (grp) { sub_barrier(ctl + CW_SUBX2 + 16 * (blockIdx.x & 7), F.G / 8, bar.bar); if (F.tid == 0) (void)xb_add(ctl + CW_DONE2, 1u); } else xcd_barrier(bar); }
    }

    if (IN(3)) for (int rep_ = 0; rep_ < REP[3]; ++rep_) {
        const int vcu = (F.G % 8 == 0) ? (int)((blockIdx.x % 8) * (F.G / 8) + blockIdx.x / 8) : (int)blockIdx.x;
        int lane = __builtin_amdgcn_mbcnt_hi(~0u, __builtin_amdgcn_mbcnt_lo(~0u, 0u)); asm volatile("" : "+v"(lane));
        for (int v = vcu; v < 256; v += F.G) {
            const int bh = v >> 2, sx = v & 3;
            mla::unit<8>(bh >> 3, bh & 7, 7 - sx, Qb, Kb, Vb, (bf16_t*)(ws + WS_RA), F.lds + RING_OFF, F.wave, lane);
            mla::unit<8>(bh >> 3, bh & 7, sx, Qb, Kb, Vb, (bf16_t*)(ws + WS_RA), F.lds + RING_OFF, F.wave, lane);
        }
        if (BOTH(3)) { if (grp) { sub_barrier(ctl + CW_SUBX + 16 * (blockIdx.x & 7), F.G / 8, bar.bar); if (F.tid == 0) { (void)xb_add(ctl + CW_DONE3, 1u); XB_SPIN(xb_ld(ctl + CW_DONE2) < (unsigned)F.G, bar.bar); } __syncthreads(); } else xcd_barrier(bar); }
    }

    if (IN(4)) for (int rep_ = 0; rep_ < REP[4]; ++rep_) {
        pg8::Gemm g{(const bf16_t*)(ws + WS_RA), (const bf16_t*)(ws + WO_WO), 1024, 1024, T_, 1024, 1024};
        pg8::StaticOrder S; S.init(T_, 1024, F.G, (int)blockIdx.x);
        pg8::EpiGen<0, false, 1, true> E{(bf16_t*)(ws + WS_RB), 1024, nullptr, nullptr, 0, 0.f, 1.f, args.in[0], 1024, (float*)(ws + PSS4_OFF), 4, T_, nullptr, nullptr};
        pg8::gemm_phase<decltype(E), pg8::StaticOrder, PG8_ALIGN, PG8_SP2>(F.lds + RING_OFF, g, S, E, F.wave);
        if (BOTH(4)) { if (grp) sub_barrier(ctl + CW_SUBP + 0 * 1024 + 16 * mypm, 4u, bar.bar); else xcd_barrier(bar); }
    }

    if (IN(5)) for (int rep_ = 0; rep_ < REP[5]; ++rep_) {
        pg8::StaticOrder S0; S0.init(T_, 1024, F.G, (int)blockIdx.x);
        for (int ui = 0; ; ++ui) {
            pg8::Unit u; if (!S0.next(ui, u)) break;
            const int bb = u.pm >> 3, hh = u.pn;
            if (ui > 0) { __builtin_amdgcn_fence(__ATOMIC_ACQUIRE, "agent"); asm volatile("s_waitcnt vmcnt(0)" ::: "memory"); __syncthreads(); }
            { pg8::Gemm g{(const bf16_t*)(ws + WS_RB), (const bf16_t*)(ws + WS_BS) + ((size_t)hh * 2048 + (size_t)bb * 256) * 1024, 1024, 1024, T_, 256, 1024};
              pg8::FixedUnit S{u.pm, 0};
              pg8::EpiSoftmax E{(bf16_t*)(ws + WS_RC) + (size_t)u.pm * 256 * 1024 + hh * 256, 1024, (const float*)(ws + PSS4_OFF), 16, 1.f / 1024.f, LOG2E / 16.f, T_};
              pg8::gemm_phase<pg8::EpiSoftmax, pg8::FixedUnit, false, PG8_SP2>(F.lds + RING_OFF, g, S, E, F.wave); }
        }
        if (BOTH(5)) { if (grp) sub_barrier(ctl + CW_SUBP + 1 * 1024 + 16 * mypm, 4u, bar.bar); else xcd_barrier(bar); }
    }


    if (IN(7)) for (int rep_ = 0; rep_ < REP[7]; ++rep_) {
        pg8::Gemm g{(const bf16_t*)(ws + WS_RC), (const bf16_t*)(ws + WS_BO), 1024, 1024, T_, 1024, 1024, (long)1024 * 1024 * 2};
        pg8::StaticOrder S; S.init(T_, 1024, F.G, (int)blockIdx.x);
        pg8::EpiGen<0, false, 2, true> E{(bf16_t*)(ws + WS_RA), 1024, nullptr, nullptr, 0, 0.f, 1.f, (const void*)(ws + WS_RB), 1024, (float*)(ws + PSS6_OFF), 4, T_, nullptr, nullptr};
        pg8::gemm_phase<decltype(E), pg8::StaticOrder, PG8_ALIGN, PG8_SP2>(F.lds + RING_OFF, g, S, E, F.wave);
        if (BOTH(7)) { if (grp) sub_barrier(ctl + CW_SUBP + 2 * 1024 + 16 * mypm, 4u, bar.bar); else xcd_barrier(bar); }
    }

    if (IN(8)) for (int rep_ = 0; rep_ < REP[8]; ++rep_) {
        pg8::StaticOrder S0; S0.init(T_, 1024, F.G, (int)blockIdx.x);
        for (int ui = 0; ; ++ui) {
            pg8::Unit u; if (!S0.next(ui, u)) break;
            { pg8::Gemm g{(const bf16_t*)(ws + WS_RA), (const bf16_t*)(ws + WO_WPQ), 1024, 1024, T_, 1024, 1024};
              pg8::FixedUnit S{u.pm, u.pn};
              pg8::EpiGen<0, true, 0, false> E{(bf16_t*)(ws + WS_RC), 1024, nullptr, (const float*)(ws + PSS6_OFF), 16, 1.f / 1024.f, 1.f, nullptr, 0, nullptr, 0, T_, nullptr, nullptr};
              pg8::gemm_phase<decltype(E), pg8::FixedUnit, false, PG8_SP2>(F.lds + RING_OFF, g, S, E, F.wave); }
            int lane = __builtin_amdgcn_mbcnt_hi(~0u, __builtin_amdgcn_mbcnt_lo(~0u, 0u)); asm volatile("" : "+v"(lane));
            rt::route_unit(u.pm, u.pn, (const bf16_t*)(ws + WS_RC), (const bf16_t*)(ws + WO_SK), (int*)(ws + WS_RIDX), (float*)(ws + WS_RGATE), F.lds + RING_OFF, F.wave, lane);
        }
        if (mv && F.tid == 0) XB_SPIN(xb_ld(ctl + CW_DONEW) < 64u, bar.bar);
        if (BOTH(8)) { if (grp) sub_barrier(ctl + CW_SUBP + 3 * 1024 + 16 * mypm, 4u, bar.bar); else xcd_barrier(bar); }
    }


    if (IN(10)) for (int rep_ = 0; rep_ < REP[10]; ++rep_) { p_peer_u(F, args);
        if (BOTH(10)) { if (grp) wg_seam(ctl + CW_DONE3, F.G, bar.bar); else xcd_barrier(bar); } }
    if (IN(11)) for (int rep_ = 0; rep_ < REP[11]; ++rep_) { p_peer_v(F, args); }
#undef IN
#undef BOTH
}

extern "C" void kernel_launch(void* const* d_in, const int* in_sizes, int n_in, void* d_out, int out_size, void* d_ws, size_t ws_size, hipStream_t stream) {
    const float* x = (const float*)d_in[0];
    const float* g_out = (const float*)d_in[10]; const float* w_o = (const float*)d_in[11];
    const float* g_x = (const float*)d_in[12]; const float* w_xq = (const float*)d_in[14];
    const float* w_xo = (const float*)d_in[16]; const float* g_ffn = (const float*)d_in[17];
    const float* w_pq = (const float*)d_in[18]; const float* sub_keys = (const float*)d_in[19]; const float* u_exp = (const float*)d_in[20];
    const float* v_exp = (const float*)d_in[21]; const float* g_final = (const float*)d_in[22];
    float* out = (float*)d_out; unsigned char* ws = (unsigned char*)d_ws;
    if (ws_size < WS_END || n_in != 23) return;
    static int grid = 0;
    if (grid == 0) {
        int dev = 0, cus = 0;
        if (hipGetDevice(&dev) != hipSuccess || hipDeviceGetAttribute(&cus, hipDeviceAttributeMultiprocessorCount, dev) != hipSuccess) { grid = -1; return; }
        if (hipFuncSetAttribute((const void*)mk_fwd, hipFuncAttributeMaxDynamicSharedMemorySize, LDS_BYTES) != hipSuccess) { grid = -1; return; }
        grid = cus;
    }
    if (grid < 0) return;
    bf16_t* KX = (bf16_t*)(ws + WS_KX); bf16_t* VXT = (bf16_t*)(ws + WS_VXT);
    float* RS1 = (float*)(ws + WS_RIDX) - 2 * T_; float* RS2 = RS1 + T_;
    int* RIDX = (int*)(ws + WS_RIDX); float* RGATE = (float*)(ws + WS_RGATE);
    bf16_t* Y = (bf16_t*)(ws + WS_RA); bf16_t* QX = Y; bf16_t* H2 = Y;
    bf16_t* H1 = (bf16_t*)(ws + WS_RB);
    bf16_t* OX = (bf16_t*)(ws + WS_RC); bf16_t* QP = OX;
    bf16_t* Q = (bf16_t*)d_out; bf16_t* K = Q + (size_t)T_ * 768; bf16_t* V = K + (size_t)T_ * 768;

    hipMemsetAsync(ws + WS_CTL, 0, CTL_ZERO_BYTES, stream);
    Args a; memset(&a, 0, sizeof a);
    for (int i = 0; i < 23; ++i) a.in[i] = d_in[i];
    a.out = out; a.ws = ws;
    a.ph_lo = 0; a.ph_hi = 12; a.bar_region = 0;
    hipLaunchKernelGGL(mk_fwd, dim3(grid), dim3(NWAVES * 64), LDS_BYTES, stream, a);
}
```
